# Optimizing an MI355X kernel written in HIP

```python
import jax, jax.numpy as jnp
from jax import lax
import numpy as np

D_MODEL = 1024
BATCH = 16
SEQ = 2048
DEPTH = 1
DEC_BATCH = 8
DEC_SEQ = 64
PAST_LEN = 4096

CHUNK = 64
GLA_HEADS = 4
GLA_DK = 128
GLA_DV = 256
GLA_K_WIDTH = GLA_HEADS * GLA_DK
GLA_V_WIDTH = GLA_HEADS * GLA_DV
GLA_GATE_RANK = 16
GLA_TAU = 16.0
ATT_HEADS = 16
ATT_DH = 64
ATT_WIDTH = ATT_HEADS * ATT_DH
BAND_PAST_CHUNKS = 8
ATT_PAST = BAND_PAST_CHUNKS * CHUNK
REL_CLIP = 128
D_FF = 2816
EPS = 1e-6
NEG_INF = -1e30
PROJ_SPLITS = (GLA_K_WIDTH, GLA_K_WIDTH, GLA_V_WIDTH, GLA_V_WIDTH, GLA_GATE_RANK,
               ATT_WIDTH, ATT_WIDTH, ATT_WIDTH, D_MODEL, D_MODEL)
PROJ_WIDTH = sum(PROJ_SPLITS)

kernel_name = "gla_chunkband_macaron_stream_step"


def rms_norm(x, g):
    x32 = x.astype(jnp.float32)
    y = x32 * lax.rsqrt(jnp.mean(x32 * x32, axis=-1, keepdims=True) + EPS)
    return (y * g.astype(jnp.float32)).astype(x.dtype)


def swiglu_ffn(x, w_in, w_out):
    gate, up = jnp.split(x @ w_in, 2, axis=-1)
    return (jax.nn.silu(gate) * up) @ w_out


def split_projection(n, w_in):
    idx = np.cumsum(PROJ_SPLITS)[:-1].tolist()
    return jnp.split(n @ w_in, idx, axis=-1)


def gla_chunked(q, k, v, log_a, s0):
    B, T, H, dk = q.shape
    dv = v.shape[-1]
    L = min(CHUNK, T)
    N = T // L
    f32 = jnp.float32
    qc = q.astype(f32).reshape(B, N, L, H, dk)
    kc = k.astype(f32).reshape(B, N, L, H, dk)
    vc = v.astype(f32).reshape(B, N, L, H, dv)
    b = jnp.cumsum(log_a.astype(f32).reshape(B, N, L, H, dk), axis=2)
    b_last = b[:, :, -1]
    q_dec = qc * jnp.exp(b)
    k_inv = kc * jnp.exp(-b)
    k_end = kc * jnp.exp(b_last[:, :, None] - b)
    causal = jnp.tril(jnp.ones((L, L), dtype=bool))
    scores = jnp.where(causal, jnp.einsum('bnihd,bnjhd->bnhij', q_dec, k_inv), 0.0)
    o_intra = jnp.einsum('bnhij,bnjhv->bnihv', scores, vc)
    incr = jnp.einsum('bnjhd,bnjhv->bnhdv', k_end, vc)
    decay = jnp.exp(b_last)

    def step(s, inp):
        d, u = inp
        return d[..., None] * s + u, s

    s_final, s_before = lax.scan(step, s0.astype(f32),
                                 (jnp.moveaxis(decay, 1, 0), jnp.moveaxis(incr, 1, 0)))
    o_inter = jnp.einsum('bnihd,nbhdv->bnihv', q_dec, s_before)
    return (o_intra + o_inter).reshape(B, T, H, dv), s_final


def gla_branch(q_a, k_a, v_a, r_a, f_a, w_gla_gate, b_gla_gate, gla_norm, s0):
    B, T, _ = q_a.shape
    q = q_a.reshape(B, T, GLA_HEADS, GLA_DK) * (GLA_DK ** -0.5)
    k = k_a.reshape(B, T, GLA_HEADS, GLA_DK)
    v = v_a.reshape(B, T, GLA_HEADS, GLA_DV)
    log_a = jax.nn.log_sigmoid((f_a @ w_gla_gate + b_gla_gate).astype(jnp.float32)) / GLA_TAU
    log_a = log_a.reshape(B, T, GLA_HEADS, GLA_DK)
    o, s_new = gla_chunked(q, k, v, log_a, s0)
    o = o * lax.rsqrt(jnp.mean(o * o, axis=-1, keepdims=True) + EPS)
    o = o * gla_norm.astype(jnp.float32).reshape(GLA_HEADS, GLA_DV)
    o = o.reshape(B, T, GLA_V_WIDTH) * jax.nn.silu(r_a.astype(jnp.float32))
    return o.astype(q_a.dtype), s_new.astype(q_a.dtype)


def rel_bias(table, q_pos, k_pos):
    rel = jnp.clip(q_pos[:, None] - k_pos[None, :], -REL_CLIP, REL_CLIP) + REL_CLIP
    return table[:, rel].astype(jnp.float32)


def attend(q, k, v, bias, valid):
    s = jnp.einsum('bqhd,bkhd->bhqk', q, k).astype(jnp.float32) * (ATT_DH ** -0.5) + bias
    s = jnp.where(valid, s, NEG_INF)
    p = jax.nn.softmax(s, axis=-1).astype(v.dtype)
    return jnp.einsum('bhqk,bkhd->bqhd', p, v)


def band_attention_prompt(q, k, v, table):
    B, T, H, d = q.shape
    N = T // CHUNK
    band = ATT_PAST + CHUNK
    kp = jnp.pad(k, ((0, 0), (ATT_PAST, 0), (0, 0), (0, 0)))
    vp = jnp.pad(v, ((0, 0), (ATT_PAST, 0), (0, 0), (0, 0)))
    bias = rel_bias(table, jnp.arange(CHUNK) + ATT_PAST, jnp.arange(band))

    def one_chunk(c):
        start = c * CHUNK
        qc = lax.dynamic_slice_in_dim(q, start, CHUNK, axis=1)
        kc = lax.dynamic_slice_in_dim(kp, start, band, axis=1)
        vc = lax.dynamic_slice_in_dim(vp, start, band, axis=1)
        valid = (start - ATT_PAST + jnp.arange(band)) >= 0
        return attend(qc, kc, vc, bias, valid)

    out = lax.map(one_chunk, jnp.arange(N))
    return jnp.moveaxis(out, 0, 1).reshape(B, T, H, d)


def band_attention_step(q, k, v, cache_k, cache_v, table):
    T = q.shape[1]
    C = cache_k.shape[1]
    keys = jnp.concatenate([cache_k.astype(k.dtype), k], axis=1)
    vals = jnp.concatenate([cache_v.astype(v.dtype), v], axis=1)
    bias = rel_bias(table, C + jnp.arange(T), jnp.arange(C + T))
    valid = jnp.ones((C + T,), dtype=bool)
    return attend(q, keys, vals, bias, valid)


def encoder_layer(x, cache_k, cache_v, state_gla, norm_ffn1, w_ffn1_in, w_ffn1_out,
                  norm_mix, w_in, w_gla_gate, b_gla_gate, gla_norm, attn_rel_bias,
                  w_branch_gla, w_branch_att, w_out, norm_ffn2, w_ffn2_in, w_ffn2_out):
    B, T, _ = x.shape
    h = x + 0.5 * swiglu_ffn(rms_norm(x, norm_ffn1), w_ffn1_in, w_ffn1_out)
    n = rms_norm(h, norm_mix)
    q_a, k_a, v_a, r_a, f_a, q_b, k_b, v_b, g_a, g_b = split_projection(n, w_in)
    if state_gla is None:
        s0 = jnp.zeros((B, GLA_HEADS, GLA_DK, GLA_DV), jnp.float32)
    else:
        s0 = state_gla
    o_a, s_new = gla_branch(q_a, k_a, v_a, r_a, f_a, w_gla_gate, b_gla_gate, gla_norm, s0)
    qh = q_b.reshape(B, T, ATT_HEADS, ATT_DH)
    kh = k_b.reshape(B, T, ATT_HEADS, ATT_DH)
    vh = v_b.reshape(B, T, ATT_HEADS, ATT_DH)
    if cache_k is None:
        o_b = band_attention_prompt(qh, kh, vh, attn_rel_bias)
        k_keep, v_keep = kh[:, -ATT_PAST:], vh[:, -ATT_PAST:]
    else:
        o_b = band_attention_step(qh, kh, vh, cache_k, cache_v, attn_rel_bias)
        k_keep, v_keep = kh, vh
    mixed = (jax.nn.sigmoid(g_a) * (o_a @ w_branch_gla)
             + jax.nn.sigmoid(g_b) * (o_b.reshape(B, T, ATT_WIDTH) @ w_branch_att))
    h = h + mixed @ w_out
    h = h + 0.5 * swiglu_ffn(rms_norm(h, norm_ffn2), w_ffn2_in, w_ffn2_out)
    return h, k_keep, v_keep, s_new


def setup_inputs(seed: int = 0) -> dict:
    key = jax.random.key(seed)
    ks = jax.random.split(key, 24)
    f32 = jnp.float32

    def nrm(k, shape, scale):
        return jax.random.normal(k, shape, f32) * scale

    def gain(k, shape):
        return 1.0 + 0.05 * jax.random.normal(k, shape, f32)

    att_cache_len = min(ATT_PAST, PAST_LEN)
    return {
        "x_prompt": nrm(ks[0], (BATCH, SEQ, D_MODEL), 1.0),
        "x_sample": nrm(ks[1], (DEC_BATCH, DEC_SEQ, D_MODEL), 1.0),
        "cache_att_k": nrm(ks[2], (DEPTH, DEC_BATCH, att_cache_len, ATT_HEADS, ATT_DH), 1.0),
        "cache_att_v": nrm(ks[3], (DEPTH, DEC_BATCH, att_cache_len, ATT_HEADS, ATT_DH), 1.0),
        "state_gla": nrm(ks[4], (DEPTH, DEC_BATCH, GLA_HEADS, GLA_DK, GLA_DV), 0.5),
        "norm_ffn1": gain(ks[5], (DEPTH, D_MODEL)),
        "w_ffn1_in": nrm(ks[6], (DEPTH, D_MODEL, 2 * D_FF), D_MODEL ** -0.5),
        "w_ffn1_out": nrm(ks[7], (DEPTH, D_FF, D_MODEL), D_FF ** -0.5),
        "norm_mix": gain(ks[8], (DEPTH, D_MODEL)),
        "w_in": nrm(ks[9], (DEPTH, D_MODEL, PROJ_WIDTH), D_MODEL ** -0.5),
        "w_gla_gate": nrm(ks[10], (DEPTH, GLA_GATE_RANK, GLA_K_WIDTH), GLA_GATE_RANK ** -0.5),
        "b_gla_gate": nrm(ks[11], (DEPTH, GLA_K_WIDTH), 0.1),
        "gla_norm": gain(ks[12], (DEPTH, GLA_V_WIDTH)),
        "attn_rel_bias": nrm(ks[13], (DEPTH, ATT_HEADS, 2 * REL_CLIP + 1), 0.1),
        "w_branch_gla": nrm(ks[14], (DEPTH, GLA_V_WIDTH, D_MODEL), GLA_V_WIDTH ** -0.5),
        "w_branch_att": nrm(ks[15], (DEPTH, ATT_WIDTH, D_MODEL), ATT_WIDTH ** -0.5),
        "w_out": nrm(ks[16], (DEPTH, D_MODEL, D_MODEL), D_MODEL ** -0.5),
        "norm_ffn2": gain(ks[17], (DEPTH, D_MODEL)),
        "w_ffn2_in": nrm(ks[18], (DEPTH, D_MODEL, 2 * D_FF), D_MODEL ** -0.5),
        "w_ffn2_out": nrm(ks[19], (DEPTH, D_FF, D_MODEL), D_FF ** -0.5),
        "norm_final": gain(ks[20], (D_MODEL,)),
    }


def reference(x_prompt, x_sample, cache_att_k, cache_att_v, state_gla, norm_ffn1, w_ffn1_in,
              w_ffn1_out, norm_mix, w_in, w_gla_gate, b_gla_gate, gla_norm, attn_rel_bias,
              w_branch_gla, w_branch_att, w_out, norm_ffn2, w_ffn2_in, w_ffn2_out, norm_final):
    hp, hs = x_prompt, x_sample
    kp_list, vp_list, sp_list, ks_list, vs_list, ss_list = [], [], [], [], [], []
    for l in range(DEPTH):
        layer_w = (norm_ffn1[l], w_ffn1_in[l], w_ffn1_out[l], norm_mix[l], w_in[l],
                   w_gla_gate[l], b_gla_gate[l], gla_norm[l], attn_rel_bias[l],
                   w_branch_gla[l], w_branch_att[l], w_out[l], norm_ffn2[l],
                   w_ffn2_in[l], w_ffn2_out[l])
        hp, kp, vp, sp = encoder_layer(hp, None, None, None, *layer_w)
        hs, kn, vn, sn = encoder_layer(hs, cache_att_k[l], cache_att_v[l], state_gla[l], *layer_w)
        kp_list.append(kp); vp_list.append(vp); sp_list.append(sp)
        ks_list.append(kn); vs_list.append(vn); ss_list.append(sn)
    y_prompt = rms_norm(hp, norm_final)
    y_sample = rms_norm(hs, norm_final)
    new_att_k_prompt = jnp.stack(kp_list)
    new_att_v_prompt = jnp.stack(vp_list)
    new_gla_prompt = jnp.stack(sp_list)
    new_att_k_sample = jnp.stack(ks_list)
    new_att_v_sample = jnp.stack(vs_list)
    new_gla_sample = jnp.stack(ss_list)
    return (y_prompt, y_sample, new_att_k_prompt, new_att_v_prompt, new_gla_prompt,
            new_att_k_sample, new_att_v_sample, new_gla_sample)
```

```cpp
#include <hip/hip_runtime.h>
#include <hip/hip_cooperative_groups.h>
#include <cstdio>
#include <cstdint>
namespace cg = cooperative_groups;
namespace pg8 {
#define PG8_LAS __attribute__((address_space(3)))
typedef unsigned short bf16_t;
typedef short bf16x8 __attribute__((ext_vector_type(8)));
typedef float f32x4 __attribute__((ext_vector_type(4)));
typedef unsigned u32x4 __attribute__((ext_vector_type(4)));
constexpr int BM = 256, BK = 64, HALF = 128, HTB = HALF * BK * 2  , STAGE_BYTES = 8 * HTB, NXCD = 8, WGM = 4;

__host__ __device__ __forceinline__ int lds_byte(int r, int c) { const int st = (r >> 4) * 2 + (c >> 5), rr = r & 15, cc = c & 31, ob = rr * 64 + cc * 2; return st * 1024 + (ob ^ (((ob >> 9) & 1) << 5)); }
__host__ __device__ __forceinline__ void stage_rc(int b, int& R, int& C) { const int st = b / 1024, sb = b % 1024, swz = sb ^ (((sb >> 9) & 1) << 5); R = (st >> 1) * 16 + swz / 64; C = (st & 1) * 32 + (swz % 64) / 2; }
__host__ __device__ __forceinline__ int perm32(int rho) { const int n = rho >> 4, i = rho & 15; return 8 * (i >> 2) + 4 * n + (i & 3); }

struct Unit { int pm, pn; };
struct Gemm { const bf16_t* A; const bf16_t* Bt; int M, N, K; };

struct StaticOrder {
    int nM, nN, nwg, G, c;
    __host__ __device__ void init(int M, int N, int G_, int c_) { nM = M / BM; nN = N / BM; nwg = nM * nN; G = G_; c = c_; }
    __host__ __device__ bool next(int i, Unit& u) const {
        const long L = (long)i * G + c; if (L >= nwg) return false;
        int wgid = (int)L; { const int q = nwg / NXCD, r = nwg % NXCD, xcd = wgid % NXCD, off = wgid / NXCD; wgid = (xcd < r ? xcd * (q + 1) : r * (q + 1) + (xcd - r) * q) + off; }
        const int nig = WGM * nN, gid = wgid / nig, fm = gid * WGM, gsz = (nM - fm) < WGM ? (nM - fm) : WGM;
        u.pm = fm + ((wgid % nig) % gsz); u.pn = (wgid % nig) / gsz; return true;
    }
    __device__ __forceinline__ void a_ready(const Unit&) const {}
    __device__ __forceinline__ void done(const Unit&) const {}
};

typedef float f32x2_cv __attribute__((ext_vector_type(2))); typedef __bf16 bf16x2_cv __attribute__((ext_vector_type(2)));
__device__ __forceinline__ unsigned cvt_pk_bf16(float lo, float hi) { f32x2_cv v = {lo, hi}; bf16x2_cv b = __builtin_convertvector(v, bf16x2_cv); return __builtin_bit_cast(unsigned, b); }
typedef unsigned u32x2 __attribute__((ext_vector_type(2)));
__device__ __forceinline__ float fast_sigmoid(float x) { return __builtin_amdgcn_rcpf(1.0f + __expf(-x)); }
__device__ __forceinline__ float bf_lo(unsigned w) { return __uint_as_float(w << 16); }
__device__ __forceinline__ float bf_hi(unsigned w) { return __uint_as_float(w & 0xffff0000u); }
__device__ __forceinline__ float rstd_from_ss(const float* ssrow, int fq) {
    const f32x4 a = ((const f32x4*)ssrow)[fq];
    float s = (a[0] + a[1]) + (a[2] + a[3]);
    s += __shfl_xor(s, 16); s += __shfl_xor(s, 32);
    return rsqrtf(s * (1.0f / 1024.0f) + 1e-6f);
}
struct EpiSwiglu {
    static constexpr bool PERM = true, AFTER_DRAIN = false;
    bf16_t* O; const float* SS;
    __device__ __forceinline__ void operator()(const f32x4 (&acc)[2][2][4][2], const Unit& u, int wr, int wc, int fr, int fq) const {
        const int row0 = u.pm * BM + wr * 64 + fr, col0 = u.pn * 128 + wc * 32 + 8 * fq;
#pragma unroll
        for (int ai = 0; ai < 2; ++ai)
#pragma unroll
            for (int m = 0; m < 4; ++m) {
                int row = row0 + ai * HALF + m * 16; asm volatile("" : "+v"(row));
                const float rs = SS ? rstd_from_ss(SS + (size_t)row * 16, fq) : 1.0f;
                float o[8];
#pragma unroll
                for (int n = 0; n < 2; ++n)
#pragma unroll
                    for (int i = 0; i < 4; ++i) { const float g = acc[ai][0][m][n][i] * rs, up = acc[ai][1][m][n][i] * rs; o[4 * n + i] = g * fast_sigmoid(g) * up; }
                u32x4 w; w.x = cvt_pk_bf16(o[0], o[1]); w.y = cvt_pk_bf16(o[2], o[3]); w.z = cvt_pk_bf16(o[4], o[5]); w.w = cvt_pk_bf16(o[6], o[7]);
                *(u32x4*)(O + (size_t)row * 2816 + col0) = w;
            }
    }
};
struct EpiRes {
    static constexpr bool PERM = true, AFTER_DRAIN = false;
    const float* base0; const float* base1; int split_pm; const bf16_t* baseb; float* H; bf16_t* XN; float* SS; float alpha;
    __device__ __forceinline__ void operator()(const f32x4 (&acc)[2][2][4][2], const Unit& u, int wr, int wc, int fr, int fq) const {
        const float* base = (u.pm < split_pm) ? base0 + (size_t)u.pm * BM * 1024 : base1 + (size_t)(u.pm - split_pm) * BM * 1024;
        const int lrow0 = wr * 64 + fr, col0 = u.pn * BM + wc * 32 + 8 * fq;
#pragma unroll
        for (int ai = 0; ai < 2; ++ai)
#pragma unroll
            for (int m = 0; m < 4; ++m) {
                int lrow = lrow0 + ai * HALF + m * 16; asm volatile("" : "+v"(lrow)); const size_t row = (size_t)u.pm * BM + lrow;
                float ss = 0.f;
#pragma unroll
                for (int bj = 0; bj < 2; ++bj) {
                    f32x4 b0, b1;
                    if (baseb) { const u32x4 bw = *(const u32x4*)(baseb + row * 1024 + col0 + bj * HALF);
                        b0 = (f32x4){bf_lo(bw.x), bf_hi(bw.x), bf_lo(bw.y), bf_hi(bw.y)}; b1 = (f32x4){bf_lo(bw.z), bf_hi(bw.z), bf_lo(bw.w), bf_hi(bw.w)}; }
                    else { const float* bp = base + (size_t)lrow * 1024 + col0 + bj * HALF; b0 = *(const f32x4*)bp; b1 = *(const f32x4*)(bp + 4); }
                    const f32x4 v0 = b0 + acc[ai][bj][m][0] * alpha, v1 = b1 + acc[ai][bj][m][1] * alpha;
                    if (H) { float* hp = H + row * 1024 + col0 + bj * HALF; *(f32x4*)hp = v0; *(f32x4*)(hp + 4) = v1; }
                    if (XN) { u32x4 w; w.x = cvt_pk_bf16(v0[0], v0[1]); w.y = cvt_pk_bf16(v0[2], v0[3]); w.z = cvt_pk_bf16(v1[0], v1[1]); w.w = cvt_pk_bf16(v1[2], v1[3]);
                        *(u32x4*)(XN + row * 1024 + col0 + bj * HALF) = w; }
                    ss += (v0[0] * v0[0] + v0[1] * v0[1]) + (v0[2] * v0[2] + v0[3] * v0[3]) + (v1[0] * v1[0] + v1[1] * v1[1]) + (v1[2] * v1[2] + v1[3] * v1[3]);
                    asm volatile("" ::: "memory");
                }
                if (SS) { ss += __shfl_xor(ss, 16); ss += __shfl_xor(ss, 32); if (fq == 0) SS[row * 16 + u.pn * 4 + wc] = ss; }
                asm volatile("" ::: "memory");
            }
    }
};
struct EpiProj {
    static constexpr bool PERM = true, AFTER_DRAIN = false;
    bf16_t* PB; size_t pbs; bf16_t* GG; float* FA; const float* SS; float* okp; float* ovp; float* oks; float* ovs; int grow0;
    __device__ __forceinline__ void operator()(const f32x4 (&acc)[2][2][4][2], const Unit& u, int wr, int wc, int fr, int fq) const {
        const int pn = u.pn; const int lrow0 = u.pm * BM + wr * 64 + fr;
        bf16_t* dst; int ldc, colt;
        if (pn < 24) { dst = PB + (size_t)(pn >> 2) * pbs; ldc = 1024; colt = (pn & 3) * 256; } else { dst = GG; ldc = 2048; colt = (pn - 24) * 256; }
        const int col0 = colt + wc * 32 + 8 * fq;
        float* kvo = nullptr; long kvrow0 = 0;
        if (pn >= 16 && pn < 24) {
            const int gt = grow0 + u.pm * BM;
            if (gt >= 32768) { kvo = (pn < 20) ? oks : ovs; kvrow0 = (long)(gt - 32768) - (long)(u.pm * BM); }
            else if ((gt & 2047) >= 1536) { kvo = (pn < 20) ? okp : ovp; kvrow0 = (long)((gt >> 11) * 512 + ((gt & 2047) - 1536)) - (long)(u.pm * BM); }
        }
#pragma unroll
        for (int ai = 0; ai < 2; ++ai)
#pragma unroll
            for (int m = 0; m < 4; ++m) {
                int row = lrow0 + ai * HALF + m * 16; asm volatile("" : "+v"(row));
                const float rs = rstd_from_ss(SS + (size_t)row * 16, fq);
                if (pn < 32) {
#pragma unroll
                    for (int bj = 0; bj < 2; ++bj) {
                        const f32x4 v0 = acc[ai][bj][m][0] * rs, v1 = acc[ai][bj][m][1] * rs;
                        u32x4 w; w.x = cvt_pk_bf16(v0[0], v0[1]); w.y = cvt_pk_bf16(v0[2], v0[3]); w.z = cvt_pk_bf16(v1[0], v1[1]); w.w = cvt_pk_bf16(v1[2], v1[3]);
                        *(u32x4*)(dst + (size_t)row * ldc + col0 + bj * HALF) = w;
                        if (kvo) { float* p = kvo + (size_t)(kvrow0 + row) * 1024 + col0 + bj * HALF; *(f32x4*)p = v0; *(f32x4*)(p + 4) = v1; }
                    }
                } else if (wc == 0 && fq < 2) {
                    const f32x4 v0 = acc[ai][0][m][0] * rs, v1 = acc[ai][0][m][1] * rs;
                    float* p = FA + (size_t)row * 16 + 8 * fq; *(f32x4*)p = v0; *(f32x4*)(p + 4) = v1;
                }
            }
    }
};
template <int MODE> struct EpiGate {
    static constexpr bool PERM = true, AFTER_DRAIN = false;
    const bf16_t* GG; int goff; bf16_t* TMP; bf16_t* MIX;
    __device__ __forceinline__ void operator()(const f32x4 (&acc)[2][2][4][2], const Unit& u, int wr, int wc, int fr, int fq) const {
        const int lrow0 = u.pm * BM + wr * 64 + fr, col0 = u.pn * BM + wc * 32 + 8 * fq;
#pragma unroll
        for (int ai = 0; ai < 2; ++ai)
#pragma unroll
            for (int m = 0; m < 4; ++m) {
                int rowi = lrow0 + ai * HALF + m * 16; asm volatile("" : "+v"(rowi)); const size_t row = (size_t)rowi;
#pragma unroll
                for (int bj = 0; bj < 2; ++bj) {
                    const u32x4 gw = *(const u32x4*)(GG + row * 2048 + goff + col0 + bj * HALF);
                    f32x4 v0, v1;
                    v0[0] = fast_sigmoid(bf_lo(gw.x)) * acc[ai][bj][m][0][0]; v0[1] = fast_sigmoid(bf_hi(gw.x)) * acc[ai][bj][m][0][1];
                    v0[2] = fast_sigmoid(bf_lo(gw.y)) * acc[ai][bj][m][0][2]; v0[3] = fast_sigmoid(bf_hi(gw.y)) * acc[ai][bj][m][0][3];
                    v1[0] = fast_sigmoid(bf_lo(gw.z)) * acc[ai][bj][m][1][0]; v1[1] = fast_sigmoid(bf_hi(gw.z)) * acc[ai][bj][m][1][1];
                    v1[2] = fast_sigmoid(bf_lo(gw.w)) * acc[ai][bj][m][1][2]; v1[3] = fast_sigmoid(bf_hi(gw.w)) * acc[ai][bj][m][1][3];
                    bf16_t* tp = TMP + row * 1024 + col0 + bj * HALF;
                    if (MODE == 1) { const u32x4 tw = *(const u32x4*)tp;
                        v0 += (f32x4){bf_lo(tw.x), bf_hi(tw.x), bf_lo(tw.y), bf_hi(tw.y)}; v1 += (f32x4){bf_lo(tw.z), bf_hi(tw.z), bf_lo(tw.w), bf_hi(tw.w)}; }
                    u32x4 w; w.x = cvt_pk_bf16(v0[0], v0[1]); w.y = cvt_pk_bf16(v0[2], v0[3]); w.z = cvt_pk_bf16(v1[0], v1[1]); w.w = cvt_pk_bf16(v1[2], v1[3]);
                    *(u32x4*)((MODE == 0 ? tp : MIX + row * 1024 + col0 + bj * HALF)) = w;
                }
            }
    }
};
template <class Epi, class Sched, bool ALIGN_EPI = false, bool SP2 = false>
__device__ __forceinline__ void gemm_phase(PG8_LAS unsigned char* lds, const Gemm g, const Sched& S, const Epi& E, const int tid_arg) {
    int tid_l = tid_arg; asm volatile("" : "+v"(tid_l));
    const int tid = tid_l, wid = __builtin_amdgcn_readfirstlane(tid >> 6), lane = tid & 63, wr = wid >> 2, wc = wid & 3, fr = lane & 15, fq = lane >> 4;
    const int K = g.K, nt = K / BK;
    unsigned voffA[2], voffB[2];
#pragma unroll
    for (int i = 0; i < 2; ++i) { int R, C; stage_rc(tid * 16 + i * 8192, R, C); const int Rb = Epi::PERM ? ((R & ~31) + perm32(R & 31)) : R;
        voffA[i] = (unsigned)(R * K + C) * 2u; voffB[i] = (unsigned)(Rb * K + C) * 2u; }
    const size_t kstep = (size_t)(BK * 2);
    const size_t hstep = (size_t)HALF * K * 2;
    const size_t tstep = 2 * hstep;
    const unsigned ldsw = (unsigned)wid * 1024u;
    const int aoff = lds_byte(wr * 64 + fr, fq * 8), boff = lds_byte(wc * 32 + fr, fq * 8);
#define PG8_SA(b, h) (((b) * 2 + (h)) * HTB)
#define PG8_SB(b, h) ((4 + (b) * 2 + (h)) * HTB)
#define PG8_STAGE(bufoff, gbase, voff) do { _Pragma("unroll") for (int _i = 0; _i < 2; ++_i) \
        __builtin_amdgcn_global_load_lds((const unsigned*)((const char*)(gbase) + (voff)[_i]), (PG8_LAS unsigned*)(lds + (bufoff) + ldsw + _i * 8192), 16, 0, 0); } while (0)
#define PG8_LDA(dst, b, h) do { _Pragma("unroll") for (int m = 0; m < 4; ++m) _Pragma("unroll") for (int k = 0; k < 2; ++k) dst[m][k] = *(const PG8_LAS bf16x8*)(lds + PG8_SA(b, h) + aoff + m * 2048 + k * 1024); } while (0)
#define PG8_LDB(dst, b, h) do { _Pragma("unroll") for (int n = 0; n < 2; ++n) _Pragma("unroll") for (int k = 0; k < 2; ++k) dst[n][k] = *(const PG8_LAS bf16x8*)(lds + PG8_SB(b, h) + boff + n * 2048 + k * 1024); } while (0)
#define PG8_MMA(ai, bj, At, Bt) do { __builtin_amdgcn_s_setprio(1); _Pragma("unroll") for (int m = 0; m < 4; ++m) _Pragma("unroll") for (int n = 0; n < 2; ++n) _Pragma("unroll") for (int k = 0; k < 2; ++k) \
        acc[ai][bj][m][n] = __builtin_amdgcn_mfma_f32_16x16x32_bf16(Bt[n][k], At[m][k], acc[ai][bj][m][n], 0, 0, 0); __builtin_amdgcn_s_setprio(0); } while (0)
#define PG8_WAIT_V(n) asm volatile("s_waitcnt vmcnt(" #n ")" ::: "memory")
#define PG8_WAIT_L(n) asm volatile("s_waitcnt lgkmcnt(" #n ")" ::: "memory")
#define PG8_BAR __builtin_amdgcn_s_barrier()
#define PG8_SCHED __builtin_amdgcn_sched_barrier(0)
    Unit cur, nxt; int ui = 0;
    if (!S.next(0, cur)) return;
    f32x4 acc[2][2][4][2];
#pragma unroll
    for (int a = 0; a < 2; ++a)
#pragma unroll
        for (int b = 0; b < 2; ++b)
#pragma unroll
            for (int m = 0; m < 4; ++m)
#pragma unroll
                for (int n = 0; n < 2; ++n) acc[a][b][m][n] = (f32x4){0.f, 0.f, 0.f, 0.f};
    bf16x8 At[4][2], B0[2][2], B1[2][2];
    const char* cA = (const char*)g.A + (size_t)cur.pm * tstep; const char* cB = (const char*)g.Bt + (size_t)cur.pn * tstep;
    S.a_ready(cur);
    if constexpr (SP2) {
        PG8_STAGE(PG8_SB(0, 0), cB, voffB); PG8_STAGE(PG8_SB(0, 1), cB + hstep, voffB); PG8_STAGE(PG8_SA(0, 0), cA, voffA); PG8_STAGE(PG8_SA(0, 1), cA + hstep, voffA);
        if (wr == 1) PG8_BAR;
        PG8_WAIT_V(2); PG8_BAR;
        PG8_STAGE(PG8_SB(1, 0), cB + kstep, voffB); PG8_STAGE(PG8_SA(1, 0), cA + kstep, voffA); PG8_STAGE(PG8_SB(1, 1), cB + hstep + kstep, voffB);
        PG8_WAIT_V(6); PG8_BAR;
    } else {
        PG8_STAGE(PG8_SB(0, 0), cB, voffB); PG8_STAGE(PG8_SA(0, 0), cA, voffA); PG8_STAGE(PG8_SB(0, 1), cB + hstep, voffB); PG8_STAGE(PG8_SA(0, 1), cA + hstep, voffA);
        if (wr == 1) PG8_BAR;
        PG8_WAIT_V(4); PG8_BAR;
        PG8_STAGE(PG8_SB(1, 0), cB + kstep, voffB); PG8_STAGE(PG8_SA(1, 0), cA + kstep, voffA); PG8_STAGE(PG8_SB(1, 1), cB + hstep + kstep, voffB);
        PG8_WAIT_V(6); PG8_BAR;
    }
    for (;;) {
        const bool has_next = S.next(ui + 1, nxt);
        const char* nA = has_next ? (const char*)g.A + (size_t)nxt.pm * tstep : cA; const char* nB = has_next ? (const char*)g.Bt + (size_t)nxt.pn * tstep : cB;
        for (int t = 0; t < nt; t += 2) {
            const bool last = (t == nt - 2);
            const char* a1 = cA + (size_t)(t + 1) * kstep;
            const char* a2 = last ? nA : cA + (size_t)(t + 2) * kstep; const char* b2 = last ? nB : cB + (size_t)(t + 2) * kstep;
            const char* a3 = a2 + kstep; const char* b3 = b2 + kstep;
            if (last && has_next) S.a_ready(nxt);
            if constexpr (SP2) {
            PG8_LDB(B0, 0, 0); PG8_LDB(B1, 0, 1); PG8_SCHED; PG8_LDA(At, 0, 0); PG8_STAGE(PG8_SA(1, 1), a1 + hstep, voffA);
            PG8_WAIT_V(8); PG8_WAIT_L(0); PG8_BAR; PG8_MMA(0, 0, At, B0); PG8_MMA(0, 1, At, B1); PG8_BAR; PG8_SCHED;
            PG8_LDA(At, 0, 1); PG8_STAGE(PG8_SB(0, 0), b2, voffB); PG8_STAGE(PG8_SB(0, 1), b2 + hstep, voffB); PG8_STAGE(PG8_SA(0, 0), a2, voffA);
            PG8_WAIT_V(8); PG8_WAIT_L(0); PG8_BAR; PG8_MMA(1, 0, At, B0); PG8_MMA(1, 1, At, B1); PG8_BAR; PG8_SCHED;
            PG8_LDB(B0, 1, 0); PG8_LDB(B1, 1, 1); PG8_SCHED; PG8_LDA(At, 1, 0); PG8_STAGE(PG8_SA(0, 1), a2 + hstep, voffA);
            PG8_WAIT_V(8); PG8_WAIT_L(0); PG8_BAR; PG8_MMA(0, 0, At, B0); PG8_MMA(0, 1, At, B1); PG8_BAR; PG8_SCHED;
            PG8_LDA(At, 1, 1); PG8_STAGE(PG8_SB(1, 0), b3, voffB); PG8_STAGE(PG8_SB(1, 1), b3 + hstep, voffB); PG8_STAGE(PG8_SA(1, 0), a3, voffA);
            PG8_WAIT_V(8); PG8_WAIT_L(0); PG8_BAR; PG8_MMA(1, 0, At, B0); PG8_MMA(1, 1, At, B1); PG8_BAR; PG8_SCHED;
            } else {
            PG8_LDB(B0, 0, 0); PG8_SCHED; PG8_LDA(At, 0, 0); PG8_STAGE(PG8_SA(1, 1), a1 + hstep, voffA);
            PG8_WAIT_L(8); PG8_BAR; PG8_WAIT_L(0); PG8_MMA(0, 0, At, B0); PG8_BAR; PG8_SCHED;
            PG8_LDB(B1, 0, 1); PG8_STAGE(PG8_SB(0, 0), b2, voffB);
            PG8_BAR; PG8_WAIT_L(0); PG8_MMA(0, 1, At, B1); PG8_BAR;
            PG8_LDA(At, 0, 1); PG8_STAGE(PG8_SA(0, 0), a2, voffA);
            PG8_BAR; PG8_WAIT_L(0); PG8_MMA(1, 0, At, B0); PG8_BAR; PG8_SCHED;
            PG8_STAGE(PG8_SB(0, 1), b2 + hstep, voffB);
            PG8_WAIT_V(6); PG8_BAR; PG8_MMA(1, 1, At, B1); PG8_BAR;
            PG8_LDB(B0, 1, 0); PG8_SCHED; PG8_LDA(At, 1, 0); PG8_STAGE(PG8_SA(0, 1), a2 + hstep, voffA);
            PG8_WAIT_L(8); PG8_BAR; PG8_WAIT_L(0); PG8_MMA(0, 0, At, B0); PG8_BAR; PG8_SCHED;
            PG8_LDB(B1, 1, 1); PG8_STAGE(PG8_SB(1, 0), b3, voffB);
            PG8_BAR; PG8_WAIT_L(0); PG8_MMA(0, 1, At, B1); PG8_BAR;
            PG8_LDA(At, 1, 1); PG8_STAGE(PG8_SA(1, 0), a3, voffA);
            PG8_BAR; PG8_WAIT_L(0); PG8_MMA(1, 0, At, B0); PG8_BAR; PG8_SCHED;
            PG8_STAGE(PG8_SB(1, 1), b3 + hstep, voffB);
            PG8_WAIT_V(6); PG8_BAR; PG8_MMA(1, 1, At, B1); PG8_BAR;
            }
        }
        if constexpr (ALIGN_EPI) { if (wr == 0) PG8_BAR; }
        if constexpr (!Epi::AFTER_DRAIN) { E(acc, cur, wr, wc, fr, fq); S.done(cur); }
        if (!has_next) break;
#pragma unroll
        for (int a = 0; a < 2; ++a)
#pragma unroll
            for (int b = 0; b < 2; ++b)
#pragma unroll
                for (int m = 0; m < 4; ++m)
#pragma unroll
                    for (int n = 0; n < 2; ++n) acc[a][b][m][n] = (f32x4){0.f, 0.f, 0.f, 0.f};
        cur = nxt; cA = nA; cB = nB; ++ui;
        if constexpr (ALIGN_EPI) { if (wr == 1) PG8_BAR; }
    }
    PG8_WAIT_V(0);
    if constexpr (!ALIGN_EPI) { if (wr == 0) PG8_BAR; }
    PG8_BAR;
    if constexpr (Epi::AFTER_DRAIN) { E.fused(acc, cur, wr, wc, fr, fq, lds, wid, lane); S.done(cur); }
#undef PG8_SA
#undef PG8_SB
#undef PG8_STAGE
#undef PG8_LDA
#undef PG8_LDB
#undef PG8_MMA
#undef PG8_WAIT_V
#undef PG8_WAIT_L
#undef PG8_BAR
#undef PG8_SCHED
}
}
#define LAS __attribute__((address_space(3)))
#define GASP __attribute__((address_space(1)))
typedef unsigned short bf16;
typedef float f32x4 __attribute__((ext_vector_type(4)));
typedef float f32x16 __attribute__((ext_vector_type(16)));
typedef short bf16x8 __attribute__((ext_vector_type(8)));
typedef short s16x4 __attribute__((ext_vector_type(4)));
typedef unsigned u32x4 __attribute__((ext_vector_type(4)));
typedef unsigned u32x2 __attribute__((ext_vector_type(2)));
constexpr int NWAVES = 8, NTHREADS = 512;
constexpr int DM = 1024, T_P = 32768, T_S = 512, T_ALL = 33280, DFF = 2816, NPROJ = 8448, NPROJ_SRC = 8208;
constexpr int MG = 16896;
constexpr size_t PBS = (size_t)MG * 1024 * 2;
constexpr size_t WS_W1T = 0;
constexpr size_t WS_W1OT = WS_W1T + (size_t)5632 * 1024 * 2;
constexpr size_t WS_WINT = WS_W1OT + (size_t)1024 * 2816 * 2;
constexpr size_t WS_WBGT = WS_WINT + (size_t)NPROJ * 1024 * 2;
constexpr size_t WS_WBAT = WS_WBGT + (size_t)1024 * 1024 * 2;
constexpr size_t WS_WOUTT = WS_WBAT + (size_t)1024 * 1024 * 2;
constexpr size_t WS_W2T = WS_WOUTT + (size_t)1024 * 1024 * 2;
constexpr size_t WS_W2OT = WS_W2T + (size_t)5632 * 1024 * 2;
constexpr size_t WS_CKB = WS_W2OT + (size_t)1024 * 2816 * 2;
constexpr size_t WS_CVB = WS_CKB + (size_t)8 * 512 * 1024 * 2;
constexpr size_t WS_XN = WS_CVB + (size_t)8 * 512 * 1024 * 2;
constexpr size_t WS_SS1 = WS_XN + (size_t)T_ALL * 1024 * 2;
constexpr size_t WS_SS2 = WS_SS1 + (size_t)T_ALL * 16 * 4;
constexpr size_t WS_R = WS_SS2 + (size_t)T_ALL * 16 * 4;
constexpr size_t WS_ACT = WS_R;
constexpr size_t WS_PB = WS_R, WS_GG = WS_PB + 6 * PBS, WS_FA = WS_GG + (size_t)MG * 2048 * 2, WS_OA = WS_FA + (size_t)MG * 16 * 4, WS_OB = WS_OA + PBS, WS_END = WS_OB + PBS;
constexpr size_t WS_TMP = WS_PB, WS_MIX = WS_PB + 2 * PBS;
static_assert(WS_END <= (size_t)536870912 && WS_ACT + (size_t)T_ALL * DFF * 2 <= WS_END, "workspace map");
constexpr size_t WS_CTL = WS_END, CTL_BYTES = 16384;
constexpr int LDS_BYTES = 147456, XST_OFF = 139264;
constexpr size_t O_Y = 0, O_KP = (size_t)T_ALL * 1024, O_VP = O_KP + (size_t)16 * 512 * 1024, O_GP = O_VP + (size_t)16 * 512 * 1024, O_KS = O_GP + (size_t)16 * 4 * 128 * 256,
                 O_VS = O_KS + (size_t)8 * 64 * 1024, O_GS = O_VS + (size_t)8 * 64 * 1024, O_END = O_GS + (size_t)8 * 4 * 128 * 256;

__device__ __forceinline__ unsigned f2bf(float f) { unsigned u = __builtin_bit_cast(unsigned, f); return (u + 0x7fffu + ((u >> 16) & 1u)) >> 16; }
__device__ __forceinline__ unsigned pk2(float lo, float hi) { return pg8::cvt_pk_bf16(lo, hi); }
__device__ __forceinline__ float bflo(unsigned w) { return __uint_as_float(w << 16); }
__device__ __forceinline__ float bfhi(unsigned w) { return __uint_as_float(w & 0xffff0000u); }
#define LDS_WAIT() asm volatile("s_waitcnt lgkmcnt(0)" ::: "memory")
__device__ __forceinline__ float wave_sum(float v) {
#pragma unroll
    for (int o = 1; o < 64; o <<= 1) v += __shfl_xor(v, o);
    return v;
}
__device__ __forceinline__ int crow(int r, int hi) { return (r & 3) + 8 * (r >> 2) + 4 * hi; }

struct Args { const float* in[21]; float* out; unsigned char* ws; };
typedef const __attribute__((address_space(4))) unsigned long long* karg_ptr_t;
__device__ __forceinline__ const float* arg_in(int i) { karg_ptr_t p = (karg_ptr_t)__builtin_amdgcn_kernarg_segment_ptr(); asm volatile("" : "+s"(p)); return (const float*)(const GASP float*)p[i]; }
#define AIN(i) arg_in(i)

__device__ __forceinline__ void transpose_item(const float* W, int N, int K, int k0, int src0, int nvalid, bf16* WT, int drow0, const float* gk, float cs, LAS float* scr, int lane) {
    const int c32 = lane & 31;
#pragma unroll
    for (int i = 0; i < 32; ++i) { const int kk = 2 * i + (lane >> 5); float v = 0.f;
        if (c32 < nvalid) v = W[(size_t)(k0 + kk) * N + src0 + c32] * (gk ? gk[k0 + kk] : 1.0f) * cs;
        scr[kk * 33 + c32] = v; }
    LDS_WAIT(); asm volatile("" ::: "memory");
    const int c = lane & 7;
#pragma unroll
    for (int j = 0; j < 4; ++j) { const int n = (lane >> 3) + 8 * j; const LAS float* s = scr + (8 * c) * 33 + n;
        u32x4 o; o.x = pk2(s[0 * 33], s[1 * 33]); o.y = pk2(s[2 * 33], s[3 * 33]); o.z = pk2(s[4 * 33], s[5 * 33]); o.w = pk2(s[6 * 33], s[7 * 33]);
        *(u32x4*)(WT + (size_t)(drow0 + n) * K + k0 + 8 * c) = o; }
    LDS_WAIT(); asm volatile("" ::: "memory");
}
__device__ __forceinline__ void transpose_matrix_item(int kind, const float* W, int N, int K, int ND, bf16* WT, const float* gk, int item, LAS float* scr, int lane) {
    const int nblk = ND / 32, kb = item / nblk, nb = item % nblk, drow0 = 32 * nb; int src0 = drow0, nvalid = 32; float cs = 1.0f;
    if (kind == 1) { const int j = drow0 >> 8, w = drow0 & 255; src0 = (w < 128) ? 128 * j + w : 2816 + 128 * j + (w - 128); }
    else if (kind == 2) {
        if (drow0 < 3072) { cs = (drow0 < 512) ? 0.08838834764831845f : 1.0f; }
        else if (drow0 < 8192) { src0 = drow0 + 16; cs = (drow0 < 4096) ? 0.125f : 1.0f; }
        else if (drow0 == 8192) { src0 = 3072; nvalid = 16; }
        else { src0 = 0; nvalid = 0; }
    }
    transpose_item(W, N, K, 64 * kb, src0, nvalid, WT, drow0, gk, cs, scr, lane);
}

__device__ __forceinline__ void transpose_tile_block(int kind, const float* W, int N, int K, int ND, bf16* WT, const float* gk, int item, LAS unsigned char* lds, int tid) {
    constexpr int LP = 260;
    const int ntile = ND / 256, kb = item / ntile, nt = item % ntile, k0 = 64 * kb, drow0 = 256 * nt;
    int srcA = drow0, srcB = drow0 + 128, nvalid = 256; float cs = 1.0f;
    if (kind == 1) { srcA = 128 * nt; srcB = 2816 + 128 * nt; }
    else if (kind == 2) {
        if (drow0 < 3072) { cs = (drow0 < 512) ? 0.08838834764831845f : 1.0f; }
        else if (drow0 < 8192) { srcA = drow0 + 16; srcB = drow0 + 144; cs = (drow0 < 4096) ? 0.125f : 1.0f; }
        else { srcA = 3072; srcB = 3072; nvalid = 16; }
    }
    LAS float* T = (LAS float*)lds;
    __syncthreads();
#pragma unroll
    for (int r = 0; r < 8; ++r) { const int id = tid + NTHREADS * r, row = id >> 6, cv = id & 63, col = cv * 4;
        f32x4 v = (f32x4){0.f, 0.f, 0.f, 0.f};
        if (col < nvalid) { const int src = (col < 128) ? srcA + col : srcB + (col - 128); v = *(const f32x4*)(W + (size_t)(k0 + row) * N + src); }
        const float g = (gk ? gk[k0 + row] : 1.0f) * cs;
        *(LAS f32x4*)(T + row * LP + col) = v * g; }
    __syncthreads();
#pragma unroll
    for (int r = 0; r < 4; ++r) { const int id = tid + NTHREADS * r, n = id >> 3, k8 = id & 7; const LAS float* s = T + (k8 * 8) * LP + n;
        u32x4 o; o.x = pk2(s[0 * LP], s[1 * LP]); o.y = pk2(s[2 * LP], s[3 * LP]); o.z = pk2(s[4 * LP], s[5 * LP]); o.w = pk2(s[6 * LP], s[7 * LP]);
        *(u32x4*)(WT + (size_t)(drow0 + n) * K + k0 + 8 * k8) = o; }
}
__device__ __forceinline__ void rms_rows4_to_bf16(const float* x0, bf16* o0, int lane) {
    f32x4 v[4][4]; float s[4];
#pragma unroll
    for (int q = 0; q < 4; ++q) { const f32x4* xr = (const f32x4*)(x0 + q * 1024) + lane;
#pragma unroll
        for (int j = 0; j < 4; ++j) v[q][j] = xr[64 * j]; }
#pragma unroll
    for (int q = 0; q < 4; ++q) { s[q] = 0.f;
#pragma unroll
        for (int j = 0; j < 4; ++j) s[q] += (v[q][j].x * v[q][j].x + v[q][j].y * v[q][j].y) + (v[q][j].z * v[q][j].z + v[q][j].w * v[q][j].w); }
#pragma unroll
    for (int o = 1; o < 64; o <<= 1) {
#pragma unroll
        for (int q = 0; q < 4; ++q) s[q] += __shfl_xor(s[q], o); }
#pragma unroll
    for (int q = 0; q < 4; ++q) { const float rstd = rsqrtf(s[q] * (1.f / 1024.f) + 1e-6f); u32x2* o8 = (u32x2*)(o0 + q * 1024) + lane;
#pragma unroll
        for (int j = 0; j < 4; ++j) { u32x2 w; w.x = pk2(v[q][j].x * rstd, v[q][j].y * rstd); w.y = pk2(v[q][j].z * rstd, v[q][j].w * rstd); o8[64 * j] = w; } }
}
#define XB_TMO      128
#define XB_XCNT(j)  (256  + 64 * (j))
#define XB_XSUB(j)  (1280 + 64 * (j))
#define XB_XGEN(j)  (2304 + 64 * (j))
#define XB_TOP      3328
#define XB_TOPGEN   3392
#define XCD_BAR_WORDS 3456
#define XB_SPIN_CAP (1u << 18)

__device__ __forceinline__ unsigned xb_ld(unsigned* p)              { return __hip_atomic_load(p, __ATOMIC_RELAXED, __HIP_MEMORY_SCOPE_AGENT); }
__device__ __forceinline__ unsigned xb_add(unsigned* p, unsigned v) { return __hip_atomic_fetch_add(p, v, __ATOMIC_RELAXED, __HIP_MEMORY_SCOPE_AGENT); }
__device__ __forceinline__ unsigned xb_xcc_id() { return (unsigned)__builtin_amdgcn_s_getreg((3 << 11) | 20) & 0xFu; }
#define XB_SPIN(cond, bar) do { unsigned _sp = 0; while (cond) { __builtin_amdgcn_s_sleep(1); \
    if ((++_sp & 255u) == 0u) { if (xb_ld(&(bar)[XB_TMO])) break; if (_sp > XB_SPIN_CAP) { atomicAdd(&(bar)[XB_TMO], 1u); break; } } } } while (0)

struct XcdBarrier {
    unsigned* bar; unsigned x;
    volatile LAS unsigned* st;
};

__device__ __forceinline__ XcdBarrier xcd_barrier_post(unsigned* bar, volatile LAS unsigned* st) {
    XcdBarrier b; b.bar = bar; b.x = xb_xcc_id(); b.st = st;
    if (threadIdx.x == 0) (void)xb_add(&bar[XB_XCNT(b.x)], 1u);
    return b;
}
__device__ __forceinline__ void xcd_barrier_complete(unsigned* bar, unsigned x, unsigned& nloc, unsigned& nx) {
    const unsigned G = gridDim.x * gridDim.y * gridDim.z;
    unsigned sum, cnt, mine, sp = 0u;
    for (;;) {
        sum = 0u; cnt = 0u; mine = 0u;
#pragma unroll
        for (unsigned j = 0; j < 16; ++j) { const unsigned c = xb_ld(&bar[XB_XCNT(j)]); sum += c; cnt += (c > 0u) ? 1u : 0u; mine = (j == x) ? c : mine; }
        if (sum == G) break;
        __builtin_amdgcn_s_sleep(1);
        if ((++sp & 255u) == 0u) { if (xb_ld(&bar[XB_TMO])) break; if (sp > XB_SPIN_CAP) { atomicAdd(&bar[XB_TMO], 1u); break; } }
    }
    nloc = mine > 0u ? mine : 1u; nx = cnt > 0u ? cnt : 1u;
}

__device__ __forceinline__ void xcd_barrier(const XcdBarrier& b, const bool leader) {
    asm volatile("s_waitcnt vmcnt(0)" ::: "memory");
    __syncthreads();
    if (leader) {
        unsigned* bar = b.bar;
        __builtin_amdgcn_s_waitcnt(0);
        unsigned nloc = b.st[0], nx = b.st[1];
        if (nloc == 0u) { xcd_barrier_complete(bar, b.x, nloc, nx); b.st[0] = nloc; b.st[1] = nx; }
        const unsigned old = xb_add(&bar[XB_XSUB(b.x)], 1u);
        const unsigned gen = old / nloc;
        if (old + 1u == (gen + 1u) * nloc) {
            __builtin_amdgcn_fence(__ATOMIC_RELEASE, "agent");
            asm volatile("s_waitcnt vmcnt(0)" ::: "memory");
            const unsigned og = xb_add(&bar[XB_TOP], 1u);
            const unsigned tg = og / nx;
            if (og + 1u == (tg + 1u) * nx) xb_add(&bar[XB_TOPGEN], 1u);
            else XB_SPIN(xb_ld(&bar[XB_TOPGEN]) == tg, bar);
            __builtin_amdgcn_fence(__ATOMIC_ACQUIRE, "agent");
            xb_add(&bar[XB_XGEN(b.x)], 1u);
            asm volatile("s_waitcnt vmcnt(0)" ::: "memory");
        } else {
            XB_SPIN(xb_ld(&bar[XB_XGEN(b.x)]) == gen, bar);
            __builtin_amdgcn_fence(__ATOMIC_ACQUIRE, "agent");
            asm volatile("s_waitcnt vmcnt(0)" ::: "memory");
        }
    }
    __syncthreads();
}
constexpr int ATT_VP = 144, ATT_VVP = 192, ATT_VBYTES = 64 * ATT_VVP, ATT_WLDS = 13440;
__device__ __forceinline__ s16x4 tr16(LAS const unsigned char* p) { typedef short v4i16_t __attribute__((ext_vector_type(4)));
    return __builtin_bit_cast(s16x4, __builtin_amdgcn_ds_read_tr16_b64_v4i16((LAS v4i16_t*)p)); }
__device__ __forceinline__ bf16x8 cat8(s16x4 a, s16x4 b) { return (bf16x8){a[0], a[1], a[2], a[3], b[0], b[1], b[2], b[3]}; }
__device__ __forceinline__ bf16x8 pack8(const f32x16& v, int o) { u32x4 w; w.x = pk2(v[o], v[o + 1]); w.y = pk2(v[o + 2], v[o + 3]); w.z = pk2(v[o + 4], v[o + 5]); w.w = pk2(v[o + 6], v[o + 7]); return __builtin_bit_cast(bf16x8, w); }

__device__ __forceinline__ void attn_unit(LAS unsigned char* wl, const bf16* Qc, bf16* Oc, const bf16* KBc, const bf16* VBc, const bf16* CK, const bf16* CV, bool sample, int t0, const float* tabh, int lane, const int qh) {
    const int r32 = lane & 31, hi = lane >> 5, g16 = lane >> 4, i16 = lane & 15;
    LAS float* btab = (LAS float*)(wl + ATT_VBYTES);
    asm volatile("" ::: "memory");
    for (int i = lane; i < 257; i += 64) btab[i] = tabh[i];
    const float cb = tabh[256];
    bf16x8 qfr[4];
#pragma unroll
    for (int d0 = 0; d0 < 4; ++d0) qfr[d0] = *(const bf16x8*)(Qc + (size_t)(32 * qh + r32) * 1024 + 16 * d0 + 8 * hi);
    f32x16 oT[2];
#pragma unroll
    for (int a = 0; a < 2; ++a)
#pragma unroll
        for (int r = 0; r < 16; ++r) oT[a][r] = 0.f;
    float mrun = -1e30f, lrun = 0.f;
    const int traddr = ((g16 >> 1) * 4 + (i16 >> 2)) * ATT_VVP + ((g16 & 1) * 16 + (i16 & 3) * 4) * 2;
    for (int t = t0; t < 9; ++t) {
        const bf16 *kp, *vp;
        if (sample && t < 8) { kp = CK + (size_t)t * 64 * 1024; vp = CV + (size_t)t * 64 * 1024; }
        else { const long off = -(long)(8 - t) * 64 * 1024; kp = KBc + off; vp = VBc + off; }
        u32x4 vreg[8];
#pragma unroll
        for (int i = 0; i < 8; ++i) vreg[i] = *(const u32x4*)(vp + (size_t)(8 * i + (lane >> 3)) * 1024 + (lane & 7) * 8);
        bf16x8 kf[2][4];
#pragma unroll
        for (int kvh = 0; kvh < 2; ++kvh)
#pragma unroll
            for (int d0 = 0; d0 < 4; ++d0) kf[kvh][d0] = *(const bf16x8*)(kp + (size_t)(32 * kvh + r32) * 1024 + 16 * d0 + 8 * hi);
        LDS_WAIT();
#pragma unroll
        for (int i = 0; i < 8; ++i) *(LAS u32x4*)(wl + (8 * i + (lane >> 3)) * ATT_VVP + (lane & 7) * 16) = vreg[i];
        {
            f32x16 s0, s1;
#pragma unroll
            for (int r = 0; r < 16; ++r) { s0[r] = 0.f; s1[r] = 0.f; }
#pragma unroll
            for (int d0 = 0; d0 < 4; ++d0) { s0 = __builtin_amdgcn_mfma_f32_32x32x16_bf16(kf[0][d0], qfr[d0], s0, 0, 0, 0); s1 = __builtin_amdgcn_mfma_f32_32x32x16_bf16(kf[1][d0], qfr[d0], s1, 0, 0, 0); }
            if (t < 6) {
#pragma unroll
                for (int r = 0; r < 16; ++r) { s0[r] += cb; s1[r] += cb; }
            } else {
                const int relb = 64 * (8 - t) + 32 * qh + r32 + 128;
#pragma unroll
                for (int r = 0; r < 16; ++r) { const int i0 = relb - crow(r, hi); s0[r] += btab[i0 > 256 ? 256 : i0]; const int i1 = i0 - 32; s1[r] += btab[i1 > 256 ? 256 : i1]; }
            }
            float tm = fmaxf(s0[0], s1[0]);
#pragma unroll
            for (int r = 1; r < 16; ++r) tm = fmaxf(tm, fmaxf(s0[r], s1[r]));
            tm = fmaxf(tm, __shfl_xor(tm, 32));
            const float mn = fmaxf(mrun, tm), sc = __expf(mrun - mn); mrun = mn;
            float ps = 0.f;
#pragma unroll
            for (int r = 0; r < 16; ++r) { s0[r] = __expf(s0[r] - mn); s1[r] = __expf(s1[r] - mn); ps += s0[r] + s1[r]; }
            lrun = lrun * sc + ps;
#pragma unroll
            for (int r = 0; r < 16; ++r) { oT[0][r] *= sc; oT[1][r] *= sc; }
            bf16x8 pf[4]; pf[0] = pack8(s0, 0); pf[1] = pack8(s0, 8); pf[2] = pack8(s1, 0); pf[3] = pack8(s1, 8);
            LDS_WAIT();
#pragma unroll
            for (int dh = 0; dh < 2; ++dh)
#pragma unroll
                for (int kc = 0; kc < 4; ++kc) {
                    LAS const unsigned char* p = wl + traddr + (16 * kc) * ATT_VVP + dh * 64;
                    const bf16x8 vf = cat8(tr16(p), tr16(p + 8 * ATT_VVP));
                    oT[dh] = __builtin_amdgcn_mfma_f32_32x32x16_bf16(vf, pf[kc], oT[dh], 0, 0, 0);
                }
        }
        asm volatile("" ::: "memory");
    }
    {
        const float lt = lrun + __shfl_xor(lrun, 32), inv = 1.0f / lt;
        bf16* orow = Oc + (size_t)(32 * qh + r32) * 1024;
#pragma unroll
        for (int dh = 0; dh < 2; ++dh)
#pragma unroll
            for (int rg = 0; rg < 4; ++rg) { u32x2 w; w.x = pk2(oT[dh][4 * rg] * inv, oT[dh][4 * rg + 1] * inv); w.y = pk2(oT[dh][4 * rg + 2] * inv, oT[dh][4 * rg + 3] * inv);
                *(u32x2*)(orow + 32 * dh + 8 * rg + 4 * hi) = w; }
    }
    LDS_WAIT(); asm volatile("" ::: "memory");
}
constexpr int AB_HB = 9216 + ATT_VBYTES, AB_BUF = 2 * AB_HB, AB_TAB = 2 * AB_BUF;
__device__ __forceinline__ void attn_block_unit(LAS unsigned char* lds, const bf16* QB, bf16* OB, const bf16* KB, const bf16* VB, int sb, int hp, int cp, const float* tab, int tid) {
    const int lane = tid & 63, w = __builtin_amdgcn_readfirstlane(tid >> 6), r32 = lane & 31, hi = lane >> 5, g16 = lane >> 4, i16 = lane & 15;
    const int hsel = w >> 2, csel = (w >> 1) & 1, qh = w & 1, h = 2 * hp + hsel, c = 2 * cp + csel;
    LAS float* btab = (LAS float*)(lds + AB_TAB + hsel * 1040);
    __syncthreads();
    for (int i = tid; i < 2 * 257; i += NTHREADS) { const int hh = i >= 257, k = i - 257 * hh; ((LAS float*)(lds + AB_TAB + hh * 1040))[k] = tab[(2 * hp + hh) * 257 + k]; }
    const float cb = tab[h * 257 + 256];
    const size_t hoff = (size_t)h * 64;
    const bf16* Qc = QB + ((size_t)sb * 2048 + (size_t)c * 64) * 1024 + hoff;
    bf16x8 qfr[4];
#pragma unroll
    for (int d0 = 0; d0 < 4; ++d0) qfr[d0] = *(const bf16x8*)(Qc + (size_t)(32 * qh + r32) * 1024 + 16 * d0 + 8 * hi);
    f32x16 oT[2];
#pragma unroll
    for (int a = 0; a < 2; ++a)
#pragma unroll
        for (int r = 0; r < 16; ++r) oT[a][r] = 0.f;
    float mrun = -1e30f, lrun = 0.f;
    const int traddr = ((g16 >> 1) * 4 + (i16 >> 2)) * ATT_VVP + ((g16 & 1) * 16 + (i16 & 3) * 4) * 2;
    const int lrow = tid >> 3, lch = tid & 7;
    const int tc0 = 2 * cp - 8, j0 = tc0 < 0 ? -tc0 : 0;
    const size_t pbase = ((size_t)sb * 2048 + lrow) * 1024 + (size_t)(2 * hp) * 64 + lch * 8;
    const bf16* kbase = KB + pbase; const bf16* vbase = VB + pbase;
    u32x4 kreg0, vreg0, kreg1, vreg1;
#define AB_LOAD(jj) do { const long o_ = (long)(tc0 + (jj)) * 64 * 1024; kreg0 = *(const u32x4*)(kbase + o_); vreg0 = *(const u32x4*)(vbase + o_); kreg1 = *(const u32x4*)(kbase + o_ + 64); vreg1 = *(const u32x4*)(vbase + o_ + 64); } while (0)
#define AB_STORE(jj) do { LAS unsigned char* bk_ = lds + ((jj) & 1) * AB_BUF + lrow * ATT_VP + lch * 16; LAS unsigned char* bv_ = lds + ((jj) & 1) * AB_BUF + 9216 + lrow * ATT_VVP + lch * 16; *(LAS u32x4*)bk_ = kreg0; *(LAS u32x4*)bv_ = vreg0; *(LAS u32x4*)(bk_ + AB_HB) = kreg1; *(LAS u32x4*)(bv_ + AB_HB) = vreg1; } while (0)
    AB_LOAD(j0); AB_STORE(j0);
    for (int j = j0; j < 10; ++j) {
        __syncthreads();
        if (j + 1 < 10) AB_LOAD(j + 1);
        const int t = j - csel;
        if (t >= 0 && t < 9) {
            LAS const unsigned char* kb = lds + (j & 1) * AB_BUF + hsel * AB_HB; LAS const unsigned char* vb = kb + 9216;
            f32x16 s0, s1;
#pragma unroll
            for (int r = 0; r < 16; ++r) { s0[r] = 0.f; s1[r] = 0.f; }
#pragma unroll
            for (int d0 = 0; d0 < 4; ++d0) {
                const bf16x8 k0 = *(const LAS bf16x8*)(kb + r32 * ATT_VP + (16 * d0 + 8 * hi) * 2), k1 = *(const LAS bf16x8*)(kb + (32 + r32) * ATT_VP + (16 * d0 + 8 * hi) * 2);
                s0 = __builtin_amdgcn_mfma_f32_32x32x16_bf16(k0, qfr[d0], s0, 0, 0, 0); s1 = __builtin_amdgcn_mfma_f32_32x32x16_bf16(k1, qfr[d0], s1, 0, 0, 0); }
            if (t < 6) {
#pragma unroll
                for (int r = 0; r < 16; ++r) { s0[r] += cb; s1[r] += cb; }
            } else {
                const int relb = 64 * (8 - t) + 32 * qh + r32 + 128;
#pragma unroll
                for (int r = 0; r < 16; ++r) { const int i0 = relb - crow(r, hi); s0[r] += btab[i0 > 256 ? 256 : i0]; const int i1 = i0 - 32; s1[r] += btab[i1 > 256 ? 256 : i1]; }
            }
            float tm = fmaxf(s0[0], s1[0]);
#pragma unroll
            for (int r = 1; r < 16; ++r) tm = fmaxf(tm, fmaxf(s0[r], s1[r]));
            tm = fmaxf(tm, __shfl_xor(tm, 32));
            const float mn = fmaxf(mrun, tm), sc = __expf(mrun - mn); mrun = mn;
            float ps = 0.f;
#pragma unroll
            for (int r = 0; r < 16; ++r) { s0[r] = __expf(s0[r] - mn); s1[r] = __expf(s1[r] - mn); ps += s0[r] + s1[r]; }
            lrun = lrun * sc + ps;
#pragma unroll
            for (int r = 0; r < 16; ++r) { oT[0][r] *= sc; oT[1][r] *= sc; }
            bf16x8 pf[4]; pf[0] = pack8(s0, 0); pf[1] = pack8(s0, 8); pf[2] = pack8(s1, 0); pf[3] = pack8(s1, 8);
#pragma unroll
            for (int dh = 0; dh < 2; ++dh)
#pragma unroll
                for (int kc = 0; kc < 4; ++kc) {
                    LAS const unsigned char* p = vb + traddr + (16 * kc) * ATT_VVP + dh * 64;
                    const bf16x8 vf = cat8(tr16(p), tr16(p + 8 * ATT_VVP));
                    oT[dh] = __builtin_amdgcn_mfma_f32_32x32x16_bf16(vf, pf[kc], oT[dh], 0, 0, 0);
                }
        }
        if (j + 1 < 10) AB_STORE(j + 1);
    }
#undef AB_LOAD
#undef AB_STORE
    {
        const float lt = lrun + __shfl_xor(lrun, 32), inv = 1.0f / lt;
        bf16* orow = OB + ((size_t)sb * 2048 + (size_t)c * 64 + 32 * qh + r32) * 1024 + hoff;
#pragma unroll
        for (int dh = 0; dh < 2; ++dh)
#pragma unroll
            for (int rg = 0; rg < 4; ++rg) { u32x2 wv; wv.x = pk2(oT[dh][4 * rg] * inv, oT[dh][4 * rg + 1] * inv); wv.y = pk2(oT[dh][4 * rg + 2] * inv, oT[dh][4 * rg + 3] * inv);
                *(u32x2*)(orow + 32 * dh + 8 * rg + 4 * hi) = wv; }
    }
}
template <int MODE> __device__ __forceinline__ void small_gemm_res(LAS unsigned char* lds, const bf16* A, const bf16* Bt, int K, const float* base, const bf16* baseb, float* H, bf16* XN, float* SS, float alpha, const bf16* GGs, int bx, int G, int tid) {
    const int lane = tid & 63, w = __builtin_amdgcn_readfirstlane(tid >> 6), r32 = lane & 31, hi = lane >> 5;
    const int kw = K >> 3;
    LAS float* P = (LAS float*)lds;
    for (int tile = bx; tile < 256; tile += G) {
        const int t0 = (tile >> 4) * 32, n0 = (tile & 15) * 64;
        f32x16 acc0, acc1;
#pragma unroll
        for (int r = 0; r < 16; ++r) { acc0[r] = 0.f; acc1[r] = 0.f; }
        const bf16* ap = A + (size_t)(t0 + r32) * K + w * kw + 8 * hi;
        const bf16* b0p = Bt + (size_t)(n0 + r32) * K + w * kw + 8 * hi; const bf16* b1p = b0p + (size_t)32 * K;
#pragma unroll 4
        for (int k = 0; k < kw; k += 16) {
            const bf16x8 x = *(const bf16x8*)(ap + k), w0 = *(const bf16x8*)(b0p + k), w1 = *(const bf16x8*)(b1p + k);
            acc0 = __builtin_amdgcn_mfma_f32_32x32x16_bf16(w0, x, acc0, 0, 0, 0); acc1 = __builtin_amdgcn_mfma_f32_32x32x16_bf16(w1, x, acc1, 0, 0, 0);
        }
        LAS float* Pw = P + w * 2112;
#pragma unroll
        for (int r = 0; r < 16; ++r) { Pw[crow(r, hi) * 33 + r32] = acc0[r]; Pw[(32 + crow(r, hi)) * 33 + r32] = acc1[r]; }
        __syncthreads();
        const int tok = tid >> 4, nq = tid & 15;
        float v[4] = {0.f, 0.f, 0.f, 0.f};
#pragma unroll
        for (int ww = 0; ww < 8; ++ww)
#pragma unroll
            for (int e = 0; e < 4; ++e) v[e] += P[ww * 2112 + (4 * nq + e) * 33 + tok];
        const size_t off = (size_t)(t0 + tok) * 1024 + n0 + 4 * nq;
        if (MODE == 0) {
            f32x4 b; if (baseb) { const u32x2 bw = *(const u32x2*)(baseb + off); b = (f32x4){bflo(bw.x), bfhi(bw.x), bflo(bw.y), bfhi(bw.y)}; } else b = *(const f32x4*)(base + off);
            const f32x4 hv = (f32x4){b[0] + alpha * v[0], b[1] + alpha * v[1], b[2] + alpha * v[2], b[3] + alpha * v[3]};
            if (H) *(f32x4*)(H + off) = hv;
            if (XN) { u32x2 xw; xw.x = pk2(hv[0], hv[1]); xw.y = pk2(hv[2], hv[3]); *(u32x2*)(XN + off) = xw; }
            if (SS) { float ss = (hv[0] * hv[0] + hv[1] * hv[1]) + (hv[2] * hv[2] + hv[3] * hv[3]);
                ss += __shfl_xor(ss, 1); ss += __shfl_xor(ss, 2); ss += __shfl_xor(ss, 4); ss += __shfl_xor(ss, 8);
                if (nq == 0) SS[(size_t)(t0 + tok) * 16 + (n0 >> 6)] = ss; }
        } else {
            const u32x2 gw = *(const u32x2*)(GGs + (size_t)(t0 + tok) * 2048 + n0 + 4 * nq);
            f32x4 o = (f32x4){pg8::fast_sigmoid(bflo(gw.x)) * v[0], pg8::fast_sigmoid(bfhi(gw.x)) * v[1], pg8::fast_sigmoid(bflo(gw.y)) * v[2], pg8::fast_sigmoid(bfhi(gw.y)) * v[3]};
            if (MODE == 1) { u32x2 xw; xw.x = pk2(o[0], o[1]); xw.y = pk2(o[2], o[3]); *(u32x2*)(XN + off) = xw; }
            else { const u32x2 tw = *(const u32x2*)(baseb + off); o += (f32x4){bflo(tw.x), bfhi(tw.x), bflo(tw.y), bfhi(tw.y)};
                u32x2 xw; xw.x = pk2(o[0], o[1]); xw.y = pk2(o[2], o[3]); *(u32x2*)(XN + off) = xw; }
        }
        __syncthreads();
    }
}
constexpr int G_QD = 0, G_KI = 17408, G_VV = 34816, G_B = 71680, G_FA = 105472, G_SEG = 109568, G_SSQ = 111616;
constexpr int GP = 272, GVP = 576, GBP = 132;
constexpr size_t WS_DECB = (size_t)1056 * 65536;
__device__ __forceinline__ bf16* ub_slot(unsigned char* ybase, int unit, int) { return (bf16*)ybase + (size_t)unit * 32768; }
__device__ __forceinline__ void gla_a_unit(LAS unsigned char* lds, bf16* QKA, bf16* VA, const float* FA, unsigned char* ws, int xnrow0, float* DECB, int lchunk, int h,
                                           const float* wgate, const float* bgate, int tid) {
    const int lane = tid & 63, w = __builtin_amdgcn_readfirstlane(tid >> 6), r32 = lane & 31, hi = lane >> 5, g16 = lane >> 4, i16 = lane & 15;
    const int gd = tid & 127, tq = tid >> 7;
    LAS float* Bimg = (LAS float*)(lds + G_B); LAS float* FAi = (LAS float*)(lds + G_FA); LAS float* SEG = (LAS float*)(lds + G_SEG);
    const int trrow = (g16 >> 1) * 4 + (i16 >> 2), trcol = (g16 & 1) * 16 + (i16 & 3) * 4;
    const size_t row0 = (size_t)lchunk * 64; const int unit = lchunk * 4 + h;
    u32x4 qv[2], kv[2];
#pragma unroll
    for (int i = 0; i < 2; ++i) { const int id = tid + 512 * i, row = id >> 4, ch = id & 15; const bf16* p = QKA + (row0 + row) * 1024 + h * 128 + ch * 8; qv[i] = *(const u32x4*)p; kv[i] = *(const u32x4*)(p + 512); }
    if (tid < 256) *(LAS f32x4*)(FAi + tid * 4) = *(const f32x4*)(FA + row0 * 16 + tid * 4);
#pragma unroll
    for (int i = 0; i < 4; ++i) { const int id = tid + 512 * i, row = id >> 5, ch = id & 31; *(LAS u32x4*)(lds + G_VV + row * GVP + ch * 16) = *(const u32x4*)(VA + (row0 + row) * 1024 + h * 256 + ch * 8); }
    __syncthreads();
    {
        float wg[16];
#pragma unroll
        for (int r = 0; r < 16; ++r) wg[r] = wgate[r * 512 + h * 128 + gd];
        const float bg = bgate[h * 128 + gd];
        float run = 0.f;
#pragma unroll
        for (int tt = 0; tt < 16; ++tt) { const int t = tq * 16 + tt; const LAS f32x4* fp = (const LAS f32x4*)(FAi + t * 16); float x = bg;
#pragma unroll
            for (int q = 0; q < 4; ++q) { const f32x4 f = fp[q]; x += f[0] * wg[4 * q] + f[1] * wg[4 * q + 1] + f[2] * wg[4 * q + 2] + f[3] * wg[4 * q + 3]; }
            const float ls = fminf(x, 0.f) - __logf(1.0f + __expf(-fabsf(x))); run += ls * 0.0625f; Bimg[t * GBP + gd] = run;
            if ((tt & 3) == 3) asm volatile("" ::: "memory"); }
        SEG[tq * 128 + gd] = run;
    }
    __syncthreads();
#pragma unroll
    for (int i = 0; i < 2; ++i) { const int id = tid + 512 * i, row = id >> 4, ch = id & 15;
        f32x4 b0 = *(const LAS f32x4*)(Bimg + row * GBP + ch * 8), b1 = *(const LAS f32x4*)(Bimg + row * GBP + ch * 8 + 4);
        f32x4 l0 = (f32x4){0.f, 0.f, 0.f, 0.f}, l1 = l0;
#pragma unroll
        for (int q = 0; q < 4; ++q) { const f32x4 s0v = *(const LAS f32x4*)(SEG + q * 128 + ch * 8), s1v = *(const LAS f32x4*)(SEG + q * 128 + ch * 8 + 4);
            l0 += s0v; l1 += s1v; if (q < (row >> 4)) { b0 += s0v; b1 += s1v; } }
        if (row == 0) { float* dp = DECB + (size_t)unit * 128 + ch * 8;
            *(f32x4*)dp = (f32x4){__expf(l0[0]), __expf(l0[1]), __expf(l0[2]), __expf(l0[3])}; *(f32x4*)(dp + 4) = (f32x4){__expf(l1[0]), __expf(l1[1]), __expf(l1[2]), __expf(l1[3])}; }
        const float bb[8] = {b0[0], b0[1], b0[2], b0[3], b1[0], b1[1], b1[2], b1[3]};
        const unsigned qw[4] = {qv[i].x, qv[i].y, qv[i].z, qv[i].w}, kw[4] = {kv[i].x, kv[i].y, kv[i].z, kv[i].w};
        unsigned oq[4], oi[4];
#pragma unroll
        for (int e = 0; e < 4; ++e) { const float q0 = bflo(qw[e]), q1 = bfhi(qw[e]), k0 = bflo(kw[e]), k1 = bfhi(kw[e]);
            const float e0 = __expf(bb[2 * e]), e1 = __expf(bb[2 * e + 1]), n0 = __expf(-bb[2 * e]), n1 = __expf(-bb[2 * e + 1]);
            oq[e] = pk2(q0 * e0, q1 * e1); oi[e] = pk2(k0 * n0, k1 * n1); }
        const u32x4 qd = (u32x4){oq[0], oq[1], oq[2], oq[3]};
        *(LAS u32x4*)(lds + G_QD + row * GP + ch * 16) = qd;
        *(LAS u32x4*)(lds + G_KI + row * GP + ch * 16) = (u32x4){oi[0], oi[1], oi[2], oi[3]};
        *(u32x4*)(QKA + (row0 + row) * 1024 + h * 128 + ch * 8) = qd; }
    __syncthreads();
    bf16x8 vvf[4];
#pragma unroll
    for (int kc = 0; kc < 4; ++kc) { LAS const unsigned char* p = lds + G_VV + (16 * kc + trrow) * GVP + (32 * w + trcol) * 2; vvf[kc] = cat8(tr16(p), tr16(p + 8 * GVP)); }
    f32x16 s00, s01, s11;
#pragma unroll
    for (int r = 0; r < 16; ++r) { s00[r] = 0.f; s01[r] = 0.f; s11[r] = 0.f; }
#pragma unroll
    for (int s = 0; s < 8; ++s) {
        const bf16x8 a0 = *(const LAS bf16x8*)(lds + G_KI + r32 * GP + (16 * s + 8 * hi) * 2), a1 = *(const LAS bf16x8*)(lds + G_KI + (32 + r32) * GP + (16 * s + 8 * hi) * 2);
        const bf16x8 b0 = *(const LAS bf16x8*)(lds + G_QD + r32 * GP + (16 * s + 8 * hi) * 2), b1 = *(const LAS bf16x8*)(lds + G_QD + (32 + r32) * GP + (16 * s + 8 * hi) * 2);
        s00 = __builtin_amdgcn_mfma_f32_32x32x16_bf16(a0, b0, s00, 0, 0, 0); s01 = __builtin_amdgcn_mfma_f32_32x32x16_bf16(a0, b1, s01, 0, 0, 0); s11 = __builtin_amdgcn_mfma_f32_32x32x16_bf16(a1, b1, s11, 0, 0, 0);
    }
#pragma unroll
    for (int r = 0; r < 16; ++r) if (crow(r, hi) > r32) { s00[r] = 0.f; s11[r] = 0.f; }
    const bf16x8 p00a = pack8(s00, 0), p00b = pack8(s00, 8), p01a = pack8(s01, 0), p01b = pack8(s01, 8), p11a = pack8(s11, 0), p11b = pack8(s11, 8);
    f32x16 oT0, oT1;
#pragma unroll
    for (int r = 0; r < 16; ++r) { oT0[r] = 0.f; oT1[r] = 0.f; }
    oT0 = __builtin_amdgcn_mfma_f32_32x32x16_bf16(vvf[0], p00a, oT0, 0, 0, 0); oT0 = __builtin_amdgcn_mfma_f32_32x32x16_bf16(vvf[1], p00b, oT0, 0, 0, 0);
    oT1 = __builtin_amdgcn_mfma_f32_32x32x16_bf16(vvf[0], p01a, oT1, 0, 0, 0); oT1 = __builtin_amdgcn_mfma_f32_32x32x16_bf16(vvf[1], p01b, oT1, 0, 0, 0);
    oT1 = __builtin_amdgcn_mfma_f32_32x32x16_bf16(vvf[2], p11a, oT1, 0, 0, 0); oT1 = __builtin_amdgcn_mfma_f32_32x32x16_bf16(vvf[3], p11b, oT1, 0, 0, 0);
    { bf16* p0 = VA + (row0 + (2 * w) * 4 + g16) * 1024 + h * 256 + i16 * 16; bf16* p1 = p0 + 4 * 1024;
      *(u32x4*)p0 = __builtin_bit_cast(u32x4, pack8(oT0, 0)); *(u32x4*)(p0 + 8) = __builtin_bit_cast(u32x4, pack8(oT0, 8));
      *(u32x4*)p1 = __builtin_bit_cast(u32x4, pack8(oT1, 0)); *(u32x4*)(p1 + 8) = __builtin_bit_cast(u32x4, pack8(oT1, 8)); }
    bf16* up = ub_slot(ws, unit, xnrow0) + (size_t)w * 4096 + lane * 8;
#pragma unroll
    for (int db = 0; db < 4; ++db) { f32x16 uacc;
#pragma unroll
        for (int r = 0; r < 16; ++r) uacc[r] = 0.f;
#pragma unroll
        for (int kc = 0; kc < 4; ++kc) { LAS const unsigned char* p = lds + G_KI + (16 * kc + trrow) * GP + (32 * db + trcol) * 2;
            uacc = __builtin_amdgcn_mfma_f32_32x32x16_bf16(cat8(tr16(p), tr16(p + 8 * GP)), vvf[kc], uacc, 0, 0, 0); }
        *(u32x4*)(up + (db * 2) * 512) = __builtin_bit_cast(u32x4, pack8(uacc, 0)); *(u32x4*)(up + (db * 2 + 1) * 512) = __builtin_bit_cast(u32x4, pack8(uacc, 8)); }
    __syncthreads();
}

__device__ __forceinline__ void gla_scan_vec(unsigned char* ws, int xnrow0, const float* DECB, int lchunk0, int nchunks, int h, int e, const float* s0, float* sout) {
    const int lane = e & 63, s2 = (e >> 6) & 1, db = (e >> 7) & 3, w = e >> 9, hi = lane >> 5, r32 = lane & 31;
    const int dbase = 32 * db + 16 * s2 + 4 * hi, v = 32 * w + r32;
    float S[8];
#pragma unroll
    for (int jj = 0; jj < 8; ++jj) S[jj] = s0 ? s0[(size_t)(dbase + 8 * (jj >> 2) + (jj & 3)) * 256 + v] : 0.f;
    for (int n0 = 0; n0 < nchunks; n0 += 4) {
        u32x4 uw[4]; f32x4 d0[4], d1[4]; bf16* up[4];
#pragma unroll
        for (int q = 0; q < 4; ++q) { const int n = (n0 + q < nchunks) ? n0 + q : nchunks - 1; const int unit = (lchunk0 + n) * 4 + h;
            up[q] = ub_slot(ws, unit, xnrow0) + (size_t)e * 8; uw[q] = *(const u32x4*)up[q];
            d0[q] = *(const f32x4*)(DECB + (size_t)unit * 128 + dbase); d1[q] = *(const f32x4*)(DECB + (size_t)unit * 128 + dbase + 8); }
#pragma unroll
        for (int q = 0; q < 4; ++q) if (n0 + q < nchunks) {
            *(u32x4*)up[q] = (u32x4){pk2(S[0], S[1]), pk2(S[2], S[3]), pk2(S[4], S[5]), pk2(S[6], S[7])};
            S[0] = d0[q][0] * (S[0] + bflo(uw[q].x)); S[1] = d0[q][1] * (S[1] + bfhi(uw[q].x)); S[2] = d0[q][2] * (S[2] + bflo(uw[q].y)); S[3] = d0[q][3] * (S[3] + bfhi(uw[q].y));
            S[4] = d1[q][0] * (S[4] + bflo(uw[q].z)); S[5] = d1[q][1] * (S[5] + bfhi(uw[q].z)); S[6] = d1[q][2] * (S[6] + bflo(uw[q].w)); S[7] = d1[q][3] * (S[7] + bfhi(uw[q].w)); }
    }
#pragma unroll
    for (int jj = 0; jj < 8; ++jj) sout[(size_t)(dbase + 8 * (jj >> 2) + (jj & 3)) * 256 + v] = S[jj];
}

__device__ __forceinline__ void gla_c_unit(LAS unsigned char* lds, const bf16* QKA, const bf16* VA, const bf16* RA, unsigned char* ws, int xnrow0, bf16* OA, int lchunk, int h, const float* gnorm, int tid) {
    const int lane = tid & 63, w = __builtin_amdgcn_readfirstlane(tid >> 6), r32 = lane & 31, hi = lane >> 5, g16 = lane >> 4, i16 = lane & 15;
    LAS float* SSQ = (LAS float*)(lds + G_SSQ);
    const size_t row0 = (size_t)lchunk * 64; const int unit = lchunk * 4 + h;
#pragma unroll
    for (int i = 0; i < 2; ++i) { const int id = tid + 512 * i, row = id >> 4, ch = id & 15; *(LAS u32x4*)(lds + G_QD + row * GP + ch * 16) = *(const u32x4*)(QKA + (row0 + row) * 1024 + h * 128 + ch * 8); }
    bf16x8 sf[8];
    { const bf16* up = ub_slot(ws, unit, xnrow0) + (size_t)w * 4096 + lane * 8;
#pragma unroll
      for (int f = 0; f < 8; ++f) sf[f] = *(const bf16x8*)(up + f * 512); }
    u32x2 rwv[2][4];
#pragma unroll
    for (int ib = 0; ib < 2; ++ib)
#pragma unroll
        for (int rg = 0; rg < 4; ++rg) rwv[ib][rg] = *(const u32x2*)(RA + (row0 + 32 * ib + r32) * 1024 + h * 256 + 32 * w + 4 * hi + 8 * rg);
    f32x16 oT0, oT1;
    { const bf16* p0 = VA + (row0 + (2 * w) * 4 + g16) * 1024 + h * 256 + i16 * 16; const bf16* p1 = p0 + 4 * 1024;
      const u32x4 a0 = *(const u32x4*)p0, a1 = *(const u32x4*)(p0 + 8), c0 = *(const u32x4*)p1, c1 = *(const u32x4*)(p1 + 8);
      const unsigned aw[8] = {a0.x, a0.y, a0.z, a0.w, a1.x, a1.y, a1.z, a1.w}, cw[8] = {c0.x, c0.y, c0.z, c0.w, c1.x, c1.y, c1.z, c1.w};
#pragma unroll
      for (int q = 0; q < 8; ++q) { oT0[2 * q] = bflo(aw[q]); oT0[2 * q + 1] = bfhi(aw[q]); oT1[2 * q] = bflo(cw[q]); oT1[2 * q + 1] = bfhi(cw[q]); } }
    __syncthreads();
#pragma unroll
    for (int db = 0; db < 4; ++db)
#pragma unroll
        for (int s2 = 0; s2 < 2; ++s2) { const int dcol = (32 * db + 16 * s2 + 4 * hi) * 2;
            LAS const unsigned char* p0 = lds + G_QD + r32 * GP + dcol; LAS const unsigned char* p1 = lds + G_QD + (32 + r32) * GP + dcol;
            const bf16x8 qb0 = cat8(*(const LAS s16x4*)p0, *(const LAS s16x4*)(p0 + 16)), qb1 = cat8(*(const LAS s16x4*)p1, *(const LAS s16x4*)(p1 + 16));
            oT0 = __builtin_amdgcn_mfma_f32_32x32x16_bf16(sf[db * 2 + s2], qb0, oT0, 0, 0, 0); oT1 = __builtin_amdgcn_mfma_f32_32x32x16_bf16(sf[db * 2 + s2], qb1, oT1, 0, 0, 0); }
    float ss0 = 0.f, ss1 = 0.f;
#pragma unroll
    for (int r = 0; r < 16; ++r) { ss0 += oT0[r] * oT0[r]; ss1 += oT1[r] * oT1[r]; }
    ss0 += __shfl_xor(ss0, 32); ss1 += __shfl_xor(ss1, 32);
    if (hi == 0) { SSQ[w * 64 + r32] = ss0; SSQ[w * 64 + 32 + r32] = ss1; }
    __syncthreads();
    f32x4 gnv[4];
#pragma unroll
    for (int rg = 0; rg < 4; ++rg) gnv[rg] = *(const f32x4*)(gnorm + h * 256 + 32 * w + 8 * rg + 4 * hi);
    float t0 = 0.f, t1 = 0.f;
#pragma unroll
    for (int q = 0; q < 8; ++q) { t0 += SSQ[q * 64 + r32]; t1 += SSQ[q * 64 + 32 + r32]; }
    const float rs0 = rsqrtf(t0 * (1.f / 256.f) + 1e-6f), rs1 = rsqrtf(t1 * (1.f / 256.f) + 1e-6f);
#pragma unroll
    for (int ib = 0; ib < 2; ++ib) { int rr = 32 * ib + r32; asm volatile("" : "+v"(rr)); const size_t rowoff = (row0 + rr) * 1024 + h * 256 + 32 * w + 4 * hi; const float rs = ib ? rs1 : rs0;
#pragma unroll
        for (int rg = 0; rg < 4; ++rg) { const u32x2 rw = rwv[ib][rg];
            const float r0 = bflo(rw.x), r1 = bfhi(rw.x), r2 = bflo(rw.y), r3 = bfhi(rw.y);
            const float o0 = (ib ? oT1[4 * rg] : oT0[4 * rg]) * rs * gnv[rg][0] * r0 * pg8::fast_sigmoid(r0), o1 = (ib ? oT1[4 * rg + 1] : oT0[4 * rg + 1]) * rs * gnv[rg][1] * r1 * pg8::fast_sigmoid(r1);
            const float o2 = (ib ? oT1[4 * rg + 2] : oT0[4 * rg + 2]) * rs * gnv[rg][2] * r2 * pg8::fast_sigmoid(r2), o3 = (ib ? oT1[4 * rg + 3] : oT0[4 * rg + 3]) * rs * gnv[rg][3] * r3 * pg8::fast_sigmoid(r3);
            u32x2 ow; ow.x = pk2(o0, o1); ow.y = pk2(o2, o3); *(u32x2*)(OA + rowoff + 8 * rg) = ow; } }
}
__global__ void __launch_bounds__(NTHREADS, 2) fwd_megakernel(Args a) {
    extern __shared__ __attribute__((aligned(16))) unsigned char lds_raw[];
    LAS unsigned char* lds = (LAS unsigned char*)lds_raw;
    cg::grid_group grid = cg::this_grid();
    const int G = gridDim.x, bx = blockIdx.x;
    const int wave0 = __builtin_amdgcn_readfirstlane((int)threadIdx.x >> 6);
#define MK_TID() (wave0 * 64 + (int)__builtin_amdgcn_mbcnt_hi(~0u, __builtin_amdgcn_mbcnt_lo(~0u, 0u)))
    volatile LAS unsigned* xst = (volatile LAS unsigned*)(lds + XST_OFF);
    if (threadIdx.x < 4) xst[threadIdx.x] = 0u;
    __syncthreads();
    (void)xcd_barrier_post((unsigned*)(a.ws + WS_CTL), xst);
    unsigned char* ws = (unsigned char*)(GASP unsigned char*)a.ws; float* out = (float*)(GASP float*)a.out;
#define RELOAD_PTRS() do { size_t z_ = 0; asm volatile("" : "+s"(z_)); ws = (unsigned char*)((GASP unsigned char*)a.ws + z_); out = (float*)((GASP float*)a.out + z_); } while (0)
#define GRID_SYNC() do { XcdBarrier b_; b_.bar = (unsigned*)(ws + WS_CTL); b_.x = xb_xcc_id(); b_.st = (volatile LAS unsigned*)(lds + XST_OFF); xcd_barrier(b_, MK_TID() == 0); RELOAD_PTRS(); } while (0)
#define GRID_SYNC_CG() do { grid.sync(); GRID_SYNC(); } while (0)
#define LAUNDER_TID() int tid = MK_TID(); asm volatile("" : "+v"(tid)); const int lane = tid & 63, wave = __builtin_amdgcn_readfirstlane(tid >> 6)
#define W1T ((bf16*)(ws + WS_W1T))
#define W1OT ((bf16*)(ws + WS_W1OT))
#define WINT ((bf16*)(ws + WS_WINT))
#define WBGT ((bf16*)(ws + WS_WBGT))
#define WBAT ((bf16*)(ws + WS_WBAT))
#define WOUTT ((bf16*)(ws + WS_WOUTT))
#define W2T ((bf16*)(ws + WS_W2T))
#define W2OT ((bf16*)(ws + WS_W2OT))
#define CKB ((bf16*)(ws + WS_CKB))
#define CVB ((bf16*)(ws + WS_CVB))
#define XN ((bf16*)(ws + WS_XN))
#define SS1 ((float*)(ws + WS_SS1))
#define SS2 ((float*)(ws + WS_SS2))
#define ACT ((bf16*)(ws + WS_ACT))
#define PB ((bf16*)(ws + WS_PB))
#define GG ((bf16*)(ws + WS_GG))
#define FA ((float*)(ws + WS_FA))
#define OA ((bf16*)(ws + WS_OA))
#define OB ((bf16*)(ws + WS_OB))
#define TMP ((bf16*)(ws + WS_TMP))
#define MIX ((bf16*)((unsigned char*)(out + O_Y) + (size_t)75497472))
#define H (out + O_Y)
    constexpr size_t PBE = PBS / 2;

#ifndef REP_P0
#define REP_P0 1
#endif
    for (int rp0 = 0; rp0 < REP_P0; ++rp0) {
        LAUNDER_TID();
        const int gw = bx * NWAVES + wave, NGW = G * NWAVES;
        for (int it = bx; it < 16 * 22; it += G) transpose_tile_block(1, AIN(6), 5632, 1024, 5632, W1T, AIN(5), it, lds, tid);
        __syncthreads();
        for (int m4 = gw; m4 < T_ALL / 4; m4 += NGW) { const int m = 4 * m4;
            const float* xr = (m < T_P) ? AIN(0) + (size_t)m * 1024 : AIN(1) + (size_t)(m - T_P) * 1024;
            rms_rows4_to_bf16(xr, XN + (size_t)m * 1024, lane); }
    }
    GRID_SYNC();
#ifndef REP_P1
#define REP_P1 1
#endif
    for (int rep1 = 0; rep1 < REP_P1; ++rep1) {
      if (rep1) { GRID_SYNC(); }
 pg8::Gemm g{XN, W1T, T_ALL, 5632, 1024}; pg8::StaticOrder S; S.init(T_ALL, 5632, G, bx); pg8::EpiSwiglu E{ACT, nullptr};
      pg8::gemm_phase<pg8::EpiSwiglu, pg8::StaticOrder, true, true>(lds, g, S, E, MK_TID()); }
    {
        LAUNDER_TID();
        const int nwg = (T_ALL / 256) * 22, rounds = (nwg + G - 1) / G, first_idle = nwg - (rounds - 1) * G;
        const bool all = (first_idle >= G); const int ib = all ? bx : bx - first_idle, nib = all ? G : G - first_idle;
        if (ib >= 0) {
            constexpr int I1 = 44 * 4, I2 = 16 * 33, I3 = 16 * 4, I6 = 16 * 22, I7 = I1, NDEF = I1 + I2 + 3 * I3 + I6 + I7;
            for (int it = ib; it < NDEF; it += nib) {
                int r = it;
                if (r < I1) { transpose_tile_block(0, AIN(7), 1024, 2816, 1024, W1OT, nullptr, r, lds, tid); continue; } r -= I1;
                if (r < I2) { transpose_tile_block(2, AIN(9), NPROJ_SRC, 1024, NPROJ, WINT, AIN(8), r, lds, tid); continue; } r -= I2;
                if (r < I3) { transpose_tile_block(0, AIN(14), 1024, 1024, 1024, WBGT, nullptr, r, lds, tid); continue; } r -= I3;
                if (r < I3) { transpose_tile_block(0, AIN(15), 1024, 1024, 1024, WBAT, nullptr, r, lds, tid); continue; } r -= I3;
                if (r < I3) { transpose_tile_block(0, AIN(16), 1024, 1024, 1024, WOUTT, nullptr, r, lds, tid); continue; } r -= I3;
                if (r < I6) { transpose_tile_block(1, AIN(18), 5632, 1024, 5632, W2T, AIN(17), r, lds, tid); continue; } r -= I6;
                transpose_tile_block(0, AIN(19), 1024, 2816, 1024, W2OT, nullptr, r, lds, tid);
            }
            const size_t nvec = (size_t)8 * 512 * 1024 / 8;
            for (size_t v = (size_t)ib * NTHREADS + tid; v < nvec; v += (size_t)nib * NTHREADS) {
                const f32x4 k0 = *(const f32x4*)(AIN(2) + v * 8), k1 = *(const f32x4*)(AIN(2) + v * 8 + 4), v0 = *(const f32x4*)(AIN(3) + v * 8), v1 = *(const f32x4*)(AIN(3) + v * 8 + 4);
                *(u32x4*)(CKB + v * 8) = (u32x4){pk2(k0[0], k0[1]), pk2(k0[2], k0[3]), pk2(k1[0], k1[1]), pk2(k1[2], k1[3])};
                *(u32x4*)(CVB + v * 8) = (u32x4){pk2(v0[0], v0[1]), pk2(v0[2], v0[3]), pk2(v1[0], v1[1]), pk2(v1[2], v1[3])};
            }
        }
    }
    GRID_SYNC();
#ifndef REP_P2
#define REP_P2 1
#endif
    for (int rp2 = 0; rp2 < REP_P2; ++rp2)
    { pg8::Gemm g{ACT, W1OT, T_P, 1024, 2816}; pg8::StaticOrder S; S.init(T_P, 1024, G, bx); pg8::EpiRes E{AIN(0), AIN(1), 128, nullptr, nullptr, XN, SS1, 0.5f};
      pg8::gemm_phase<pg8::EpiRes, pg8::StaticOrder, true, true>(lds, g, S, E, MK_TID()); }
    { LAUNDER_TID(); (void)lane; (void)wave; small_gemm_res<0>(lds, ACT + (size_t)T_P * DFF, W1OT, DFF, AIN(1), nullptr, nullptr, XN + (size_t)T_P * 1024, SS1 + (size_t)T_P * 16, 0.5f, nullptr, bx, G, tid); }
    GRID_SYNC();
    for (int grp = 0; grp < 2; ++grp) {
        const int row0 = grp ? 16384 : 0, Mg = grp ? 16896 : 16384;
#ifndef REP_P3
#define REP_P3 1
#endif
        for (int rp3 = 0; rp3 < REP_P3; ++rp3)
        { pg8::Gemm g{XN + (size_t)row0 * 1024, WINT, Mg, NPROJ, 1024}; pg8::StaticOrder S; S.init(Mg, NPROJ, G, bx);
          pg8::EpiProj E{PB, PBE, GG, FA, SS1 + (size_t)row0 * 16, out + O_KP, out + O_VP, out + O_KS, out + O_VS, row0};
          pg8::gemm_phase<pg8::EpiProj, pg8::StaticOrder, true, true>(lds, g, S, E, MK_TID()); }
        GRID_SYNC();
        {
            LAUNDER_TID();
            const bf16* QB = PB + 3 * PBE; const bf16* KB = PB + 4 * PBE; const bf16* VB = PB + 5 * PBE;
            LAS unsigned char* wl = lds + wave * ATT_WLDS;
            const int nbu = 1024 + (grp ? 32 : 0);
#ifndef REP_ATT
#define REP_ATT 1
#endif
            for (int ra_ = 0; ra_ < REP_ATT; ++ra_)
            for (int bu = bx; bu < nbu; bu += G) {
                int lrow, h, t0, qh; bool sample = false; const bf16 *ck = CKB, *cv = CVB;
                if (bu < 1024) {
                    const int sb = bu & 7, j = bu >> 3, hp = (j >> 4) & 7, cp = ((j & 15) + 4 * (j >> 5)) & 15; attn_block_unit(lds, QB, OB, KB, VB, sb, hp, cp, AIN(13), tid); continue; }
                __syncthreads();
                { const int su = (bu - 1024) * 8 + wave, sbh = su >> 1, sb = sbh >> 4; h = sbh & 15; qh = su & 1; lrow = 16384 + sb * 64; t0 = 0; sample = true; ck = CKB + (size_t)sb * 512 * 1024 + h * 64; cv = CVB + (size_t)sb * 512 * 1024 + h * 64; }
                const size_t off = (size_t)lrow * 1024 + h * 64;
                if (qh) attn_unit(wl, QB + off, OB + off, KB + off, VB + off, ck, cv, sample, t0, AIN(13) + h * 257, lane, 1);
                else attn_unit(wl, QB + off, OB + off, KB + off, VB + off, ck, cv, sample, t0, AIN(13) + h * 257, lane, 0);
            }
        }
        {
            LAUNDER_TID();
            __syncthreads();
            const int nun = (grp ? 264 : 256) * 4;
            for (int u = G - 1 - bx; u < nun; u += G) gla_a_unit(lds, PB, PB + PBE, FA, (unsigned char*)H, row0, (float*)((unsigned char*)H + WS_DECB), u >> 2, u & 3, AIN(10), AIN(11), tid);
        }
        GRID_SYNC();
        {
            LAUNDER_TID();
            const int gt = bx * NTHREADS + tid, nthr = G * NTHREADS;
            for (int v = gt; v < 32 * 4096; v += nthr) { const int pair = v >> 12, e = v & 4095, sb = pair >> 2, h = pair & 3;
                gla_scan_vec((unsigned char*)H, row0, (const float*)((unsigned char*)H + WS_DECB), sb * 32, 32, h, e, nullptr, out + O_GP + (size_t)((8 * grp + sb) * 4 + h) * 32768); }
            if (grp) for (int v = gt; v < 32 * 4096; v += nthr) { const int pair = v >> 12, e = v & 4095, sb = pair >> 2, h = pair & 3;
                gla_scan_vec((unsigned char*)H, row0, (const float*)((unsigned char*)H + WS_DECB), 256 + sb, 1, h, e, AIN(4) + (size_t)(sb * 4 + h) * 32768, out + O_GS + (size_t)(sb * 4 + h) * 32768); }
        }
        GRID_SYNC();
        {
            LAUNDER_TID();
            const int nun = (grp ? 264 : 256) * 4;
#ifndef REP_C
#define REP_C 1
#endif
            for (int rc_ = 0; rc_ < REP_C; ++rc_)
            for (int u = bx; u < nun; u += G) gla_c_unit(lds, PB, PB + PBE, PB + 2 * PBE, (unsigned char*)H, row0, OA, u >> 2, u & 3, AIN(12), tid);
        }
        GRID_SYNC();
        { pg8::Gemm g{OA, WBGT, 16384, 1024, 1024}; pg8::StaticOrder S; S.init(16384, 1024, G, bx); pg8::EpiGate<0> E{GG, 0, TMP, MIX};
          pg8::gemm_phase<pg8::EpiGate<0>, pg8::StaticOrder, true, true>(lds, g, S, E, MK_TID()); }
        if (grp) { LAUNDER_TID(); (void)lane; (void)wave; small_gemm_res<1>(lds, OA + (size_t)16384 * 1024, WBGT, 1024, nullptr, nullptr, nullptr, TMP + (size_t)16384 * 1024, nullptr, 0.f, GG + (size_t)16384 * 2048, bx, G, tid); }
        { pg8::Gemm g{OB, WBAT, 16384, 1024, 1024}; pg8::StaticOrder S; S.init(16384, 1024, G, bx); pg8::EpiGate<1> E{GG, 1024, TMP, MIX};
          pg8::gemm_phase<pg8::EpiGate<1>, pg8::StaticOrder, true, true>(lds, g, S, E, MK_TID()); }
        if (grp) { LAUNDER_TID(); (void)lane; (void)wave; small_gemm_res<2>(lds, OB + (size_t)16384 * 1024, WBAT, 1024, nullptr, TMP + (size_t)16384 * 1024, nullptr, MIX + (size_t)16384 * 1024, nullptr, 0.f, GG + (size_t)16384 * 2048 + 1024, bx, G, tid); }
        GRID_SYNC();
        { pg8::Gemm g{MIX, WOUTT, 16384, 1024, 1024}; pg8::StaticOrder S; S.init(16384, 1024, G, bx);
          pg8::EpiRes E{nullptr, nullptr, 1 << 30, XN + (size_t)row0 * 1024, nullptr, XN + (size_t)row0 * 1024, SS2 + (size_t)row0 * 16, 1.0f};
          pg8::gemm_phase<pg8::EpiRes, pg8::StaticOrder, true, true>(lds, g, S, E, MK_TID()); }
        if (grp) { LAUNDER_TID(); (void)lane; (void)wave; small_gemm_res<0>(lds, MIX + (size_t)16384 * 1024, WOUTT, 1024, nullptr, XN + (size_t)T_P * 1024, nullptr, XN + (size_t)T_P * 1024, SS2 + (size_t)T_P * 16, 1.0f, nullptr, bx, G, tid); }
        if (grp == 1) GRID_SYNC();
    }
    { pg8::Gemm g{XN, W2T, T_ALL, 5632, 1024}; pg8::StaticOrder S; S.init(T_ALL, 5632, G, bx); pg8::EpiSwiglu E{ACT, SS2};
      pg8::gemm_phase<pg8::EpiSwiglu, pg8::StaticOrder, true, true>(lds, g, S, E, MK_TID()); }
    GRID_SYNC_CG();
    { pg8::Gemm g{ACT, W2OT, T_P, 1024, 2816}; pg8::StaticOrder S; S.init(T_P, 1024, G, bx); pg8::EpiRes E{nullptr, nullptr, 1 << 30, XN, nullptr, XN, nullptr, 0.5f};
      pg8::gemm_phase<pg8::EpiRes, pg8::StaticOrder, true, true>(lds, g, S, E, MK_TID()); }
    { LAUNDER_TID(); (void)lane; (void)wave; small_gemm_res<0>(lds, ACT + (size_t)T_P * DFF, W2OT, DFF, nullptr, XN + (size_t)T_P * 1024, nullptr, XN + (size_t)T_P * 1024, nullptr, 0.5f, nullptr, bx, G, tid); }
    GRID_SYNC();
    {
        LAUNDER_TID();
        const int gw = bx * NWAVES + wave, NGW = G * NWAVES; const f32x4* gf = (const f32x4*)AIN(20) + lane;
        f32x4 gv[4];
#pragma unroll
        for (int j = 0; j < 4; ++j) gv[j] = gf[64 * j];
        for (int m4 = gw; m4 < T_ALL / 4; m4 += NGW) { f32x4* xr = (f32x4*)(H + (size_t)m4 * 4096) + lane; const u32x2* hb = (const u32x2*)(XN + (size_t)m4 * 4096) + lane; f32x4 v[4][4]; float s[4];
#pragma unroll
            for (int q = 0; q < 4; ++q)
#pragma unroll
                for (int j = 0; j < 4; ++j) { const u32x2 w = hb[q * 256 + 64 * j]; v[q][j] = (f32x4){bflo(w.x), bfhi(w.x), bflo(w.y), bfhi(w.y)}; }
#pragma unroll
            for (int q = 0; q < 4; ++q) { s[q] = 0.f;
#pragma unroll
                for (int j = 0; j < 4; ++j) s[q] += (v[q][j].x * v[q][j].x + v[q][j].y * v[q][j].y) + (v[q][j].z * v[q][j].z + v[q][j].w * v[q][j].w); }
#pragma unroll
            for (int o = 1; o < 64; o <<= 1) {
#pragma unroll
                for (int q = 0; q < 4; ++q) s[q] += __shfl_xor(s[q], o); }
#pragma unroll
            for (int q = 0; q < 4; ++q) { const float rstd = rsqrtf(s[q] * (1.f / 1024.f) + 1e-6f);
#pragma unroll
                for (int j = 0; j < 4; ++j) xr[q * 256 + 64 * j] = v[q][j] * rstd * gv[j]; } }
    }
}

extern "C" void kernel_launch(void* const* d_in, const int* in_sizes, int n_in, void* d_out, int out_size, void* d_ws, size_t ws_size, hipStream_t stream) {
    static int grid = 0;
    if (grid == 0) {
        if (n_in != 21 || (size_t)out_size != O_END || ws_size < WS_CTL + CTL_BYTES) { fprintf(stderr, "kernel_launch: unexpected shapes (n_in %d, out %d, ws %zu); nothing launched\n", n_in, out_size, ws_size); grid = -1; return; }
        int dev = 0, cus = 0, per_cu = 0;
        hipGetDevice(&dev); hipDeviceGetAttribute(&cus, hipDeviceAttributeMultiprocessorCount, dev);
        hipFuncSetAttribute((const void*)fwd_megakernel, hipFuncAttributeMaxDynamicSharedMemorySize, LDS_BYTES);
        hipOccupancyMaxActiveBlocksPerMultiprocessor(&per_cu, (const void*)fwd_megakernel, NTHREADS, LDS_BYTES);
        if (per_cu < 1) { fprintf(stderr, "kernel_launch: occupancy query says %d blocks per CU; nothing launched\n", per_cu); grid = -1; return; }
        grid = cus;
        if (grid < 64) { fprintf(stderr, "kernel_launch: needs at least 64 CUs\n"); grid = -1; return; }
    }
    if (grid < 0) return;
    if (hipMemsetAsync((char*)d_ws + WS_CTL, 0, CTL_BYTES, stream) != hipSuccess) { fprintf(stderr, "kernel_launch: hipMemsetAsync failed\n"); return; }
    Args a{};
    for (int i = 0; i < 21; ++i) a.in[i] = (const float*)d_in[i];
    a.out = (float*)d_out; a.ws = (unsigned char*)d_ws;
    void* args[] = {&a};
    hipError_t e = hipLaunchCooperativeKernel((const void*)fwd_megakernel, dim3(grid), dim3(NTHREADS), args, LDS_BYTES, stream);
    if (e != hipSuccess) fprintf(stderr, "cooperative launch failed: %s (grid %d)\n", hipGetErrorString(e), grid);
}
```

```cpp
#include <hip/hip_runtime.h>
#include <hip/hip_cooperative_groups.h>
#include <cstdio>
#include <cstdint>
namespace cg = cooperative_groups;
namespace pg8 {
#define PG8_LAS __attribute__((address_space(3)))
typedef unsigned short bf16_t;
typedef short bf16x8 __attribute__((ext_vector_type(8)));
typedef float f32x4 __attribute__((ext_vector_type(4)));
typedef unsigned u32x4 __attribute__((ext_vector_type(4)));
constexpr int BM = 256, BK = 64, HALF = 128, HTB = HALF * BK * 2  , STAGE_BYTES = 8 * HTB, NXCD = 8, WGM = 4;

__host__ __device__ __forceinline__ int lds_byte(int r, int c) { const int st = (r >> 4) * 2 + (c >> 5), rr = r & 15, cc = c & 31, ob = rr * 64 + cc * 2; return st * 1024 + (ob ^ (((ob >> 9) & 1) << 5)); }
__host__ __device__ __forceinline__ void stage_rc(int b, int& R, int& C) { const int st = b / 1024, sb = b % 1024, swz = sb ^ (((sb >> 9) & 1) << 5); R = (st >> 1) * 16 + swz / 64; C = (st & 1) * 32 + (swz % 64) / 2; }
__host__ __device__ __forceinline__ int perm32(int rho) { const int n = rho >> 4, i = rho & 15; return 8 * (i >> 2) + 4 * n + (i & 3); }

struct Unit { int pm, pn; };
struct Gemm { const bf16_t* A; const bf16_t* Bt; int M, N, K; };

struct StaticOrder {
    int nM, nN, nwg, G, c;
    __host__ __device__ void init(int M, int N, int G_, int c_) { nM = M / BM; nN = N / BM; nwg = nM * nN; G = G_; c = c_; }
    __host__ __device__ bool next(int i, Unit& u) const {
        const long L = (long)i * G + c; if (L >= nwg) return false;
        int wgid = (int)L; { const int q = nwg / NXCD, r = nwg % NXCD, xcd = wgid % NXCD, off = wgid / NXCD; wgid = (xcd < r ? xcd * (q + 1) : r * (q + 1) + (xcd - r) * q) + off; }
        const int nig = WGM * nN, gid = wgid / nig, fm = gid * WGM, gsz = (nM - fm) < WGM ? (nM - fm) : WGM;
        u.pm = fm + ((wgid % nig) % gsz); u.pn = (wgid % nig) / gsz; return true;
    }
    __device__ __forceinline__ void a_ready(const Unit&) const {}
    __device__ __forceinline__ void done(const Unit&) const {}
};

typedef float f32x2_cv __attribute__((ext_vector_type(2))); typedef __bf16 bf16x2_cv __attribute__((ext_vector_type(2)));
__device__ __forceinline__ unsigned cvt_pk_bf16(float lo, float hi) { f32x2_cv v = {lo, hi}; bf16x2_cv b = __builtin_convertvector(v, bf16x2_cv); return __builtin_bit_cast(unsigned, b); }
typedef unsigned u32x2 __attribute__((ext_vector_type(2)));
__device__ __forceinline__ float fast_sigmoid(float x) { return __builtin_amdgcn_rcpf(1.0f + __expf(-x)); }
__device__ __forceinline__ float bf_lo(unsigned w) { return __uint_as_float(w << 16); }
__device__ __forceinline__ float bf_hi(unsigned w) { return __uint_as_float(w & 0xffff0000u); }
__device__ __forceinline__ float rstd_from_ss(const float* ssrow, int fq) {
    const f32x4 a = ((const f32x4*)ssrow)[fq];
    float s = (a[0] + a[1]) + (a[2] + a[3]);
    s += __shfl_xor(s, 16); s += __shfl_xor(s, 32);
    return rsqrtf(s * (1.0f / 1024.0f) + 1e-6f);
}
struct EpiSwiglu {
    static constexpr bool PERM = true, AFTER_DRAIN = false;
    bf16_t* O; const float* SS;
    __device__ __forceinline__ void operator()(const f32x4 (&acc)[2][2][4][2], const Unit& u, int wr, int wc, int fr, int fq) const {
        const int row0 = u.pm * BM + wr * 64 + fr, col0 = u.pn * 128 + wc * 32 + 8 * fq;
#pragma unroll
        for (int ai = 0; ai < 2; ++ai)
#pragma unroll
            for (int m = 0; m < 4; ++m) {
                int row = row0 + ai * HALF + m * 16; asm volatile("" : "+v"(row));
                const float rs = SS ? rstd_from_ss(SS + (size_t)row * 16, fq) : 1.0f;
                float o[8];
#pragma unroll
                for (int n = 0; n < 2; ++n)
#pragma unroll
                    for (int i = 0; i < 4; ++i) { const float g = acc[ai][0][m][n][i] * rs, up = acc[ai][1][m][n][i] * rs; o[4 * n + i] = g * fast_sigmoid(g) * up; }
                u32x4 w; w.x = cvt_pk_bf16(o[0], o[1]); w.y = cvt_pk_bf16(o[2], o[3]); w.z = cvt_pk_bf16(o[4], o[5]); w.w = cvt_pk_bf16(o[6], o[7]);
                *(u32x4*)(O + (size_t)row * 2816 + col0) = w;
            }
    }
};
struct EpiRes {
    static constexpr bool PERM = true, AFTER_DRAIN = false;
    const float* base0; const float* base1; int split_pm; const bf16_t* baseb; float* H; bf16_t* XN; float* SS; float alpha;
    __device__ __forceinline__ void operator()(const f32x4 (&acc)[2][2][4][2], const Unit& u, int wr, int wc, int fr, int fq) const {
        const float* base = (u.pm < split_pm) ? base0 + (size_t)u.pm * BM * 1024 : base1 + (size_t)(u.pm - split_pm) * BM * 1024;
        const int lrow0 = wr * 64 + fr, col0 = u.pn * BM + wc * 32 + 8 * fq;
#pragma unroll
        for (int ai = 0; ai < 2; ++ai)
#pragma unroll
            for (int m = 0; m < 4; ++m) {
                int lrow = lrow0 + ai * HALF + m * 16; asm volatile("" : "+v"(lrow)); const size_t row = (size_t)u.pm * BM + lrow;
                float ss = 0.f;
#pragma unroll
                for (int bj = 0; bj < 2; ++bj) {
                    f32x4 b0, b1;
                    if (baseb) { const u32x4 bw = *(const u32x4*)(baseb + row * 1024 + col0 + bj * HALF);
                        b0 = (f32x4){bf_lo(bw.x), bf_hi(bw.x), bf_lo(bw.y), bf_hi(bw.y)}; b1 = (f32x4){bf_lo(bw.z), bf_hi(bw.z), bf_lo(bw.w), bf_hi(bw.w)}; }
                    else { const float* bp = base + (size_t)lrow * 1024 + col0 + bj * HALF; b0 = *(const f32x4*)bp; b1 = *(const f32x4*)(bp + 4); }
                    const f32x4 v0 = b0 + acc[ai][bj][m][0] * alpha, v1 = b1 + acc[ai][bj][m][1] * alpha;
                    if (H) { float* hp = H + row * 1024 + col0 + bj * HALF; *(f32x4*)hp = v0; *(f32x4*)(hp + 4) = v1; }
                    if (XN) { u32x4 w; w.x = cvt_pk_bf16(v0[0], v0[1]); w.y = cvt_pk_bf16(v0[2], v0[3]); w.z = cvt_pk_bf16(v1[0], v1[1]); w.w = cvt_pk_bf16(v1[2], v1[3]);
                        *(u32x4*)(XN + row * 1024 + col0 + bj * HALF) = w; }
                    ss += (v0[0] * v0[0] + v0[1] * v0[1]) + (v0[2] * v0[2] + v0[3] * v0[3]) + (v1[0] * v1[0] + v1[1] * v1[1]) + (v1[2] * v1[2] + v1[3] * v1[3]);
                    asm volatile("" ::: "memory");
                }
                if (SS) { ss += __shfl_xor(ss, 16); ss += __shfl_xor(ss, 32); if (fq == 0) SS[row * 16 + u.pn * 4 + wc] = ss; }
                asm volatile("" ::: "memory");
            }
    }
};
struct EpiProj {
    static constexpr bool PERM = true, AFTER_DRAIN = false;
    bf16_t* PB; size_t pbs; bf16_t* GG; float* FA; const float* SS; float* okp; float* ovp; float* oks; float* ovs; int grow0;
    __device__ __forceinline__ void operator()(const f32x4 (&acc)[2][2][4][2], const Unit& u, int wr, int wc, int fr, int fq) const {
        const int pn = u.pn; const int lrow0 = u.pm * BM + wr * 64 + fr;
        bf16_t* dst; int ldc, colt;
        if (pn < 24) { dst = PB + (size_t)(pn >> 2) * pbs; ldc = 1024; colt = (pn & 3) * 256; } else { dst = GG; ldc = 2048; colt = (pn - 24) * 256; }
        const int col0 = colt + wc * 32 + 8 * fq;
        float* kvo = nullptr; long kvrow0 = 0;
        if (pn >= 16 && pn < 24) {
            const int gt = grow0 + u.pm * BM;
            if (gt >= 32768) { kvo = (pn < 20) ? oks : ovs; kvrow0 = (long)(gt - 32768) - (long)(u.pm * BM); }
            else if ((gt & 2047) >= 1536) { kvo = (pn < 20) ? okp : ovp; kvrow0 = (long)((gt >> 11) * 512 + ((gt & 2047) - 1536)) - (long)(u.pm * BM); }
        }
#pragma unroll
        for (int ai = 0; ai < 2; ++ai)
#pragma unroll
            for (int m = 0; m < 4; ++m) {
                int row = lrow0 + ai * HALF + m * 16; asm volatile("" : "+v"(row));
                const float rs = rstd_from_ss(SS + (size_t)row * 16, fq);
                if (pn < 32) {
#pragma unroll
                    for (int bj = 0; bj < 2; ++bj) {
                        const f32x4 v0 = acc[ai][bj][m][0] * rs, v1 = acc[ai][bj][m][1] * rs;
                        u32x4 w; w.x = cvt_pk_bf16(v0[0], v0[1]); w.y = cvt_pk_bf16(v0[2], v0[3]); w.z = cvt_pk_bf16(v1[0], v1[1]); w.w = cvt_pk_bf16(v1[2], v1[3]);
                        *(u32x4*)(dst + (size_t)row * ldc + col0 + bj * HALF) = w;
                        if (kvo) { float* p = kvo + (size_t)(kvrow0 + row) * 1024 + col0 + bj * HALF; *(f32x4*)p = v0; *(f32x4*)(p + 4) = v1; }
                    }
                } else if (wc == 0 && fq < 2) {
                    const f32x4 v0 = acc[ai][0][m][0] * rs, v1 = acc[ai][0][m][1] * rs;
                    float* p = FA + (size_t)row * 16 + 8 * fq; *(f32x4*)p = v0; *(f32x4*)(p + 4) = v1;
                }
            }
    }
};
template <int MODE> struct EpiGate {
    static constexpr bool PERM = true, AFTER_DRAIN = false;
    const bf16_t* GG; int goff; bf16_t* TMP; bf16_t* MIX;
    __device__ __forceinline__ void operator()(const f32x4 (&acc)[2][2][4][2], const Unit& u, int wr, int wc, int fr, int fq) const {
        const int lrow0 = u.pm * BM + wr * 64 + fr, col0 = u.pn * BM + wc * 32 + 8 * fq;
#pragma unroll
        for (int ai = 0; ai < 2; ++ai)
#pragma unroll
            for (int m = 0; m < 4; ++m) {
                int rowi = lrow0 + ai * HALF + m * 16; asm volatile("" : "+v"(rowi)); const size_t row = (size_t)rowi;
#pragma unroll
                for (int bj = 0; bj < 2; ++bj) {
                    const u32x4 gw = *(const u32x4*)(GG + row * 2048 + goff + col0 + bj * HALF);
                    f32x4 v0, v1;
                    v0[0] = fast_sigmoid(bf_lo(gw.x)) * acc[ai][bj][m][0][0]; v0[1] = fast_sigmoid(bf_hi(gw.x)) * acc[ai][bj][m][0][1];
                    v0[2] = fast_sigmoid(bf_lo(gw.y)) * acc[ai][bj][m][0][2]; v0[3] = fast_sigmoid(bf_hi(gw.y)) * acc[ai][bj][m][0][3];
                    v1[0] = fast_sigmoid(bf_lo(gw.z)) * acc[ai][bj][m][1][0]; v1[1] = fast_sigmoid(bf_hi(gw.z)) * acc[ai][bj][m][1][1];
                    v1[2] = fast_sigmoid(bf_lo(gw.w)) * acc[ai][bj][m][1][2]; v1[3] = fast_sigmoid(bf_hi(gw.w)) * acc[ai][bj][m][1][3];
                    bf16_t* tp = TMP + row * 1024 + col0 + bj * HALF;
                    if (MODE == 1) { const u32x4 tw = *(const u32x4*)tp;
                        v0 += (f32x4){bf_lo(tw.x), bf_hi(tw.x), bf_lo(tw.y), bf_hi(tw.y)}; v1 += (f32x4){bf_lo(tw.z), bf_hi(tw.z), bf_lo(tw.w), bf_hi(tw.w)}; }
                    u32x4 w; w.x = cvt_pk_bf16(v0[0], v0[1]); w.y = cvt_pk_bf16(v0[2], v0[3]); w.z = cvt_pk_bf16(v1[0], v1[1]); w.w = cvt_pk_bf16(v1[2], v1[3]);
                    *(u32x4*)((MODE == 0 ? tp : MIX + row * 1024 + col0 + bj * HALF)) = w;
                }
            }
    }
};
template <class Epi, class Sched, bool ALIGN_EPI = false, bool SP2 = false>
__device__ __forceinline__ void gemm_phase(PG8_LAS unsigned char* lds, const Gemm g, const Sched& S, const Epi& E, const int tid_arg) {
    int tid_l = tid_arg; asm volatile("" : "+v"(tid_l));
    const int tid = tid_l, wid = __builtin_amdgcn_readfirstlane(tid >> 6), lane = tid & 63, wr = wid >> 2, wc = wid & 3, fr = lane & 15, fq = lane >> 4;
    const int K = g.K, nt = K / BK;
    unsigned voffA[2], voffB[2];
#pragma unroll
    for (int i = 0; i < 2; ++i) { int R, C; stage_rc(tid * 16 + i * 8192, R, C); const int Rb = Epi::PERM ? ((R & ~31) + perm32(R & 31)) : R;
        voffA[i] = (unsigned)(R * K + C) * 2u; voffB[i] = (unsigned)(Rb * K + C) * 2u; }
    const size_t kstep = (size_t)(BK * 2);
    const size_t hstep = (size_t)HALF * K * 2;
    const size_t tstep = 2 * hstep;
    const unsigned ldsw = (unsigned)wid * 1024u;
    const int aoff = lds_byte(wr * 64 + fr, fq * 8), boff = lds_byte(wc * 32 + fr, fq * 8);
#define PG8_SA(b, h) (((b) * 2 + (h)) * HTB)
#define PG8_SB(b, h) ((4 + (b) * 2 + (h)) * HTB)
#define PG8_STAGE(bufoff, gbase, voff) do { _Pragma("unroll") for (int _i = 0; _i < 2; ++_i) \
        __builtin_amdgcn_global_load_lds((const unsigned*)((const char*)(gbase) + (voff)[_i]), (PG8_LAS unsigned*)(lds + (bufoff) + ldsw + _i * 8192), 16, 0, 0); } while (0)
#define PG8_LDA(dst, b, h) do { _Pragma("unroll") for (int m = 0; m < 4; ++m) _Pragma("unroll") for (int k = 0; k < 2; ++k) dst[m][k] = *(const PG8_LAS bf16x8*)(lds + PG8_SA(b, h) + aoff + m * 2048 + k * 1024); } while (0)
#define PG8_LDB(dst, b, h) do { _Pragma("unroll") for (int n = 0; n < 2; ++n) _Pragma("unroll") for (int k = 0; k < 2; ++k) dst[n][k] = *(const PG8_LAS bf16x8*)(lds + PG8_SB(b, h) + boff + n * 2048 + k * 1024); } while (0)
#define PG8_MMA(ai, bj, At, Bt) do { __builtin_amdgcn_s_setprio(1); _Pragma("unroll") for (int m = 0; m < 4; ++m) _Pragma("unroll") for (int n = 0; n < 2; ++n) _Pragma("unroll") for (int k = 0; k < 2; ++k) \
        acc[ai][bj][m][n] = __builtin_amdgcn_mfma_f32_16x16x32_bf16(Bt[n][k], At[m][k], acc[ai][bj][m][n], 0, 0, 0); __builtin_amdgcn_s_setprio(0); } while (0)
#define PG8_WAIT_V(n) asm volatile("s_waitcnt vmcnt(" #n ")" ::: "memory")
#define PG8_WAIT_L(n) asm volatile("s_waitcnt lgkmcnt(" #n ")" ::: "memory")
#define PG8_BAR __builtin_amdgcn_s_barrier()
#define PG8_SCHED __builtin_amdgcn_sched_barrier(0)
    Unit cur, nxt; int ui = 0;
    if (!S.next(0, cur)) return;
    f32x4 acc[2][2][4][2];
#pragma unroll
    for (int a = 0; a < 2; ++a)
#pragma unroll
        for (int b = 0; b < 2; ++b)
#pragma unroll
            for (int m = 0; m < 4; ++m)
#pragma unroll
                for (int n = 0; n < 2; ++n) acc[a][b][m][n] = (f32x4){0.f, 0.f, 0.f, 0.f};
    bf16x8 At[4][2], B0[2][2], B1[2][2];
    const char* cA = (const char*)g.A + (size_t)cur.pm * tstep; const char* cB = (const char*)g.Bt + (size_t)cur.pn * tstep;
    S.a_ready(cur);
    if constexpr (SP2) {
        PG8_STAGE(PG8_SB(0, 0), cB, voffB); PG8_STAGE(PG8_SB(0, 1), cB + hstep, voffB); PG8_STAGE(PG8_SA(0, 0), cA, voffA); PG8_STAGE(PG8_SA(0, 1), cA + hstep, voffA);
        if (wr == 1) PG8_BAR;
        PG8_WAIT_V(2); PG8_BAR;
        PG8_STAGE(PG8_SB(1, 0), cB + kstep, voffB); PG8_STAGE(PG8_SA(1, 0), cA + kstep, voffA); PG8_STAGE(PG8_SB(1, 1), cB + hstep + kstep, voffB);
        PG8_WAIT_V(6); PG8_BAR;
    } else {
        PG8_STAGE(PG8_SB(0, 0), cB, voffB); PG8_STAGE(PG8_SA(0, 0), cA, voffA); PG8_STAGE(PG8_SB(0, 1), cB + hstep, voffB); PG8_STAGE(PG8_SA(0, 1), cA + hstep, voffA);
        if (wr == 1) PG8_BAR;
        PG8_WAIT_V(4); PG8_BAR;
        PG8_STAGE(PG8_SB(1, 0), cB + kstep, voffB); PG8_STAGE(PG8_SA(1, 0), cA + kstep, voffA); PG8_STAGE(PG8_SB(1, 1), cB + hstep + kstep, voffB);
        PG8_WAIT_V(6); PG8_BAR;
    }
    for (;;) {
        const bool has_next = S.next(ui + 1, nxt);
        const char* nA = has_next ? (const char*)g.A + (size_t)nxt.pm * tstep : cA; const char* nB = has_next ? (const char*)g.Bt + (size_t)nxt.pn * tstep : cB;
        for (int t = 0; t < nt; t += 2) {
            const bool last = (t == nt - 2);
            const char* a1 = cA + (size_t)(t + 1) * kstep;
            const char* a2 = last ? nA : cA + (size_t)(t + 2) * kstep; const char* b2 = last ? nB : cB + (size_t)(t + 2) * kstep;
            const char* a3 = a2 + kstep; const char* b3 = b2 + kstep;
            if (last && has_next) S.a_ready(nxt);
            if constexpr (SP2) {
            PG8_LDB(B0, 0, 0); PG8_LDB(B1, 0, 1); PG8_SCHED; PG8_LDA(At, 0, 0); PG8_STAGE(PG8_SA(1, 1), a1 + hstep, voffA);
            PG8_WAIT_V(8); PG8_WAIT_L(0); PG8_BAR; PG8_MMA(0, 0, At, B0); PG8_MMA(0, 1, At, B1); PG8_BAR; PG8_SCHED;
            PG8_LDA(At, 0, 1); PG8_STAGE(PG8_SB(0, 0), b2, voffB); PG8_STAGE(PG8_SB(0, 1), b2 + hstep, voffB); PG8_STAGE(PG8_SA(0, 0), a2, voffA);
            PG8_WAIT_V(8); PG8_WAIT_L(0); PG8_BAR; PG8_MMA(1, 0, At, B0); PG8_MMA(1, 1, At, B1); PG8_BAR; PG8_SCHED;
            PG8_LDB(B0, 1, 0); PG8_LDB(B1, 1, 1); PG8_SCHED; PG8_LDA(At, 1, 0); PG8_STAGE(PG8_SA(0, 1), a2 + hstep, voffA);
            PG8_WAIT_V(8); PG8_WAIT_L(0); PG8_BAR; PG8_MMA(0, 0, At, B0); PG8_MMA(0, 1, At, B1); PG8_BAR; PG8_SCHED;
            PG8_LDA(At, 1, 1); PG8_STAGE(PG8_SB(1, 0), b3, voffB); PG8_STAGE(PG8_SB(1, 1), b3 + hstep, voffB); PG8_STAGE(PG8_SA(1, 0), a3, voffA);
            PG8_WAIT_V(8); PG8_WAIT_L(0); PG8_BAR; PG8_MMA(1, 0, At, B0); PG8_MMA(1, 1, At, B1); PG8_BAR; PG8_SCHED;
            } else {
            PG8_LDB(B0, 0, 0); PG8_SCHED; PG8_LDA(At, 0, 0); PG8_STAGE(PG8_SA(1, 1), a1 + hstep, voffA);
            PG8_WAIT_L(8); PG8_BAR; PG8_WAIT_L(0); PG8_MMA(0, 0, At, B0); PG8_BAR; PG8_SCHED;
            PG8_LDB(B1, 0, 1); PG8_STAGE(PG8_SB(0, 0), b2, voffB);
            PG8_BAR; PG8_WAIT_L(0); PG8_MMA(0, 1, At, B1); PG8_BAR;
            PG8_LDA(At, 0, 1); PG8_STAGE(PG8_SA(0, 0), a2, voffA);
            PG8_BAR; PG8_WAIT_L(0); PG8_MMA(1, 0, At, B0); PG8_BAR; PG8_SCHED;
            PG8_STAGE(PG8_SB(0, 1), b2 + hstep, voffB);
            PG8_WAIT_V(6); PG8_BAR; PG8_MMA(1, 1, At, B1); PG8_BAR;
            PG8_LDB(B0, 1, 0); PG8_SCHED; PG8_LDA(At, 1, 0); PG8_STAGE(PG8_SA(0, 1), a2 + hstep, voffA);
            PG8_WAIT_L(8); PG8_BAR; PG8_WAIT_L(0); PG8_MMA(0, 0, At, B0); PG8_BAR; PG8_SCHED;
            PG8_LDB(B1, 1, 1); PG8_STAGE(PG8_SB(1, 0), b3, voffB);
            PG8_BAR; PG8_WAIT_L(0); PG8_MMA(0, 1, At, B1); PG8_BAR;
            PG8_LDA(At, 1, 1); PG8_STAGE(PG8_SA(1, 0), a3, voffA);
            PG8_BAR; PG8_WAIT_L(0); PG8_MMA(1, 0, At, B0); PG8_BAR; PG8_SCHED;
            PG8_STAGE(PG8_SB(1, 1), b3 + hstep, voffB);
            PG8_WAIT_V(6); PG8_BAR; PG8_MMA(1, 1, At, B1); PG8_BAR;
            }
        }
        if constexpr (ALIGN_EPI) { if (wr == 0) PG8_BAR; }
        if constexpr (!Epi::AFTER_DRAIN) { E(acc, cur, wr, wc, fr, fq); S.done(cur); }
        if (!has_next) break;
#pragma unroll
        for (int a = 0; a < 2; ++a)
#pragma unroll
            for (int b = 0; b < 2; ++b)
#pragma unroll
                for (int m = 0; m < 4; ++m)
#pragma unroll
                    for (int n = 0; n < 2; ++n) acc[a][b][m][n] = (f32x4){0.f, 0.f, 0.f, 0.f};
        cur = nxt; cA = nA; cB = nB; ++ui;
        if constexpr (ALIGN_EPI) { if (wr == 1) PG8_BAR; }
    }
    PG8_WAIT_V(0);
    if constexpr (!ALIGN_EPI) { if (wr == 0) PG8_BAR; }
    PG8_BAR;
    if constexpr (Epi::AFTER_DRAIN) { E.fused(acc, cur, wr, wc, fr, fq, lds, wid, lane); S.done(cur); }
#undef PG8_SA
#undef PG8_SB
#undef PG8_STAGE
#undef PG8_LDA
#undef PG8_LDB
#undef PG8_MMA
#undef PG8_WAIT_V
#undef PG8_WAIT_L
#undef PG8_BAR
#undef PG8_SCHED
}
}
#define LAS __attribute__((address_space(3)))
#define GASP __attribute__((address_space(1)))
typedef unsigned short bf16;
typedef float f32x4 __attribute__((ext_vector_type(4)));
typedef float f32x16 __attribute__((ext_vector_type(16)));
typedef short bf16x8 __attribute__((ext_vector_type(8)));
typedef short s16x4 __attribute__((ext_vector_type(4)));
typedef unsigned u32x4 __attribute__((ext_vector_type(4)));
typedef unsigned u32x2 __attribute__((ext_vector_type(2)));
constexpr int NWAVES = 8, NTHREADS = 512;
constexpr int DM = 1024, T_P = 32768, T_S = 512, T_ALL = 33280, DFF = 2816, NPROJ = 8448, NPROJ_SRC = 8208;
constexpr int MG = 16896;
constexpr size_t PBS = (size_t)MG * 1024 * 2;
constexpr size_t WS_W1T = 0;
constexpr size_t WS_W1OT = WS_W1T + (size_t)5632 * 1024 * 2;
constexpr size_t WS_WINT = WS_W1OT + (size_t)1024 * 2816 * 2;
constexpr size_t WS_WBGT = WS_WINT + (size_t)NPROJ * 1024 * 2;
constexpr size_t WS_WBAT = WS_WBGT + (size_t)1024 * 1024 * 2;
constexpr size_t WS_WOUTT = WS_WBAT + (size_t)1024 * 1024 * 2;
constexpr size_t WS_W2T = WS_WOUTT + (size_t)1024 * 1024 * 2;
constexpr size_t WS_W2OT = WS_W2T + (size_t)5632 * 1024 * 2;
constexpr size_t WS_CKB = WS_W2OT + (size_t)1024 * 2816 * 2;
constexpr size_t WS_CVB = WS_CKB + (size_t)8 * 512 * 1024 * 2;
constexpr size_t WS_XN = WS_CVB + (size_t)8 * 512 * 1024 * 2;
constexpr size_t WS_SS1 = WS_XN + (size_t)T_ALL * 1024 * 2;
constexpr size_t WS_SS2 = WS_SS1 + (size_t)T_ALL * 16 * 4;
constexpr size_t WS_R = WS_SS2 + (size_t)T_ALL * 16 * 4;
constexpr size_t WS_ACT = WS_R;
constexpr size_t WS_PB = WS_R, WS_GG = WS_PB + 6 * PBS, WS_FA = WS_GG + (size_t)MG * 2048 * 2, WS_OA = WS_FA + (size_t)MG * 16 * 4, WS_OB = WS_OA + PBS, WS_END = WS_OB + PBS;
constexpr size_t WS_TMP = WS_PB, WS_MIX = WS_PB + 2 * PBS;
static_assert(WS_END <= (size_t)536870912 && WS_ACT + (size_t)T_ALL * DFF * 2 <= WS_END, "workspace map");
constexpr size_t WS_CTL = WS_END, CTL_BYTES = 16384;
constexpr int LDS_BYTES = 147456, XST_OFF = 139264;
constexpr size_t O_Y = 0, O_KP = (size_t)T_ALL * 1024, O_VP = O_KP + (size_t)16 * 512 * 1024, O_GP = O_VP + (size_t)16 * 512 * 1024, O_KS = O_GP + (size_t)16 * 4 * 128 * 256,
                 O_VS = O_KS + (size_t)8 * 64 * 1024, O_GS = O_VS + (size_t)8 * 64 * 1024, O_END = O_GS + (size_t)8 * 4 * 128 * 256;

__device__ __forceinline__ unsigned f2bf(float f) { unsigned u = __builtin_bit_cast(unsigned, f); return (u + 0x7fffu + ((u >> 16) & 1u)) >> 16; }
__device__ __forceinline__ unsigned pk2(float lo, float hi) { return pg8::cvt_pk_bf16(lo, hi); }
__device__ __forceinline__ float bflo(unsigned w) { return __uint_as_float(w << 16); }
__device__ __forceinline__ float bfhi(unsigned w) { return __uint_as_float(w & 0xffff0000u); }
#define LDS_WAIT() asm volatile("s_waitcnt lgkmcnt(0)" ::: "memory")
__device__ __forceinline__ float wave_sum(float v) {
#pragma unroll
    for (int o = 1; o < 64; o <<= 1) v += __shfl_xor(v, o);
    return v;
}
__device__ __forceinline__ int crow(int r, int hi) { return (r & 3) + 8 * (r >> 2) + 4 * hi; }

struct Args { const float* in[21]; float* out; unsigned char* ws; };
typedef const __attribute__((address_space(4))) unsigned long long* karg_ptr_t;
__device__ __forceinline__ const float* arg_in(int i) { karg_ptr_t p = (karg_ptr_t)__builtin_amdgcn_kernarg_segment_ptr(); asm volatile("" : "+s"(p)); return (const float*)(const GASP float*)p[i]; }
#define AIN(i) arg_in(i)

__device__ __forceinline__ void transpose_item(const float* W, int N, int K, int k0, int src0, int nvalid, bf16* WT, int drow0, const float* gk, float cs, LAS float* scr, int lane) {
    const int c32 = lane & 31;
#pragma unroll
    for (int i = 0; i < 32; ++i) { const int kk = 2 * i + (lane >> 5); float v = 0.f;
        if (c32 < nvalid) v = W[(size_t)(k0 + kk) * N + src0 + c32] * (gk ? gk[k0 + kk] : 1.0f) * cs;
        scr[kk * 33 + c32] = v; }
    LDS_WAIT(); asm volatile("" ::: "memory");
    const int c = lane & 7;
#pragma unroll
    for (int j = 0; j < 4; ++j) { const int n = (lane >> 3) + 8 * j; const LAS float* s = scr + (8 * c) * 33 + n;
        u32x4 o; o.x = pk2(s[0 * 33], s[1 * 33]); o.y = pk2(s[2 * 33], s[3 * 33]); o.z = pk2(s[4 * 33], s[5 * 33]); o.w = pk2(s[6 * 33], s[7 * 33]);
        *(u32x4*)(WT + (size_t)(drow0 + n) * K + k0 + 8 * c) = o; }
    LDS_WAIT(); asm volatile("" ::: "memory");
}
__device__ __forceinline__ void transpose_matrix_item(int kind, const float* W, int N, int K, int ND, bf16* WT, const float* gk, int item, LAS float* scr, int lane) {
    const int nblk = ND / 32, kb = item / nblk, nb = item % nblk, drow0 = 32 * nb; int src0 = drow0, nvalid = 32; float cs = 1.0f;
    if (kind == 1) { const int j = drow0 >> 8, w = drow0 & 255; src0 = (w < 128) ? 128 * j + w : 2816 + 128 * j + (w - 128); }
    else if (kind == 2) {
        if (drow0 < 3072) { cs = (drow0 < 512) ? 0.08838834764831845f : 1.0f; }
        else if (drow0 < 8192) { src0 = drow0 + 16; cs = (drow0 < 4096) ? 0.125f : 1.0f; }
        else if (drow0 == 8192) { src0 = 3072; nvalid = 16; }
        else { src0 = 0; nvalid = 0; }
    }
    transpose_item(W, N, K, 64 * kb, src0, nvalid, WT, drow0, gk, cs, scr, lane);
}

__device__ __forceinline__ void transpose_tile_block(int kind, const float* W, int N, int K, int ND, bf16* WT, const float* gk, int item, LAS unsigned char* lds, int tid) {
    constexpr int LP = 260;
    const int ntile = ND / 256, kb = item / ntile, nt = item % ntile, k0 = 64 * kb, drow0 = 256 * nt;
    int srcA = drow0, srcB = drow0 + 128, nvalid = 256; float cs = 1.0f;
    if (kind == 1) { srcA = 128 * nt; srcB = 2816 + 128 * nt; }
    else if (kind == 2) {
        if (drow0 < 3072) { cs = (drow0 < 512) ? 0.08838834764831845f : 1.0f; }
        else if (drow0 < 8192) { srcA = drow0 + 16; srcB = drow0 + 144; cs = (drow0 < 4096) ? 0.125f : 1.0f; }
        else { srcA = 3072; srcB = 3072; nvalid = 16; }
    }
    LAS float* T = (LAS float*)lds;
    __syncthreads();
#pragma unroll
    for (int r = 0; r < 8; ++r) { const int id = tid + NTHREADS * r, row = id >> 6, cv = id & 63, col = cv * 4;
        f32x4 v = (f32x4){0.f, 0.f, 0.f, 0.f};
        if (col < nvalid) { const int src = (col < 128) ? srcA + col : srcB + (col - 128); v = __builtin_nontemporal_load((const f32x4*)(W + (size_t)(k0 + row) * N + src)); }
        const float g = (gk ? gk[k0 + row] : 1.0f) * cs;
        *(LAS f32x4*)(T + row * LP + col) = v * g; }
    __syncthreads();
#pragma unroll
    for (int r = 0; r < 4; ++r) { const int id = tid + NTHREADS * r, n = id >> 3, k8 = id & 7; const LAS float* s = T + (k8 * 8) * LP + n;
        u32x4 o; o.x = pk2(s[0 * LP], s[1 * LP]); o.y = pk2(s[2 * LP], s[3 * LP]); o.z = pk2(s[4 * LP], s[5 * LP]); o.w = pk2(s[6 * LP], s[7 * LP]);
        *(u32x4*)(WT + (size_t)(drow0 + n) * K + k0 + 8 * k8) = o; }
}
__device__ __forceinline__ void rms_rows4_to_bf16(const float* x0, bf16* o0, int lane) {
    f32x4 v[4][4]; float s[4];
#pragma unroll
    for (int q = 0; q < 4; ++q) { const f32x4* xr = (const f32x4*)(x0 + q * 1024) + lane;
#pragma unroll
        for (int j = 0; j < 4; ++j) v[q][j] = __builtin_nontemporal_load(xr + 64 * j); }
#pragma unroll
    for (int q = 0; q < 4; ++q) { s[q] = 0.f;
#pragma unroll
        for (int j = 0; j < 4; ++j) s[q] += (v[q][j].x * v[q][j].x + v[q][j].y * v[q][j].y) + (v[q][j].z * v[q][j].z + v[q][j].w * v[q][j].w); }
#pragma unroll
    for (int o = 1; o < 64; o <<= 1) {
#pragma unroll
        for (int q = 0; q < 4; ++q) s[q] += __shfl_xor(s[q], o); }
#pragma unroll
    for (int q = 0; q < 4; ++q) { const float rstd = rsqrtf(s[q] * (1.f / 1024.f) + 1e-6f); u32x2* o8 = (u32x2*)(o0 + q * 1024) + lane;
#pragma unroll
        for (int j = 0; j < 4; ++j) { u32x2 w; w.x = pk2(v[q][j].x * rstd, v[q][j].y * rstd); w.y = pk2(v[q][j].z * rstd, v[q][j].w * rstd); o8[64 * j] = w; } }
}
#define XB_TMO      128
#define XB_XCNT(j)  (256  + 64 * (j))
#define XB_XSUB(j)  (1280 + 64 * (j))
#define XB_XGEN(j)  (2304 + 64 * (j))
#define XB_TOP      3328
#define XB_TOPGEN   3392
#define XCD_BAR_WORDS 3456
#define XB_SPIN_CAP (1u << 18)

__device__ __forceinline__ unsigned xb_ld(unsigned* p)              { return __hip_atomic_load(p, __ATOMIC_RELAXED, __HIP_MEMORY_SCOPE_AGENT); }
__device__ __forceinline__ unsigned xb_add(unsigned* p, unsigned v) { return __hip_atomic_fetch_add(p, v, __ATOMIC_RELAXED, __HIP_MEMORY_SCOPE_AGENT); }
__device__ __forceinline__ unsigned xb_xcc_id() { return (unsigned)__builtin_amdgcn_s_getreg((3 << 11) | 20) & 0xFu; }
#define XB_SPIN(cond, bar) do { unsigned _sp = 0; while (cond) { __builtin_amdgcn_s_sleep(1); \
    if ((++_sp & 255u) == 0u) { if (xb_ld(&(bar)[XB_TMO])) break; if (_sp > XB_SPIN_CAP) { atomicAdd(&(bar)[XB_TMO], 1u); break; } } } } while (0)

struct XcdBarrier {
    unsigned* bar; unsigned x;
    volatile LAS unsigned* st;
};

__device__ __forceinline__ XcdBarrier xcd_barrier_post(unsigned* bar, volatile LAS unsigned* st) {
    XcdBarrier b; b.bar = bar; b.x = xb_xcc_id(); b.st = st;
    if (threadIdx.x == 0) (void)xb_add(&bar[XB_XCNT(b.x)], 1u);
    return b;
}
__device__ __forceinline__ void xcd_barrier_complete(unsigned* bar, unsigned x, unsigned& nloc, unsigned& nx) {
    const unsigned G = gridDim.x * gridDim.y * gridDim.z;
    unsigned sum, cnt, mine, sp = 0u;
    for (;;) {
        sum = 0u; cnt = 0u; mine = 0u;
#pragma unroll
        for (unsigned j = 0; j < 16; ++j) { const unsigned c = xb_ld(&bar[XB_XCNT(j)]); sum += c; cnt += (c > 0u) ? 1u : 0u; mine = (j == x) ? c : mine; }
        if (sum == G) break;
        __builtin_amdgcn_s_sleep(1);
        if ((++sp & 255u) == 0u) { if (xb_ld(&bar[XB_TMO])) break; if (sp > XB_SPIN_CAP) { atomicAdd(&bar[XB_TMO], 1u); break; } }
    }
    nloc = mine > 0u ? mine : 1u; nx = cnt > 0u ? cnt : 1u;
}

__device__ __forceinline__ void xcd_barrier(const XcdBarrier& b, const bool leader) {
    asm volatile("s_waitcnt vmcnt(0)" ::: "memory");
    __syncthreads();
    if (leader) {
        unsigned* bar = b.bar;
        __builtin_amdgcn_s_waitcnt(0);
        unsigned nloc = b.st[0], nx = b.st[1];
        if (nloc == 0u) { xcd_barrier_complete(bar, b.x, nloc, nx); b.st[0] = nloc; b.st[1] = nx; }
        const unsigned old = xb_add(&bar[XB_XSUB(b.x)], 1u);
        const unsigned gen = old / nloc;
        if (old + 1u == (gen + 1u) * nloc) {
            __builtin_amdgcn_fence(__ATOMIC_RELEASE, "agent");
            asm volatile("s_waitcnt vmcnt(0)" ::: "memory");
            const unsigned og = xb_add(&bar[XB_TOP], 1u);
            const unsigned tg = og / nx;
            if (og + 1u == (tg + 1u) * nx) xb_add(&bar[XB_TOPGEN], 1u);
            else XB_SPIN(xb_ld(&bar[XB_TOPGEN]) == tg, bar);
            __builtin_amdgcn_fence(__ATOMIC_ACQUIRE, "agent");
            xb_add(&bar[XB_XGEN(b.x)], 1u);
            asm volatile("s_waitcnt vmcnt(0)" ::: "memory");
        } else {
            XB_SPIN(xb_ld(&bar[XB_XGEN(b.x)]) == gen, bar);
            __builtin_amdgcn_fence(__ATOMIC_ACQUIRE, "agent");
            asm volatile("s_waitcnt vmcnt(0)" ::: "memory");
        }
    }
    __syncthreads();
}
constexpr int ATT_VP = 144, ATT_WLDS = 10496;
__device__ __forceinline__ s16x4 tr16(LAS const unsigned char* p) { typedef short v4i16_t __attribute__((ext_vector_type(4)));
    return __builtin_bit_cast(s16x4, __builtin_amdgcn_ds_read_tr16_b64_v4i16((LAS v4i16_t*)p)); }
__device__ __forceinline__ bf16x8 cat8(s16x4 a, s16x4 b) { return (bf16x8){a[0], a[1], a[2], a[3], b[0], b[1], b[2], b[3]}; }
__device__ __forceinline__ bf16x8 pack8(const f32x16& v, int o) { u32x4 w; w.x = pk2(v[o], v[o + 1]); w.y = pk2(v[o + 2], v[o + 3]); w.z = pk2(v[o + 4], v[o + 5]); w.w = pk2(v[o + 6], v[o + 7]); return __builtin_bit_cast(bf16x8, w); }

__device__ __forceinline__ void attn_unit(LAS unsigned char* wl, const bf16* Qc, bf16* Oc, const bf16* KBc, const bf16* VBc, const bf16* CK, const bf16* CV, bool sample, int t0, const float* tabh, int lane, const int qh) {
    const int r32 = lane & 31, hi = lane >> 5, g16 = lane >> 4, i16 = lane & 15;
    LAS float* btab = (LAS float*)(wl + 9216);
    asm volatile("" ::: "memory");
    for (int i = lane; i < 257; i += 64) btab[i] = tabh[i];
    const float cb = tabh[256];
    bf16x8 qfr[4];
#pragma unroll
    for (int d0 = 0; d0 < 4; ++d0) qfr[d0] = *(const bf16x8*)(Qc + (size_t)(32 * qh + r32) * 1024 + 16 * d0 + 8 * hi);
    f32x16 oT[2];
#pragma unroll
    for (int a = 0; a < 2; ++a)
#pragma unroll
        for (int r = 0; r < 16; ++r) oT[a][r] = 0.f;
    float mrun = -1e30f, lrun = 0.f;
    const int traddr = ((g16 >> 1) * 4 + (i16 >> 2)) * ATT_VP + ((g16 & 1) * 16 + (i16 & 3) * 4) * 2;
    for (int t = t0; t < 9; ++t) {
        const bf16 *kp, *vp;
        if (sample && t < 8) { kp = CK + (size_t)t * 64 * 1024; vp = CV + (size_t)t * 64 * 1024; }
        else { const long off = -(long)(8 - t) * 64 * 1024; kp = KBc + off; vp = VBc + off; }
        u32x4 vreg[8];
#pragma unroll
        for (int i = 0; i < 8; ++i) vreg[i] = *(const u32x4*)(vp + (size_t)(8 * i + (lane >> 3)) * 1024 + (lane & 7) * 8);
        bf16x8 kf[2][4];
#pragma unroll
        for (int kvh = 0; kvh < 2; ++kvh)
#pragma unroll
            for (int d0 = 0; d0 < 4; ++d0) kf[kvh][d0] = *(const bf16x8*)(kp + (size_t)(32 * kvh + r32) * 1024 + 16 * d0 + 8 * hi);
        LDS_WAIT();
#pragma unroll
        for (int i = 0; i < 8; ++i) *(LAS u32x4*)(wl + (8 * i + (lane >> 3)) * ATT_VP + (lane & 7) * 16) = vreg[i];
        {
            f32x16 s0, s1;
#pragma unroll
            for (int r = 0; r < 16; ++r) { s0[r] = 0.f; s1[r] = 0.f; }
#pragma unroll
            for (int d0 = 0; d0 < 4; ++d0) { s0 = __builtin_amdgcn_mfma_f32_32x32x16_bf16(kf[0][d0], qfr[d0], s0, 0, 0, 0); s1 = __builtin_amdgcn_mfma_f32_32x32x16_bf16(kf[1][d0], qfr[d0], s1, 0, 0, 0); }
            if (t < 6) {
#pragma unroll
                for (int r = 0; r < 16; ++r) { s0[r] += cb; s1[r] += cb; }
            } else {
                const int relb = 64 * (8 - t) + 32 * qh + r32 + 128;
#pragma unroll
                for (int r = 0; r < 16; ++r) { const int i0 = relb - crow(r, hi); s0[r] += btab[i0 > 256 ? 256 : i0]; const int i1 = i0 - 32; s1[r] += btab[i1 > 256 ? 256 : i1]; }
            }
            float tm = fmaxf(s0[0], s1[0]);
#pragma unroll
            for (int r = 1; r < 16; ++r) tm = fmaxf(tm, fmaxf(s0[r], s1[r]));
            tm = fmaxf(tm, __shfl_xor(tm, 32));
            const float mn = fmaxf(mrun, tm), sc = __expf(mrun - mn); mrun = mn;
            float ps = 0.f;
#pragma unroll
            for (int r = 0; r < 16; ++r) { s0[r] = __expf(s0[r] - mn); s1[r] = __expf(s1[r] - mn); ps += s0[r] + s1[r]; }
            lrun = lrun * sc + ps;
#pragma unroll
            for (int r = 0; r < 16; ++r) { oT[0][r] *= sc; oT[1][r] *= sc; }
            bf16x8 pf[4]; pf[0] = pack8(s0, 0); pf[1] = pack8(s0, 8); pf[2] = pack8(s1, 0); pf[3] = pack8(s1, 8);
            LDS_WAIT();
#pragma unroll
            for (int dh = 0; dh < 2; ++dh)
#pragma unroll
                for (int kc = 0; kc < 4; ++kc) {
                    LAS const unsigned char* p = wl + traddr + (16 * kc) * ATT_VP + dh * 64;
                    const bf16x8 vf = cat8(tr16(p), tr16(p + 8 * ATT_VP));
                    oT[dh] = __builtin_amdgcn_mfma_f32_32x32x16_bf16(vf, pf[kc], oT[dh], 0, 0, 0);
                }
        }
        asm volatile("" ::: "memory");
    }
    {
        const float lt = lrun + __shfl_xor(lrun, 32), inv = 1.0f / lt;
        bf16* orow = Oc + (size_t)(32 * qh + r32) * 1024;
#pragma unroll
        for (int dh = 0; dh < 2; ++dh)
#pragma unroll
            for (int rg = 0; rg < 4; ++rg) { u32x2 w; w.x = pk2(oT[dh][4 * rg] * inv, oT[dh][4 * rg + 1] * inv); w.y = pk2(oT[dh][4 * rg + 2] * inv, oT[dh][4 * rg + 3] * inv);
                *(u32x2*)(orow + 32 * dh + 8 * rg + 4 * hi) = w; }
    }
    LDS_WAIT(); asm volatile("" ::: "memory");
}
constexpr int AB_HB = 18432, AB_BUF = 2 * AB_HB, AB_TAB = 2 * AB_BUF;
__device__ __forceinline__ void attn_block_unit(LAS unsigned char* lds, const bf16* QB, bf16* OB, const bf16* KB, const bf16* VB, int sb, int hp, int cp, const float* tab, int tid) {
    const int lane = tid & 63, w = __builtin_amdgcn_readfirstlane(tid >> 6), r32 = lane & 31, hi = lane >> 5, g16 = lane >> 4, i16 = lane & 15;
    const int hsel = w >> 2, csel = (w >> 1) & 1, qh = w & 1, h = 2 * hp + hsel, c = 2 * cp + csel;
    LAS float* btab = (LAS float*)(lds + AB_TAB + hsel * 1040);
    __syncthreads();
    for (int i = tid; i < 2 * 257; i += NTHREADS) { const int hh = i >= 257, k = i - 257 * hh; ((LAS float*)(lds + AB_TAB + hh * 1040))[k] = tab[(2 * hp + hh) * 257 + k]; }
    const float cb = tab[h * 257 + 256];
    const size_t hoff = (size_t)h * 64;
    const bf16* Qc = QB + ((size_t)sb * 2048 + (size_t)c * 64) * 1024 + hoff;
    bf16x8 qfr[4];
#pragma unroll
    for (int d0 = 0; d0 < 4; ++d0) qfr[d0] = *(const bf16x8*)(Qc + (size_t)(32 * qh + r32) * 1024 + 16 * d0 + 8 * hi);
    f32x16 oT[2];
#pragma unroll
    for (int a = 0; a < 2; ++a)
#pragma unroll
        for (int r = 0; r < 16; ++r) oT[a][r] = 0.f;
    float mrun = -1e30f, lrun = 0.f;
    const int traddr = ((g16 >> 1) * 4 + (i16 >> 2)) * ATT_VP + ((g16 & 1) * 16 + (i16 & 3) * 4) * 2;
    const int lrow = tid >> 3, lch = tid & 7;
    const int tc0 = 2 * cp - 8, j0 = tc0 < 0 ? -tc0 : 0;
    const size_t pbase = ((size_t)sb * 2048 + lrow) * 1024 + (size_t)(2 * hp) * 64 + lch * 8;
    const bf16* kbase = KB + pbase; const bf16* vbase = VB + pbase;
    u32x4 kreg0, vreg0, kreg1, vreg1;
#define AB_LOAD(jj) do { const long o_ = (long)(tc0 + (jj)) * 64 * 1024; kreg0 = *(const u32x4*)(kbase + o_); vreg0 = *(const u32x4*)(vbase + o_); kreg1 = *(const u32x4*)(kbase + o_ + 64); vreg1 = *(const u32x4*)(vbase + o_ + 64); } while (0)
#define AB_STORE(jj) do { LAS unsigned char* b_ = lds + ((jj) & 1) * AB_BUF + lrow * ATT_VP + lch * 16; *(LAS u32x4*)b_ = kreg0; *(LAS u32x4*)(b_ + 9216) = vreg0; *(LAS u32x4*)(b_ + AB_HB) = kreg1; *(LAS u32x4*)(b_ + AB_HB + 9216) = vreg1; } while (0)
    AB_LOAD(j0); AB_STORE(j0);
    for (int j = j0; j < 10; ++j) {
        __syncthreads();
        if (j + 1 < 10) AB_LOAD(j + 1);
        const int t = j - csel;
        if (t >= 0 && t < 9) {
            LAS const unsigned char* kb = lds + (j & 1) * AB_BUF + hsel * AB_HB; LAS const unsigned char* vb = kb + 9216;
            f32x16 s0, s1;
#pragma unroll
            for (int r = 0; r < 16; ++r) { s0[r] = 0.f; s1[r] = 0.f; }
#pragma unroll
            for (int d0 = 0; d0 < 4; ++d0) {
                const bf16x8 k0 = *(const LAS bf16x8*)(kb + r32 * ATT_VP + (16 * d0 + 8 * hi) * 2), k1 = *(const LAS bf16x8*)(kb + (32 + r32) * ATT_VP + (16 * d0 + 8 * hi) * 2);
                s0 = __builtin_amdgcn_mfma_f32_32x32x16_bf16(k0, qfr[d0], s0, 0, 0, 0); s1 = __builtin_amdgcn_mfma_f32_32x32x16_bf16(k1, qfr[d0], s1, 0, 0, 0); }
            if (t < 6) {
#pragma unroll
                for (int r = 0; r < 16; ++r) { s0[r] += cb; s1[r] += cb; }
            } else {
                const int relb = 64 * (8 - t) + 32 * qh + r32 + 128;
#pragma unroll
                for (int r = 0; r < 16; ++r) { const int i0 = relb - crow(r, hi); s0[r] += btab[i0 > 256 ? 256 : i0]; const int i1 = i0 - 32; s1[r] += btab[i1 > 256 ? 256 : i1]; }
            }
            float tm = fmaxf(s0[0], s1[0]);
#pragma unroll
            for (int r = 1; r < 16; ++r) tm = fmaxf(tm, fmaxf(s0[r], s1[r]));
            tm = fmaxf(tm, __shfl_xor(tm, 32));
            const float mn = fmaxf(mrun, tm), sc = __expf(mrun - mn); mrun = mn;
            float ps = 0.f;
#pragma unroll
            for (int r = 0; r < 16; ++r) { s0[r] = __expf(s0[r] - mn); s1[r] = __expf(s1[r] - mn); ps += s0[r] + s1[r]; }
            lrun = lrun * sc + ps;
#pragma unroll
            for (int r = 0; r < 16; ++r) { oT[0][r] *= sc; oT[1][r] *= sc; }
            bf16x8 pf[4]; pf[0] = pack8(s0, 0); pf[1] = pack8(s0, 8); pf[2] = pack8(s1, 0); pf[3] = pack8(s1, 8);
#pragma unroll
            for (int dh = 0; dh < 2; ++dh)
#pragma unroll
                for (int kc = 0; kc < 4; ++kc) {
                    LAS const unsigned char* p = vb + traddr + (16 * kc) * ATT_VP + dh * 64;
                    const bf16x8 vf = cat8(tr16(p), tr16(p + 8 * ATT_VP));
                    oT[dh] = __builtin_amdgcn_mfma_f32_32x32x16_bf16(vf, pf[kc], oT[dh], 0, 0, 0);
                }
        }
        if (j + 1 < 10) AB_STORE(j + 1);
    }
#undef AB_LOAD
#undef AB_STORE
    {
        const float lt = lrun + __shfl_xor(lrun, 32), inv = 1.0f / lt;
        bf16* orow = OB + ((size_t)sb * 2048 + (size_t)c * 64 + 32 * qh + r32) * 1024 + hoff;
#pragma unroll
        for (int dh = 0; dh < 2; ++dh)
#pragma unroll
            for (int rg = 0; rg < 4; ++rg) { u32x2 wv; wv.x = pk2(oT[dh][4 * rg] * inv, oT[dh][4 * rg + 1] * inv); wv.y = pk2(oT[dh][4 * rg + 2] * inv, oT[dh][4 * rg + 3] * inv);
                *(u32x2*)(orow + 32 * dh + 8 * rg + 4 * hi) = wv; }
    }
}
template <int MODE> __device__ __forceinline__ void small_gemm_res(LAS unsigned char* lds, const bf16* A, const bf16* Bt, int K, const float* base, const bf16* baseb, float* H, bf16* XN, float* SS, float alpha, const bf16* GGs, int bx, int G, int tid) {
    const int lane = tid & 63, w = __builtin_amdgcn_readfirstlane(tid >> 6), r32 = lane & 31, hi = lane >> 5;
    const int kw = K >> 3;
    LAS float* P = (LAS float*)lds;
    for (int tile = bx; tile < 256; tile += G) {
        const int t0 = (tile >> 4) * 32, n0 = (tile & 15) * 64;
        f32x16 acc0, acc1;
#pragma unroll
        for (int r = 0; r < 16; ++r) { acc0[r] = 0.f; acc1[r] = 0.f; }
        const bf16* ap = A + (size_t)(t0 + r32) * K + w * kw + 8 * hi;
        const bf16* b0p = Bt + (size_t)(n0 + r32) * K + w * kw + 8 * hi; const bf16* b1p = b0p + (size_t)32 * K;
#pragma unroll 4
        for (int k = 0; k < kw; k += 16) {
            const bf16x8 x = *(const bf16x8*)(ap + k), w0 = *(const bf16x8*)(b0p + k), w1 = *(const bf16x8*)(b1p + k);
            acc0 = __builtin_amdgcn_mfma_f32_32x32x16_bf16(w0, x, acc0, 0, 0, 0); acc1 = __builtin_amdgcn_mfma_f32_32x32x16_bf16(w1, x, acc1, 0, 0, 0);
        }
        LAS float* Pw = P + w * 2112;
#pragma unroll
        for (int r = 0; r < 16; ++r) { Pw[crow(r, hi) * 33 + r32] = acc0[r]; Pw[(32 + crow(r, hi)) * 33 + r32] = acc1[r]; }
        __syncthreads();
        const int tok = tid >> 4, nq = tid & 15;
        float v[4] = {0.f, 0.f, 0.f, 0.f};
#pragma unroll
        for (int ww = 0; ww < 8; ++ww)
#pragma unroll
            for (int e = 0; e < 4; ++e) v[e] += P[ww * 2112 + (4 * nq + e) * 33 + tok];
        const size_t off = (size_t)(t0 + tok) * 1024 + n0 + 4 * nq;
        if (MODE == 0) {
            f32x4 b; if (baseb) { const u32x2 bw = *(const u32x2*)(baseb + off); b = (f32x4){bflo(bw.x), bfhi(bw.x), bflo(bw.y), bfhi(bw.y)}; } else b = *(const f32x4*)(base + off);
            const f32x4 hv = (f32x4){b[0] + alpha * v[0], b[1] + alpha * v[1], b[2] + alpha * v[2], b[3] + alpha * v[3]};
            if (H) *(f32x4*)(H + off) = hv;
            if (XN) { u32x2 xw; xw.x = pk2(hv[0], hv[1]); xw.y = pk2(hv[2], hv[3]); *(u32x2*)(XN + off) = xw; }
            if (SS) { float ss = (hv[0] * hv[0] + hv[1] * hv[1]) + (hv[2] * hv[2] + hv[3] * hv[3]);
                ss += __shfl_xor(ss, 1); ss += __shfl_xor(ss, 2); ss += __shfl_xor(ss, 4); ss += __shfl_xor(ss, 8);
                if (nq == 0) SS[(size_t)(t0 + tok) * 16 + (n0 >> 6)] = ss; }
        } else {
            const u32x2 gw = *(const u32x2*)(GGs + (size_t)(t0 + tok) * 2048 + n0 + 4 * nq);
            f32x4 o = (f32x4){pg8::fast_sigmoid(bflo(gw.x)) * v[0], pg8::fast_sigmoid(bfhi(gw.x)) * v[1], pg8::fast_sigmoid(bflo(gw.y)) * v[2], pg8::fast_sigmoid(bfhi(gw.y)) * v[3]};
            if (MODE == 1) { u32x2 xw; xw.x = pk2(o[0], o[1]); xw.y = pk2(o[2], o[3]); *(u32x2*)(XN + off) = xw; }
            else { const u32x2 tw = *(const u32x2*)(baseb + off); o += (f32x4){bflo(tw.x), bfhi(tw.x), bflo(tw.y), bfhi(tw.y)};
                u32x2 xw; xw.x = pk2(o[0], o[1]); xw.y = pk2(o[2], o[3]); *(u32x2*)(XN + off) = xw; }
        }
        __syncthreads();
    }
}
constexpr int G_QD = 0, G_KI = 17408, G_VV = 34816, G_B = 71680, G_FA = 105472, G_SEG = 109568, G_SSQ = 111616;
constexpr int GP = 272, GVP = 576, GBP = 132;
constexpr size_t WS_DECB = (size_t)1056 * 65536;
__device__ __forceinline__ bf16* ub_slot(unsigned char* ybase, int unit, int) { return (bf16*)ybase + (size_t)unit * 32768; }
__device__ __forceinline__ void gla_a_unit(LAS unsigned char* lds, bf16* QKA, bf16* VA, const float* FA, unsigned char* ws, int xnrow0, float* DECB, int lchunk, int h,
                                           const float* wgate, const float* bgate, int tid) {
    const int lane = tid & 63, w = __builtin_amdgcn_readfirstlane(tid >> 6), r32 = lane & 31, hi = lane >> 5, g16 = lane >> 4, i16 = lane & 15;
    const int gd = tid & 127, tq = tid >> 7;
    LAS float* Bimg = (LAS float*)(lds + G_B); LAS float* FAi = (LAS float*)(lds + G_FA); LAS float* SEG = (LAS float*)(lds + G_SEG);
    const int trrow = (g16 >> 1) * 4 + (i16 >> 2), trcol = (g16 & 1) * 16 + (i16 & 3) * 4;
    const size_t row0 = (size_t)lchunk * 64; const int unit = lchunk * 4 + h;
    u32x4 qv[2], kv[2];
#pragma unroll
    for (int i = 0; i < 2; ++i) { const int id = tid + 512 * i, row = id >> 4, ch = id & 15; const bf16* p = QKA + (row0 + row) * 1024 + h * 128 + ch * 8; qv[i] = *(const u32x4*)p; kv[i] = *(const u32x4*)(p + 512); }
    if (tid < 256) *(LAS f32x4*)(FAi + tid * 4) = *(const f32x4*)(FA + row0 * 16 + tid * 4);
#pragma unroll
    for (int i = 0; i < 4; ++i) { const int id = tid + 512 * i, row = id >> 5, ch = id & 31; *(LAS u32x4*)(lds + G_VV + row * GVP + ch * 16) = *(const u32x4*)(VA + (row0 + row) * 1024 + h * 256 + ch * 8); }
    __syncthreads();
    {
        float wg[16];
#pragma unroll
        for (int r = 0; r < 16; ++r) wg[r] = wgate[r * 512 + h * 128 + gd];
        const float bg = bgate[h * 128 + gd];
        float run = 0.f;
#pragma unroll
        for (int tt = 0; tt < 16; ++tt) { const int t = tq * 16 + tt; const LAS f32x4* fp = (const LAS f32x4*)(FAi + t * 16); float x = bg;
#pragma unroll
            for (int q = 0; q < 4; ++q) { const f32x4 f = fp[q]; x += f[0] * wg[4 * q] + f[1] * wg[4 * q + 1] + f[2] * wg[4 * q + 2] + f[3] * wg[4 * q + 3]; }
            const float ls = fminf(x, 0.f) - __logf(1.0f + __expf(-fabsf(x))); run += ls * 0.0625f; Bimg[t * GBP + gd] = run;
            if ((tt & 3) == 3) asm volatile("" ::: "memory"); }
        SEG[tq * 128 + gd] = run;
    }
    __syncthreads();
#pragma unroll
    for (int i = 0; i < 2; ++i) { const int id = tid + 512 * i, row = id >> 4, ch = id & 15;
        f32x4 b0 = *(const LAS f32x4*)(Bimg + row * GBP + ch * 8), b1 = *(const LAS f32x4*)(Bimg + row * GBP + ch * 8 + 4);
        f32x4 l0 = (f32x4){0.f, 0.f, 0.f, 0.f}, l1 = l0;
#pragma unroll
        for (int q = 0; q < 4; ++q) { const f32x4 s0v = *(const LAS f32x4*)(SEG + q * 128 + ch * 8), s1v = *(const LAS f32x4*)(SEG + q * 128 + ch * 8 + 4);
            l0 += s0v; l1 += s1v; if (q < (row >> 4)) { b0 += s0v; b1 += s1v; } }
        if (row == 0) { float* dp = DECB + (size_t)unit * 128 + ch * 8;
            *(f32x4*)dp = (f32x4){__expf(l0[0]), __expf(l0[1]), __expf(l0[2]), __expf(l0[3])}; *(f32x4*)(dp + 4) = (f32x4){__expf(l1[0]), __expf(l1[1]), __expf(l1[2]), __expf(l1[3])}; }
        const float bb[8] = {b0[0], b0[1], b0[2], b0[3], b1[0], b1[1], b1[2], b1[3]};
        const unsigned qw[4] = {qv[i].x, qv[i].y, qv[i].z, qv[i].w}, kw[4] = {kv[i].x, kv[i].y, kv[i].z, kv[i].w};
        unsigned oq[4], oi[4];
#pragma unroll
        for (int e = 0; e < 4; ++e) { const float q0 = bflo(qw[e]), q1 = bfhi(qw[e]), k0 = bflo(kw[e]), k1 = bfhi(kw[e]);
            const float e0 = __expf(bb[2 * e]), e1 = __expf(bb[2 * e + 1]), n0 = __expf(-bb[2 * e]), n1 = __expf(-bb[2 * e + 1]);
            oq[e] = pk2(q0 * e0, q1 * e1); oi[e] = pk2(k0 * n0, k1 * n1); }
        const u32x4 qd = (u32x4){oq[0], oq[1], oq[2], oq[3]};
        *(LAS u32x4*)(lds + G_QD + row * GP + ch * 16) = qd;
        *(LAS u32x4*)(lds + G_KI + row * GP + ch * 16) = (u32x4){oi[0], oi[1], oi[2], oi[3]};
        *(u32x4*)(QKA + (row0 + row) * 1024 + h * 128 + ch * 8) = qd; }
    __syncthreads();
    bf16x8 vvf[4];
#pragma unroll
    for (int kc = 0; kc < 4; ++kc) { LAS const unsigned char* p = lds + G_VV + (16 * kc + trrow) * GVP + (32 * w + trcol) * 2; vvf[kc] = cat8(tr16(p), tr16(p + 8 * GVP)); }
    f32x16 s00, s01, s11;
#pragma unroll
    for (int r = 0; r < 16; ++r) { s00[r] = 0.f; s01[r] = 0.f; s11[r] = 0.f; }
#pragma unroll
    for (int s = 0; s < 8; ++s) {
        const bf16x8 a0 = *(const LAS bf16x8*)(lds + G_KI + r32 * GP + (16 * s + 8 * hi) * 2), a1 = *(const LAS bf16x8*)(lds + G_KI + (32 + r32) * GP + (16 * s + 8 * hi) * 2);
        const bf16x8 b0 = *(const LAS bf16x8*)(lds + G_QD + r32 * GP + (16 * s + 8 * hi) * 2), b1 = *(const LAS bf16x8*)(lds + G_QD + (32 + r32) * GP + (16 * s + 8 * hi) * 2);
        s00 = __builtin_amdgcn_mfma_f32_32x32x16_bf16(a0, b0, s00, 0, 0, 0); s01 = __builtin_amdgcn_mfma_f32_32x32x16_bf16(a0, b1, s01, 0, 0, 0); s11 = __builtin_amdgcn_mfma_f32_32x32x16_bf16(a1, b1, s11, 0, 0, 0);
    }
#pragma unroll
    for (int r = 0; r < 16; ++r) if (crow(r, hi) > r32) { s00[r] = 0.f; s11[r] = 0.f; }
    const bf16x8 p00a = pack8(s00, 0), p00b = pack8(s00, 8), p01a = pack8(s01, 0), p01b = pack8(s01, 8), p11a = pack8(s11, 0), p11b = pack8(s11, 8);
    f32x16 oT0, oT1;
#pragma unroll
    for (int r = 0; r < 16; ++r) { oT0[r] = 0.f; oT1[r] = 0.f; }
    oT0 = __builtin_amdgcn_mfma_f32_32x32x16_bf16(vvf[0], p00a, oT0, 0, 0, 0); oT0 = __builtin_amdgcn_mfma_f32_32x32x16_bf16(vvf[1], p00b, oT0, 0, 0, 0);
    oT1 = __builtin_amdgcn_mfma_f32_32x32x16_bf16(vvf[0], p01a, oT1, 0, 0, 0); oT1 = __builtin_amdgcn_mfma_f32_32x32x16_bf16(vvf[1], p01b, oT1, 0, 0, 0);
    oT1 = __builtin_amdgcn_mfma_f32_32x32x16_bf16(vvf[2], p11a, oT1, 0, 0, 0); oT1 = __builtin_amdgcn_mfma_f32_32x32x16_bf16(vvf[3], p11b, oT1, 0, 0, 0);
    { bf16* p0 = VA + (row0 + (2 * w) * 4 + g16) * 1024 + h * 256 + i16 * 16; bf16* p1 = p0 + 4 * 1024;
      *(u32x4*)p0 = __builtin_bit_cast(u32x4, pack8(oT0, 0)); *(u32x4*)(p0 + 8) = __builtin_bit_cast(u32x4, pack8(oT0, 8));
      *(u32x4*)p1 = __builtin_bit_cast(u32x4, pack8(oT1, 0)); *(u32x4*)(p1 + 8) = __builtin_bit_cast(u32x4, pack8(oT1, 8)); }
    bf16* up = ub_slot(ws, unit, xnrow0) + (size_t)w * 4096 + lane * 8;
#pragma unroll
    for (int db = 0; db < 4; ++db) { f32x16 uacc;
#pragma unroll
        for (int r = 0; r < 16; ++r) uacc[r] = 0.f;
#pragma unroll
        for (int kc = 0; kc < 4; ++kc) { LAS const unsigned char* p = lds + G_KI + (16 * kc + trrow) * GP + (32 * db + trcol) * 2;
            uacc = __builtin_amdgcn_mfma_f32_32x32x16_bf16(cat8(tr16(p), tr16(p + 8 * GP)), vvf[kc], uacc, 0, 0, 0); }
        *(u32x4*)(up + (db * 2) * 512) = __builtin_bit_cast(u32x4, pack8(uacc, 0)); *(u32x4*)(up + (db * 2 + 1) * 512) = __builtin_bit_cast(u32x4, pack8(uacc, 8)); }
    __syncthreads();
}

__device__ __forceinline__ void gla_scan_vec(unsigned char* ws, int xnrow0, const float* DECB, int lchunk0, int nchunks, int h, int e, const float* s0, float* sout) {
    const int lane = e & 63, s2 = (e >> 6) & 1, db = (e >> 7) & 3, w = e >> 9, hi = lane >> 5, r32 = lane & 31;
    const int dbase = 32 * db + 16 * s2 + 4 * hi, v = 32 * w + r32;
    float S[8];
#pragma unroll
    for (int jj = 0; jj < 8; ++jj) S[jj] = s0 ? s0[(size_t)(dbase + 8 * (jj >> 2) + (jj & 3)) * 256 + v] : 0.f;
    for (int n0 = 0; n0 < nchunks; n0 += 4) {
        u32x4 uw[4]; f32x4 d0[4], d1[4]; bf16* up[4];
#pragma unroll
        for (int q = 0; q < 4; ++q) { const int n = (n0 + q < nchunks) ? n0 + q : nchunks - 1; const int unit = (lchunk0 + n) * 4 + h;
            up[q] = ub_slot(ws, unit, xnrow0) + (size_t)e * 8; uw[q] = *(const u32x4*)up[q];
            d0[q] = *(const f32x4*)(DECB + (size_t)unit * 128 + dbase); d1[q] = *(const f32x4*)(DECB + (size_t)unit * 128 + dbase + 8); }
#pragma unroll
        for (int q = 0; q < 4; ++q) if (n0 + q < nchunks) {
            *(u32x4*)up[q] = (u32x4){pk2(S[0], S[1]), pk2(S[2], S[3]), pk2(S[4], S[5]), pk2(S[6], S[7])};
            S[0] = d0[q][0] * (S[0] + bflo(uw[q].x)); S[1] = d0[q][1] * (S[1] + bfhi(uw[q].x)); S[2] = d0[q][2] * (S[2] + bflo(uw[q].y)); S[3] = d0[q][3] * (S[3] + bfhi(uw[q].y));
            S[4] = d1[q][0] * (S[4] + bflo(uw[q].z)); S[5] = d1[q][1] * (S[5] + bfhi(uw[q].z)); S[6] = d1[q][2] * (S[6] + bflo(uw[q].w)); S[7] = d1[q][3] * (S[7] + bfhi(uw[q].w)); }
    }
#pragma unroll
    for (int jj = 0; jj < 8; ++jj) sout[(size_t)(dbase + 8 * (jj >> 2) + (jj & 3)) * 256 + v] = S[jj];
}

__device__ __forceinline__ void gla_c_unit(LAS unsigned char* lds, const bf16* QKA, const bf16* VA, const bf16* RA, unsigned char* ws, int xnrow0, bf16* OA, int lchunk, int h, const float* gnorm, int tid) {
    const int lane = tid & 63, w = __builtin_amdgcn_readfirstlane(tid >> 6), r32 = lane & 31, hi = lane >> 5, g16 = lane >> 4, i16 = lane & 15;
    LAS float* SSQ = (LAS float*)(lds + G_SSQ);
    const size_t row0 = (size_t)lchunk * 64; const int unit = lchunk * 4 + h;
#pragma unroll
    for (int i = 0; i < 2; ++i) { const int id = tid + 512 * i, row = id >> 4, ch = id & 15; *(LAS u32x4*)(lds + G_QD + row * GP + ch * 16) = *(const u32x4*)(QKA + (row0 + row) * 1024 + h * 128 + ch * 8); }
    bf16x8 sf[8];
    { const bf16* up = ub_slot(ws, unit, xnrow0) + (size_t)w * 4096 + lane * 8;
#pragma unroll
      for (int f = 0; f < 8; ++f) sf[f] = *(const bf16x8*)(up + f * 512); }
    u32x2 rwv[2][4];
#pragma unroll
    for (int ib = 0; ib < 2; ++ib)
#pragma unroll
        for (int rg = 0; rg < 4; ++rg) rwv[ib][rg] = *(const u32x2*)(RA + (row0 + 32 * ib + r32) * 1024 + h * 256 + 32 * w + 4 * hi + 8 * rg);
    f32x16 oT0, oT1;
    { const bf16* p0 = VA + (row0 + (2 * w) * 4 + g16) * 1024 + h * 256 + i16 * 16; const bf16* p1 = p0 + 4 * 1024;
      const u32x4 a0 = *(const u32x4*)p0, a1 = *(const u32x4*)(p0 + 8), c0 = *(const u32x4*)p1, c1 = *(const u32x4*)(p1 + 8);
      const unsigned aw[8] = {a0.x, a0.y, a0.z, a0.w, a1.x, a1.y, a1.z, a1.w}, cw[8] = {c0.x, c0.y, c0.z, c0.w, c1.x, c1.y, c1.z, c1.w};
#pragma unroll
      for (int q = 0; q < 8; ++q) { oT0[2 * q] = bflo(aw[q]); oT0[2 * q + 1] = bfhi(aw[q]); oT1[2 * q] = bflo(cw[q]); oT1[2 * q + 1] = bfhi(cw[q]); } }
    __syncthreads();
#pragma unroll
    for (int db = 0; db < 4; ++db)
#pragma unroll
        for (int s2 = 0; s2 < 2; ++s2) { const int dcol = (32 * db + 16 * s2 + 4 * hi) * 2;
            LAS const unsigned char* p0 = lds + G_QD + r32 * GP + dcol; LAS const unsigned char* p1 = lds + G_QD + (32 + r32) * GP + dcol;
            const bf16x8 qb0 = cat8(*(const LAS s16x4*)p0, *(const LAS s16x4*)(p0 + 16)), qb1 = cat8(*(const LAS s16x4*)p1, *(const LAS s16x4*)(p1 + 16));
            oT0 = __builtin_amdgcn_mfma_f32_32x32x16_bf16(sf[db * 2 + s2], qb0, oT0, 0, 0, 0); oT1 = __builtin_amdgcn_mfma_f32_32x32x16_bf16(sf[db * 2 + s2], qb1, oT1, 0, 0, 0); }
    float ss0 = 0.f, ss1 = 0.f;
#pragma unroll
    for (int r = 0; r < 16; ++r) { ss0 += oT0[r] * oT0[r]; ss1 += oT1[r] * oT1[r]; }
    ss0 += __shfl_xor(ss0, 32); ss1 += __shfl_xor(ss1, 32);
    if (hi == 0) { SSQ[w * 64 + r32] = ss0; SSQ[w * 64 + 32 + r32] = ss1; }
    __syncthreads();
    f32x4 gnv[4];
#pragma unroll
    for (int rg = 0; rg < 4; ++rg) gnv[rg] = *(const f32x4*)(gnorm + h * 256 + 32 * w + 8 * rg + 4 * hi);
    float t0 = 0.f, t1 = 0.f;
#pragma unroll
    for (int q = 0; q < 8; ++q) { t0 += SSQ[q * 64 + r32]; t1 += SSQ[q * 64 + 32 + r32]; }
    const float rs0 = rsqrtf(t0 * (1.f / 256.f) + 1e-6f), rs1 = rsqrtf(t1 * (1.f / 256.f) + 1e-6f);
#pragma unroll
    for (int ib = 0; ib < 2; ++ib) { int rr = 32 * ib + r32; asm volatile("" : "+v"(rr)); const size_t rowoff = (row0 + rr) * 1024 + h * 256 + 32 * w + 4 * hi; const float rs = ib ? rs1 : rs0;
#pragma unroll
        for (int rg = 0; rg < 4; ++rg) { const u32x2 rw = rwv[ib][rg];
            const float r0 = bflo(rw.x), r1 = bfhi(rw.x), r2 = bflo(rw.y), r3 = bfhi(rw.y);
            const float o0 = (ib ? oT1[4 * rg] : oT0[4 * rg]) * rs * gnv[rg][0] * r0 * pg8::fast_sigmoid(r0), o1 = (ib ? oT1[4 * rg + 1] : oT0[4 * rg + 1]) * rs * gnv[rg][1] * r1 * pg8::fast_sigmoid(r1);
            const float o2 = (ib ? oT1[4 * rg + 2] : oT0[4 * rg + 2]) * rs * gnv[rg][2] * r2 * pg8::fast_sigmoid(r2), o3 = (ib ? oT1[4 * rg + 3] : oT0[4 * rg + 3]) * rs * gnv[rg][3] * r3 * pg8::fast_sigmoid(r3);
            u32x2 ow; ow.x = pk2(o0, o1); ow.y = pk2(o2, o3); *(u32x2*)(OA + rowoff + 8 * rg) = ow; } }
}
__global__ void __launch_bounds__(NTHREADS, 2) fwd_megakernel(Args a) {
    extern __shared__ __attribute__((aligned(16))) unsigned char lds_raw[];
    LAS unsigned char* lds = (LAS unsigned char*)lds_raw;
    cg::grid_group grid = cg::this_grid();
    const int G = gridDim.x, bx = blockIdx.x;
    const int wave0 = __builtin_amdgcn_readfirstlane((int)threadIdx.x >> 6);
#define MK_TID() (wave0 * 64 + (int)__builtin_amdgcn_mbcnt_hi(~0u, __builtin_amdgcn_mbcnt_lo(~0u, 0u)))
    volatile LAS unsigned* xst = (volatile LAS unsigned*)(lds + XST_OFF);
    if (threadIdx.x < 4) xst[threadIdx.x] = 0u;
    __syncthreads();
    (void)xcd_barrier_post((unsigned*)(a.ws + WS_CTL), xst);
    unsigned char* ws = (unsigned char*)(GASP unsigned char*)a.ws; float* out = (float*)(GASP float*)a.out;
#define RELOAD_PTRS() do { size_t z_ = 0; asm volatile("" : "+s"(z_)); ws = (unsigned char*)((GASP unsigned char*)a.ws + z_); out = (float*)((GASP float*)a.out + z_); } while (0)
#define GRID_SYNC() do { XcdBarrier b_; b_.bar = (unsigned*)(ws + WS_CTL); b_.x = xb_xcc_id(); b_.st = (volatile LAS unsigned*)(lds + XST_OFF); xcd_barrier(b_, MK_TID() == 0); RELOAD_PTRS(); } while (0)
#define GRID_SYNC_CG() do { grid.sync(); GRID_SYNC(); } while (0)
#define LAUNDER_TID() int tid = MK_TID(); asm volatile("" : "+v"(tid)); const int lane = tid & 63, wave = __builtin_amdgcn_readfirstlane(tid >> 6)
#define W1T ((bf16*)(ws + WS_W1T))
#define W1OT ((bf16*)(ws + WS_W1OT))
#define WINT ((bf16*)(ws + WS_WINT))
#define WBGT ((bf16*)(ws + WS_WBGT))
#define WBAT ((bf16*)(ws + WS_WBAT))
#define WOUTT ((bf16*)(ws + WS_WOUTT))
#define W2T ((bf16*)(ws + WS_W2T))
#define W2OT ((bf16*)(ws + WS_W2OT))
#define CKB ((bf16*)(ws + WS_CKB))
#define CVB ((bf16*)(ws + WS_CVB))
#define XN ((bf16*)(ws + WS_XN))
#define SS1 ((float*)(ws + WS_SS1))
#define SS2 ((float*)(ws + WS_SS2))
#define ACT ((bf16*)(ws + WS_ACT))
#define PB ((bf16*)(ws + WS_PB))
#define GG ((bf16*)(ws + WS_GG))
#define FA ((float*)(ws + WS_FA))
#define OA ((bf16*)(ws + WS_OA))
#define OB ((bf16*)(ws + WS_OB))
#define TMP ((bf16*)(ws + WS_TMP))
#define MIX ((bf16*)((unsigned char*)(out + O_Y) + (size_t)75497472))
#define H (out + O_Y)
    constexpr size_t PBE = PBS / 2;

#ifndef REP_P0
#define REP_P0 1
#endif
    for (int rp0 = 0; rp0 < REP_P0; ++rp0) {
        LAUNDER_TID();
        const int gw = bx * NWAVES + wave, NGW = G * NWAVES;
        for (int it = bx; it < 16 * 22; it += G) transpose_tile_block(1, AIN(6), 5632, 1024, 5632, W1T, AIN(5), it, lds, tid);
        __syncthreads();
        for (int m4 = gw; m4 < T_ALL / 4; m4 += NGW) { const int m = 4 * m4;
            const float* xr = (m < T_P) ? AIN(0) + (size_t)m * 1024 : AIN(1) + (size_t)(m - T_P) * 1024;
            rms_rows4_to_bf16(xr, XN + (size_t)m * 1024, lane); }
    }
    GRID_SYNC();
#ifndef REP_P1
#define REP_P1 1
#endif
    for (int rep1 = 0; rep1 < REP_P1; ++rep1) {
      if (rep1) { GRID_SYNC(); }
 pg8::Gemm g{XN, W1T, T_ALL, 5632, 1024}; pg8::StaticOrder S; S.init(T_ALL, 5632, G, bx); pg8::EpiSwiglu E{ACT, nullptr};
      pg8::gemm_phase<pg8::EpiSwiglu, pg8::StaticOrder, true, true>(lds, g, S, E, MK_TID()); }
    {
        LAUNDER_TID();
        const int nwg = (T_ALL / 256) * 22, rounds = (nwg + G - 1) / G, first_idle = nwg - (rounds - 1) * G;
        const bool all = (first_idle >= G); const int ib = all ? bx : bx - first_idle, nib = all ? G : G - first_idle;
        if (ib >= 0) {
            constexpr int I1 = 44 * 4, I2 = 16 * 33, I3 = 16 * 4, I6 = 16 * 22, I7 = I1, NDEF = I1 + I2 + 3 * I3 + I6 + I7;
            for (int it = ib; it < NDEF; it += nib) {
                int r = it;
                if (r < I1) { transpose_tile_block(0, AIN(7), 1024, 2816, 1024, W1OT, nullptr, r, lds, tid); continue; } r -= I1;
                if (r < I2) { transpose_tile_block(2, AIN(9), NPROJ_SRC, 1024, NPROJ, WINT, AIN(8), r, lds, tid); continue; } r -= I2;
                if (r < I3) { transpose_tile_block(0, AIN(14), 1024, 1024, 1024, WBGT, nullptr, r, lds, tid); continue; } r -= I3;
                if (r < I3) { transpose_tile_block(0, AIN(15), 1024, 1024, 1024, WBAT, nullptr, r, lds, tid); continue; } r -= I3;
                if (r < I3) { transpose_tile_block(0, AIN(16), 1024, 1024, 1024, WOUTT, nullptr, r, lds, tid); continue; } r -= I3;
                if (r < I6) { transpose_tile_block(1, AIN(18), 5632, 1024, 5632, W2T, AIN(17), r, lds, tid); continue; } r -= I6;
                transpose_tile_block(0, AIN(19), 1024, 2816, 1024, W2OT, nullptr, r, lds, tid);
            }
            const size_t nvec = (size_t)8 * 512 * 1024 / 8;
            for (size_t v = (size_t)ib * NTHREADS + tid; v < nvec; v += (size_t)nib * NTHREADS) {
                const f32x4 k0 = __builtin_nontemporal_load((const f32x4*)(AIN(2) + v * 8)), k1 = __builtin_nontemporal_load((const f32x4*)(AIN(2) + v * 8 + 4)), v0 = __builtin_nontemporal_load((const f32x4*)(AIN(3) + v * 8)), v1 = __builtin_nontemporal_load((const f32x4*)(AIN(3) + v * 8 + 4));
                *(u32x4*)(CKB + v * 8) = (u32x4){pk2(k0[0], k0[1]), pk2(k0[2], k0[3]), pk2(k1[0], k1[1]), pk2(k1[2], k1[3])};
                *(u32x4*)(CVB + v * 8) = (u32x4){pk2(v0[0], v0[1]), pk2(v0[2], v0[3]), pk2(v1[0], v1[1]), pk2(v1[2], v1[3])};
            }
        }
    }
    GRID_SYNC();
#ifndef REP_P2
#define REP_P2 1
#endif
    for (int rp2 = 0; rp2 < REP_P2; ++rp2)
    { pg8::Gemm g{ACT, W1OT, T_P, 1024, 2816}; pg8::StaticOrder S; S.init(T_P, 1024, G, bx); pg8::EpiRes E{AIN(0), AIN(1), 128, nullptr, nullptr, XN, SS1, 0.5f};
      pg8::gemm_phase<pg8::EpiRes, pg8::StaticOrder, true, true>(lds, g, S, E, MK_TID()); }
    { LAUNDER_TID(); (void)lane; (void)wave; small_gemm_res<0>(lds, ACT + (size_t)T_P * DFF, W1OT, DFF, AIN(1), nullptr, nullptr, XN + (size_t)T_P * 1024, SS1 + (size_t)T_P * 16, 0.5f, nullptr, bx, G, tid); }
    GRID_SYNC();
    for (int grp = 0; grp < 2; ++grp) {
        const int row0 = grp ? 16384 : 0, Mg = grp ? 16896 : 16384;
#ifndef REP_P3
#define REP_P3 1
#endif
        for (int rp3 = 0; rp3 < REP_P3; ++rp3)
        { pg8::Gemm g{XN + (size_t)row0 * 1024, WINT, Mg, NPROJ, 1024}; pg8::StaticOrder S; S.init(Mg, NPROJ, G, bx);
          pg8::EpiProj E{PB, PBE, GG, FA, SS1 + (size_t)row0 * 16, out + O_KP, out + O_VP, out + O_KS, out + O_VS, row0};
          pg8::gemm_phase<pg8::EpiProj, pg8::StaticOrder, true, true>(lds, g, S, E, MK_TID()); }
        GRID_SYNC();
        {
            LAUNDER_TID();
            const bf16* QB = PB + 3 * PBE; const bf16* KB = PB + 4 * PBE; const bf16* VB = PB + 5 * PBE;
            LAS unsigned char* wl = lds + wave * ATT_WLDS;
            const int nbu = 1024 + (grp ? 32 : 0);
#ifndef REP_ATT
#define REP_ATT 1
#endif
            for (int ra_ = 0; ra_ < REP_ATT; ++ra_)
            for (int bu = bx; bu < nbu; bu += G) {
                int lrow, h, t0, qh; bool sample = false; const bf16 *ck = CKB, *cv = CVB;
                if (bu < 1024) {
                    const int sb = bu & 7, j = bu >> 3, hp = (j >> 4) & 7, cp = ((j & 15) + 4 * (j >> 5)) & 15; attn_block_unit(lds, QB, OB, KB, VB, sb, hp, cp, AIN(13), tid); continue; }
                __syncthreads();
                { const int su = (bu - 1024) * 8 + wave, sbh = su >> 1, sb = sbh >> 4; h = sbh & 15; qh = su & 1; lrow = 16384 + sb * 64; t0 = 0; sample = true; ck = CKB + (size_t)sb * 512 * 1024 + h * 64; cv = CVB + (size_t)sb * 512 * 1024 + h * 64; }
                const size_t off = (size_t)lrow * 1024 + h * 64;
                if (qh) attn_unit(wl, QB + off, OB + off, KB + off, VB + off, ck, cv, sample, t0, AIN(13) + h * 257, lane, 1);
                else attn_unit(wl, QB + off, OB + off, KB + off, VB + off, ck, cv, sample, t0, AIN(13) + h * 257, lane, 0);
            }
        }
        {
            LAUNDER_TID();
            __syncthreads();
            const int nun = (grp ? 264 : 256) * 4;
            for (int u = G - 1 - bx; u < nun; u += G) gla_a_unit(lds, PB, PB + PBE, FA, (unsigned char*)H, row0, (float*)((unsigned char*)H + WS_DECB), u >> 2, u & 3, AIN(10), AIN(11), tid);
        }
        GRID_SYNC();
        {
            LAUNDER_TID();
            const int gt = bx * NTHREADS + tid, nthr = G * NTHREADS;
            for (int v = gt; v < 32 * 4096; v += nthr) { const int pair = v >> 12, e = v & 4095, sb = pair >> 2, h = pair & 3;
                gla_scan_vec((unsigned char*)H, row0, (const float*)((unsigned char*)H + WS_DECB), sb * 32, 32, h, e, nullptr, out + O_GP + (size_t)((8 * grp + sb) * 4 + h) * 32768); }
            if (grp) for (int v = gt; v < 32 * 4096; v += nthr) { const int pair = v >> 12, e = v & 4095, sb = pair >> 2, h = pair & 3;
                gla_scan_vec((unsigned char*)H, row0, (const float*)((unsigned char*)H + WS_DECB), 256 + sb, 1, h, e, AIN(4) + (size_t)(sb * 4 + h) * 32768, out + O_GS + (size_t)(sb * 4 + h) * 32768); }
        }
        GRID_SYNC();
        {
            LAUNDER_TID();
            const int nun = (grp ? 264 : 256) * 4;
#ifndef REP_C
#define REP_C 1
#endif
            for (int rc_ = 0; rc_ < REP_C; ++rc_)
            for (int u = bx; u < nun; u += G) gla_c_unit(lds, PB, PB + PBE, PB + 2 * PBE, (unsigned char*)H, row0, OA, u >> 2, u & 3, AIN(12), tid);
        }
        GRID_SYNC();
        { pg8::Gemm g{OA, WBGT, 16384, 1024, 1024}; pg8::StaticOrder S; S.init(16384, 1024, G, bx); pg8::EpiGate<0> E{GG, 0, TMP, MIX};
          pg8::gemm_phase<pg8::EpiGate<0>, pg8::StaticOrder, true, true>(lds, g, S, E, MK_TID()); }
        if (grp) { LAUNDER_TID(); (void)lane; (void)wave; small_gemm_res<1>(lds, OA + (size_t)16384 * 1024, WBGT, 1024, nullptr, nullptr, nullptr, TMP + (size_t)16384 * 1024, nullptr, 0.f, GG + (size_t)16384 * 2048, bx, G, tid); }
        { pg8::Gemm g{OB, WBAT, 16384, 1024, 1024}; pg8::StaticOrder S; S.init(16384, 1024, G, bx); pg8::EpiGate<1> E{GG, 1024, TMP, MIX};
          pg8::gemm_phase<pg8::EpiGate<1>, pg8::StaticOrder, true, true>(lds, g, S, E, MK_TID()); }
        if (grp) { LAUNDER_TID(); (void)lane; (void)wave; small_gemm_res<2>(lds, OB + (size_t)16384 * 1024, WBAT, 1024, nullptr, TMP + (size_t)16384 * 1024, nullptr, MIX + (size_t)16384 * 1024, nullptr, 0.f, GG + (size_t)16384 * 2048 + 1024, bx, G, tid); }
        GRID_SYNC();
        { pg8::Gemm g{MIX, WOUTT, 16384, 1024, 1024}; pg8::StaticOrder S; S.init(16384, 1024, G, bx);
          pg8::EpiRes E{nullptr, nullptr, 1 << 30, XN + (size_t)row0 * 1024, nullptr, XN + (size_t)row0 * 1024, SS2 + (size_t)row0 * 16, 1.0f};
          pg8::gemm_phase<pg8::EpiRes, pg8::StaticOrder, true, true>(lds, g, S, E, MK_TID()); }
        if (grp) { LAUNDER_TID(); (void)lane; (void)wave; small_gemm_res<0>(lds, MIX + (size_t)16384 * 1024, WOUTT, 1024, nullptr, XN + (size_t)T_P * 1024, nullptr, XN + (size_t)T_P * 1024, SS2 + (size_t)T_P * 16, 1.0f, nullptr, bx, G, tid); }
        if (grp == 1) GRID_SYNC();
    }
    { pg8::Gemm g{XN, W2T, T_ALL, 5632, 1024}; pg8::StaticOrder S; S.init(T_ALL, 5632, G, bx); pg8::EpiSwiglu E{ACT, SS2};
      pg8::gemm_phase<pg8::EpiSwiglu, pg8::StaticOrder, true, true>(lds, g, S, E, MK_TID()); }
    GRID_SYNC_CG();
    { pg8::Gemm g{ACT, W2OT, T_P, 1024, 2816}; pg8::StaticOrder S; S.init(T_P, 1024, G, bx); pg8::EpiRes E{nullptr, nullptr, 1 << 30, XN, nullptr, XN, nullptr, 0.5f};
      pg8::gemm_phase<pg8::EpiRes, pg8::StaticOrder, true, true>(lds, g, S, E, MK_TID()); }
    { LAUNDER_TID(); (void)lane; (void)wave; small_gemm_res<0>(lds, ACT + (size_t)T_P * DFF, W2OT, DFF, nullptr, XN + (size_t)T_P * 1024, nullptr, XN + (size_t)T_P * 1024, nullptr, 0.5f, nullptr, bx, G, tid); }
    GRID_SYNC();
    {
        LAUNDER_TID();
        const int gw = bx * NWAVES + wave, NGW = G * NWAVES; const f32x4* gf = (const f32x4*)AIN(20) + lane;
        f32x4 gv[4];
#pragma unroll
        for (int j = 0; j < 4; ++j) gv[j] = gf[64 * j];
        for (int m4 = gw; m4 < T_ALL / 4; m4 += NGW) { f32x4* xr = (f32x4*)(H + (size_t)m4 * 4096) + lane; const u32x2* hb = (const u32x2*)(XN + (size_t)m4 * 4096) + lane; f32x4 v[4][4]; float s[4];
#pragma unroll
            for (int q = 0; q < 4; ++q)
#pragma unroll
                for (int j = 0; j < 4; ++j) { const u32x2 w = hb[q * 256 + 64 * j]; v[q][j] = (f32x4){bflo(w.x), bfhi(w.x), bflo(w.y), bfhi(w.y)}; }
#pragma unroll
            for (int q = 0; q < 4; ++q) { s[q] = 0.f;
#pragma unroll
                for (int j = 0; j < 4; ++j) s[q] += (v[q][j].x * v[q][j].x + v[q][j].y * v[q][j].y) + (v[q][j].z * v[q][j].z + v[q][j].w * v[q][j].w); }
#pragma unroll
            for (int o = 1; o < 64; o <<= 1) {
#pragma unroll
                for (int q = 0; q < 4; ++q) s[q] += __shfl_xor(s[q], o); }
#pragma unroll
            for (int q = 0; q < 4; ++q) { const float rstd = rsqrtf(s[q] * (1.f / 1024.f) + 1e-6f);
#pragma unroll
                for (int j = 0; j < 4; ++j) xr[q * 256 + 64 * j] = v[q][j] * rstd * gv[j]; } }
    }
}

extern "C" void kernel_launch(void* const* d_in, const int* in_sizes, int n_in, void* d_out, int out_size, void* d_ws, size_t ws_size, hipStream_t stream) {
    static int grid = 0;
    if (grid == 0) {
        if (n_in != 21 || (size_t)out_size != O_END || ws_size < WS_CTL + CTL_BYTES) { fprintf(stderr, "kernel_launch: unexpected shapes (n_in %d, out %d, ws %zu); nothing launched\n", n_in, out_size, ws_size); grid = -1; return; }
        int dev = 0, cus = 0, per_cu = 0;
        hipGetDevice(&dev); hipDeviceGetAttribute(&cus, hipDeviceAttributeMultiprocessorCount, dev);
        hipFuncSetAttribute((const void*)fwd_megakernel, hipFuncAttributeMaxDynamicSharedMemorySize, LDS_BYTES);
        hipOccupancyMaxActiveBlocksPerMultiprocessor(&per_cu, (const void*)fwd_megakernel, NTHREADS, LDS_BYTES);
        if (per_cu < 1) { fprintf(stderr, "kernel_launch: occupancy query says %d blocks per CU; nothing launched\n", per_cu); grid = -1; return; }
        grid = cus;
        if (grid < 64) { fprintf(stderr, "kernel_launch: needs at least 64 CUs\n"); grid = -1; return; }
    }
    if (grid < 0) return;
    if (hipMemsetAsync((char*)d_ws + WS_CTL, 0, CTL_BYTES, stream) != hipSuccess) { fprintf(stderr, "kernel_launch: hipMemsetAsync failed\n"); return; }
    Args a{};
    for (int i = 0; i < 21; ++i) a.in[i] = (const float*)d_in[i];
    a.out = (float*)d_out; a.ws = (unsigned char*)d_ws;
    void* args[] = {&a};
    hipError_t e = hipLaunchCooperativeKernel((const void*)fwd_megakernel, dim3(grid), dim3(NTHREADS), args, LDS_BYTES, stream);
    if (e != hipSuccess) fprintf(stderr, "cooperative launch failed: %s (grid %d)\n", hipGetErrorString(e), grid);
}
```

```cpp
#include <hip/hip_runtime.h>
#include <hip/hip_cooperative_groups.h>
#include <cstdio>
#include <cstdint>
namespace cg = cooperative_groups;
namespace pg8 {
#define PG8_LAS __attribute__((address_space(3)))
typedef unsigned short bf16_t;
typedef short bf16x8 __attribute__((ext_vector_type(8)));
typedef float f32x4 __attribute__((ext_vector_type(4)));
typedef unsigned u32x4 __attribute__((ext_vector_type(4)));
constexpr int BM = 256, BK = 64, HALF = 128, HTB = HALF * BK * 2  , STAGE_BYTES = 8 * HTB, NXCD = 8, WGM = 4;

__host__ __device__ __forceinline__ int lds_byte(int r, int c) { const int st = (r >> 4) * 2 + (c >> 5), rr = r & 15, cc = c & 31, ob = rr * 64 + cc * 2; return st * 1024 + (ob ^ (((ob >> 9) & 1) << 5)); }
__host__ __device__ __forceinline__ void stage_rc(int b, int& R, int& C) { const int st = b / 1024, sb = b % 1024, swz = sb ^ (((sb >> 9) & 1) << 5); R = (st >> 1) * 16 + swz / 64; C = (st & 1) * 32 + (swz % 64) / 2; }
__host__ __device__ __forceinline__ int perm32(int rho) { const int n = rho >> 4, i = rho & 15; return 8 * (i >> 2) + 4 * n + (i & 3); }

struct Unit { int pm, pn; };
struct Gemm { const bf16_t* A; const bf16_t* Bt; int M, N, K; };

struct StaticOrder {
    int nM, nN, nwg, G, c;
    __host__ __device__ void init(int M, int N, int G_, int c_) { nM = M / BM; nN = N / BM; nwg = nM * nN; G = G_; c = c_; }
    __host__ __device__ bool next(int i, Unit& u) const {
        const long L = (long)i * G + c; if (L >= nwg) return false;
        int wgid = (int)L; { const int q = nwg / NXCD, r = nwg % NXCD, xcd = wgid % NXCD, off = wgid / NXCD; wgid = (xcd < r ? xcd * (q + 1) : r * (q + 1) + (xcd - r) * q) + off; }
        const int nig = WGM * nN, gid = wgid / nig, fm = gid * WGM, gsz = (nM - fm) < WGM ? (nM - fm) : WGM;
        u.pm = fm + ((wgid % nig) % gsz); u.pn = (wgid % nig) / gsz; return true;
    }
    __device__ __forceinline__ void a_ready(const Unit&) const {}
    __device__ __forceinline__ void done(const Unit&) const {}
};

typedef float f32x2_cv __attribute__((ext_vector_type(2))); typedef __bf16 bf16x2_cv __attribute__((ext_vector_type(2)));
__device__ __forceinline__ unsigned cvt_pk_bf16(float lo, float hi) { f32x2_cv v = {lo, hi}; bf16x2_cv b = __builtin_convertvector(v, bf16x2_cv); return __builtin_bit_cast(unsigned, b); }
typedef unsigned u32x2 __attribute__((ext_vector_type(2)));
__device__ __forceinline__ float fast_sigmoid(float x) { return __builtin_amdgcn_rcpf(1.0f + __expf(-x)); }
__device__ __forceinline__ float bf_lo(unsigned w) { return __uint_as_float(w << 16); }
__device__ __forceinline__ float bf_hi(unsigned w) { return __uint_as_float(w & 0xffff0000u); }
__device__ __forceinline__ float rstd_from_ss(const float* ssrow, int fq) {
    const f32x4 a = ((const f32x4*)ssrow)[fq];
    float s = (a[0] + a[1]) + (a[2] + a[3]);
    s += __shfl_xor(s, 16); s += __shfl_xor(s, 32);
    return rsqrtf(s * (1.0f / 1024.0f) + 1e-6f);
}
struct EpiSwiglu {
    static constexpr bool PERM = true, AFTER_DRAIN = false;
    bf16_t* O; const float* SS;
    __device__ __forceinline__ void operator()(const f32x4 (&acc)[2][2][4][2], const Unit& u, int wr, int wc, int fr, int fq) const {
        const int row0 = u.pm * BM + wr * 64 + fr, col0 = u.pn * 128 + wc * 32 + 8 * fq;
#pragma unroll
        for (int ai = 0; ai < 2; ++ai)
#pragma unroll
            for (int m = 0; m < 4; ++m) {
                int row = row0 + ai * HALF + m * 16; asm volatile("" : "+v"(row));
                const float rs = SS ? rstd_from_ss(SS + (size_t)row * 16, fq) : 1.0f;
                float o[8];
#pragma unroll
                for (int n = 0; n < 2; ++n)
#pragma unroll
                    for (int i = 0; i < 4; ++i) { const float g = acc[ai][0][m][n][i] * rs, up = acc[ai][1][m][n][i] * rs; o[4 * n + i] = g * fast_sigmoid(g) * up; }
                u32x4 w; w.x = cvt_pk_bf16(o[0], o[1]); w.y = cvt_pk_bf16(o[2], o[3]); w.z = cvt_pk_bf16(o[4], o[5]); w.w = cvt_pk_bf16(o[6], o[7]);
                *(u32x4*)(O + (size_t)row * 2816 + col0) = w;
            }
    }
};
struct EpiRes {
    static constexpr bool PERM = true, AFTER_DRAIN = false;
    const float* base0; const float* base1; int split_pm; const bf16_t* baseb; float* H; bf16_t* XN; float* SS; float alpha;
    __device__ __forceinline__ void operator()(const f32x4 (&acc)[2][2][4][2], const Unit& u, int wr, int wc, int fr, int fq) const {
        const float* base = (u.pm < split_pm) ? base0 + (size_t)u.pm * BM * 1024 : base1 + (size_t)(u.pm - split_pm) * BM * 1024;
        const int lrow0 = wr * 64 + fr, col0 = u.pn * BM + wc * 32 + 8 * fq;
#pragma unroll
        for (int ai = 0; ai < 2; ++ai)
#pragma unroll
            for (int m = 0; m < 4; ++m) {
                int lrow = lrow0 + ai * HALF + m * 16; asm volatile("" : "+v"(lrow)); const size_t row = (size_t)u.pm * BM + lrow;
                float ss = 0.f;
#pragma unroll
                for (int bj = 0; bj < 2; ++bj) {
                    f32x4 b0, b1;
                    if (baseb) { const u32x4 bw = *(const u32x4*)(baseb + row * 1024 + col0 + bj * HALF);
                        b0 = (f32x4){bf_lo(bw.x), bf_hi(bw.x), bf_lo(bw.y), bf_hi(bw.y)}; b1 = (f32x4){bf_lo(bw.z), bf_hi(bw.z), bf_lo(bw.w), bf_hi(bw.w)}; }
                    else { const float* bp = base + (size_t)lrow * 1024 + col0 + bj * HALF; b0 = *(const f32x4*)bp; b1 = *(const f32x4*)(bp + 4); }
                    const f32x4 v0 = b0 + acc[ai][bj][m][0] * alpha, v1 = b1 + acc[ai][bj][m][1] * alpha;
                    if (H) { float* hp = H + row * 1024 + col0 + bj * HALF; *(f32x4*)hp = v0; *(f32x4*)(hp + 4) = v1; }
                    if (XN) { u32x4 w; w.x = cvt_pk_bf16(v0[0], v0[1]); w.y = cvt_pk_bf16(v0[2], v0[3]); w.z = cvt_pk_bf16(v1[0], v1[1]); w.w = cvt_pk_bf16(v1[2], v1[3]);
                        *(u32x4*)(XN + row * 1024 + col0 + bj * HALF) = w; }
                    ss += (v0[0] * v0[0] + v0[1] * v0[1]) + (v0[2] * v0[2] + v0[3] * v0[3]) + (v1[0] * v1[0] + v1[1] * v1[1]) + (v1[2] * v1[2] + v1[3] * v1[3]);
                    asm volatile("" ::: "memory");
                }
                if (SS) { ss += __shfl_xor(ss, 16); ss += __shfl_xor(ss, 32); if (fq == 0) SS[row * 16 + u.pn * 4 + wc] = ss; }
                asm volatile("" ::: "memory");
            }
    }
};
struct EpiProj {
    static constexpr bool PERM = true, AFTER_DRAIN = false;
    bf16_t* PB; size_t pbs; bf16_t* GG; float* FA; const float* SS; float* okp; float* ovp; float* oks; float* ovs; int grow0;
    __device__ __forceinline__ void operator()(const f32x4 (&acc)[2][2][4][2], const Unit& u, int wr, int wc, int fr, int fq) const {
        const int pn = u.pn; const int lrow0 = u.pm * BM + wr * 64 + fr;
        bf16_t* dst; int ldc, colt;
        if (pn < 24) { dst = PB + (size_t)(pn >> 2) * pbs; ldc = 1024; colt = (pn & 3) * 256; } else { dst = GG; ldc = 2048; colt = (pn - 24) * 256; }
        const int col0 = colt + wc * 32 + 8 * fq;
        float* kvo = nullptr; long kvrow0 = 0;
        if (pn >= 16 && pn < 24) {
            const int gt = grow0 + u.pm * BM;
            if (gt >= 32768) { kvo = (pn < 20) ? oks : ovs; kvrow0 = (long)(gt - 32768) - (long)(u.pm * BM); }
            else if ((gt & 2047) >= 1536) { kvo = (pn < 20) ? okp : ovp; kvrow0 = (long)((gt >> 11) * 512 + ((gt & 2047) - 1536)) - (long)(u.pm * BM); }
        }
#pragma unroll
        for (int ai = 0; ai < 2; ++ai)
#pragma unroll
            for (int m = 0; m < 4; ++m) {
                int row = lrow0 + ai * HALF + m * 16; asm volatile("" : "+v"(row));
                const float rs = rstd_from_ss(SS + (size_t)row * 16, fq);
                if (pn < 32) {
#pragma unroll
                    for (int bj = 0; bj < 2; ++bj) {
                        const f32x4 v0 = acc[ai][bj][m][0] * rs, v1 = acc[ai][bj][m][1] * rs;
                        u32x4 w; w.x = cvt_pk_bf16(v0[0], v0[1]); w.y = cvt_pk_bf16(v0[2], v0[3]); w.z = cvt_pk_bf16(v1[0], v1[1]); w.w = cvt_pk_bf16(v1[2], v1[3]);
                        *(u32x4*)(dst + (size_t)row * ldc + col0 + bj * HALF) = w;
                        if (kvo) { float* p = kvo + (size_t)(kvrow0 + row) * 1024 + col0 + bj * HALF; *(f32x4*)p = v0; *(f32x4*)(p + 4) = v1; }
                    }
                } else if (wc == 0 && fq < 2) {
                    const f32x4 v0 = acc[ai][0][m][0] * rs, v1 = acc[ai][0][m][1] * rs;
                    float* p = FA + (size_t)row * 16 + 8 * fq; *(f32x4*)p = v0; *(f32x4*)(p + 4) = v1;
                }
            }
    }
};
template <int MODE> struct EpiGate {
    static constexpr bool PERM = true, AFTER_DRAIN = false;
    const bf16_t* GG; int goff; bf16_t* TMP; bf16_t* MIX;
    __device__ __forceinline__ void operator()(const f32x4 (&acc)[2][2][4][2], const Unit& u, int wr, int wc, int fr, int fq) const {
        const int lrow0 = u.pm * BM + wr * 64 + fr, col0 = u.pn * BM + wc * 32 + 8 * fq;
#pragma unroll
        for (int ai = 0; ai < 2; ++ai)
#pragma unroll
            for (int m = 0; m < 4; ++m) {
                int rowi = lrow0 + ai * HALF + m * 16; asm volatile("" : "+v"(rowi)); const size_t row = (size_t)rowi;
#pragma unroll
                for (int bj = 0; bj < 2; ++bj) {
                    const u32x4 gw = *(const u32x4*)(GG + row * 2048 + goff + col0 + bj * HALF);
                    f32x4 v0, v1;
                    v0[0] = fast_sigmoid(bf_lo(gw.x)) * acc[ai][bj][m][0][0]; v0[1] = fast_sigmoid(bf_hi(gw.x)) * acc[ai][bj][m][0][1];
                    v0[2] = fast_sigmoid(bf_lo(gw.y)) * acc[ai][bj][m][0][2]; v0[3] = fast_sigmoid(bf_hi(gw.y)) * acc[ai][bj][m][0][3];
                    v1[0] = fast_sigmoid(bf_lo(gw.z)) * acc[ai][bj][m][1][0]; v1[1] = fast_sigmoid(bf_hi(gw.z)) * acc[ai][bj][m][1][1];
                    v1[2] = fast_sigmoid(bf_lo(gw.w)) * acc[ai][bj][m][1][2]; v1[3] = fast_sigmoid(bf_hi(gw.w)) * acc[ai][bj][m][1][3];
                    bf16_t* tp = TMP + row * 1024 + col0 + bj * HALF;
                    if (MODE == 1) { const u32x4 tw = *(const u32x4*)tp;
                        v0 += (f32x4){bf_lo(tw.x), bf_hi(tw.x), bf_lo(tw.y), bf_hi(tw.y)}; v1 += (f32x4){bf_lo(tw.z), bf_hi(tw.z), bf_lo(tw.w), bf_hi(tw.w)}; }
                    u32x4 w; w.x = cvt_pk_bf16(v0[0], v0[1]); w.y = cvt_pk_bf16(v0[2], v0[3]); w.z = cvt_pk_bf16(v1[0], v1[1]); w.w = cvt_pk_bf16(v1[2], v1[3]);
                    *(u32x4*)((MODE == 0 ? tp : MIX + row * 1024 + col0 + bj * HALF)) = w;
                }
            }
    }
};
template <class Epi, class Sched, bool ALIGN_EPI = false, bool SP2 = false>
__device__ __forceinline__ void gemm_phase(PG8_LAS unsigned char* lds, const Gemm g, const Sched& S, const Epi& E, const int tid_arg) {
    int tid_l = tid_arg; asm volatile("" : "+v"(tid_l));
    const int tid = tid_l, wid = __builtin_amdgcn_readfirstlane(tid >> 6), lane = tid & 63, wr = wid >> 2, wc = wid & 3, fr = lane & 15, fq = lane >> 4;
    const int K = g.K, nt = K / BK;
    unsigned voffA[2], voffB[2];
#pragma unroll
    for (int i = 0; i < 2; ++i) { int R, C; stage_rc(tid * 16 + i * 8192, R, C); const int Rb = Epi::PERM ? ((R & ~31) + perm32(R & 31)) : R;
        voffA[i] = (unsigned)(R * K + C) * 2u; voffB[i] = (unsigned)(Rb * K + C) * 2u; }
    const size_t kstep = (size_t)(BK * 2);
    const size_t hstep = (size_t)HALF * K * 2;
    const size_t tstep = 2 * hstep;
    const unsigned ldsw = (unsigned)wid * 1024u;
    const int aoff = lds_byte(wr * 64 + fr, fq * 8), boff = lds_byte(wc * 32 + fr, fq * 8);
#define PG8_SA(b, h) (((b) * 2 + (h)) * HTB)
#define PG8_SB(b, h) ((4 + (b) * 2 + (h)) * HTB)
#define PG8_STAGE(bufoff, gbase, voff) do { _Pragma("unroll") for (int _i = 0; _i < 2; ++_i) \
        __builtin_amdgcn_global_load_lds((const unsigned*)((const char*)(gbase) + (voff)[_i]), (PG8_LAS unsigned*)(lds + (bufoff) + ldsw + _i * 8192), 16, 0, 0); } while (0)
#define PG8_LDA(dst, b, h) do { _Pragma("unroll") for (int m = 0; m < 4; ++m) _Pragma("unroll") for (int k = 0; k < 2; ++k) dst[m][k] = *(const PG8_LAS bf16x8*)(lds + PG8_SA(b, h) + aoff + m * 2048 + k * 1024); } while (0)
#define PG8_LDB(dst, b, h) do { _Pragma("unroll") for (int n = 0; n < 2; ++n) _Pragma("unroll") for (int k = 0; k < 2; ++k) dst[n][k] = *(const PG8_LAS bf16x8*)(lds + PG8_SB(b, h) + boff + n * 2048 + k * 1024); } while (0)
#define PG8_MMA(ai, bj, At, Bt) do { __builtin_amdgcn_s_setprio(1); _Pragma("unroll") for (int m = 0; m < 4; ++m) _Pragma("unroll") for (int n = 0; n < 2; ++n) _Pragma("unroll") for (int k = 0; k < 2; ++k) \
        acc[ai][bj][m][n] = __builtin_amdgcn_mfma_f32_16x16x32_bf16(Bt[n][k], At[m][k], acc[ai][bj][m][n], 0, 0, 0); __builtin_amdgcn_s_setprio(0); } while (0)
#define PG8_WAIT_V(n) asm volatile("s_waitcnt vmcnt(" #n ")" ::: "memory")
#define PG8_WAIT_L(n) asm volatile("s_waitcnt lgkmcnt(" #n ")" ::: "memory")
#define PG8_BAR __builtin_amdgcn_s_barrier()
#define PG8_SCHED __builtin_amdgcn_sched_barrier(0)
    Unit cur, nxt; int ui = 0;
    if (!S.next(0, cur)) return;
    f32x4 acc[2][2][4][2];
#pragma unroll
    for (int a = 0; a < 2; ++a)
#pragma unroll
        for (int b = 0; b < 2; ++b)
#pragma unroll
            for (int m = 0; m < 4; ++m)
#pragma unroll
                for (int n = 0; n < 2; ++n) acc[a][b][m][n] = (f32x4){0.f, 0.f, 0.f, 0.f};
    bf16x8 At[4][2], B0[2][2], B1[2][2];
    const char* cA = (const char*)g.A + (size_t)cur.pm * tstep; const char* cB = (const char*)g.Bt + (size_t)cur.pn * tstep;
    S.a_ready(cur);
    if constexpr (SP2) {
        PG8_STAGE(PG8_SB(0, 0), cB, voffB); PG8_STAGE(PG8_SB(0, 1), cB + hstep, voffB); PG8_STAGE(PG8_SA(0, 0), cA, voffA); PG8_STAGE(PG8_SA(0, 1), cA + hstep, voffA);
        if (wr == 1) PG8_BAR;
        PG8_WAIT_V(2); PG8_BAR;
        PG8_STAGE(PG8_SB(1, 0), cB + kstep, voffB); PG8_STAGE(PG8_SA(1, 0), cA + kstep, voffA); PG8_STAGE(PG8_SB(1, 1), cB + hstep + kstep, voffB);
        PG8_WAIT_V(6); PG8_BAR;
    } else {
        PG8_STAGE(PG8_SB(0, 0), cB, voffB); PG8_STAGE(PG8_SA(0, 0), cA, voffA); PG8_STAGE(PG8_SB(0, 1), cB + hstep, voffB); PG8_STAGE(PG8_SA(0, 1), cA + hstep, voffA);
        if (wr == 1) PG8_BAR;
        PG8_WAIT_V(4); PG8_BAR;
        PG8_STAGE(PG8_SB(1, 0), cB + kstep, voffB); PG8_STAGE(PG8_SA(1, 0), cA + kstep, voffA); PG8_STAGE(PG8_SB(1, 1), cB + hstep + kstep, voffB);
        PG8_WAIT_V(6); PG8_BAR;
    }
    for (;;) {
        const bool has_next = S.next(ui + 1, nxt);
        const char* nA = has_next ? (const char*)g.A + (size_t)nxt.pm * tstep : cA; const char* nB = has_next ? (const char*)g.Bt + (size_t)nxt.pn * tstep : cB;
        for (int t = 0; t < nt; t += 2) {
            const bool last = (t == nt - 2);
            const char* a1 = cA + (size_t)(t + 1) * kstep;
            const char* a2 = last ? nA : cA + (size_t)(t + 2) * kstep; const char* b2 = last ? nB : cB + (size_t)(t + 2) * kstep;
            const char* a3 = a2 + kstep; const char* b3 = b2 + kstep;
            if (last && has_next) S.a_ready(nxt);
            if constexpr (SP2) {
            PG8_LDB(B0, 0, 0); PG8_LDB(B1, 0, 1); PG8_SCHED; PG8_LDA(At, 0, 0); PG8_STAGE(PG8_SA(1, 1), a1 + hstep, voffA);
            PG8_WAIT_V(8); PG8_WAIT_L(0); PG8_BAR; PG8_MMA(0, 0, At, B0); PG8_MMA(0, 1, At, B1); PG8_BAR; PG8_SCHED;
            PG8_LDA(At, 0, 1); PG8_STAGE(PG8_SB(0, 0), b2, voffB); PG8_STAGE(PG8_SB(0, 1), b2 + hstep, voffB); PG8_STAGE(PG8_SA(0, 0), a2, voffA);
            PG8_WAIT_V(8); PG8_WAIT_L(0); PG8_BAR; PG8_MMA(1, 0, At, B0); PG8_MMA(1, 1, At, B1); PG8_BAR; PG8_SCHED;
            PG8_LDB(B0, 1, 0); PG8_LDB(B1, 1, 1); PG8_SCHED; PG8_LDA(At, 1, 0); PG8_STAGE(PG8_SA(0, 1), a2 + hstep, voffA);
            PG8_WAIT_V(8); PG8_WAIT_L(0); PG8_BAR; PG8_MMA(0, 0, At, B0); PG8_MMA(0, 1, At, B1); PG8_BAR; PG8_SCHED;
            PG8_LDA(At, 1, 1); PG8_STAGE(PG8_SB(1, 0), b3, voffB); PG8_STAGE(PG8_SB(1, 1), b3 + hstep, voffB); PG8_STAGE(PG8_SA(1, 0), a3, voffA);
            PG8_WAIT_V(8); PG8_WAIT_L(0); PG8_BAR; PG8_MMA(1, 0, At, B0); PG8_MMA(1, 1, At, B1); PG8_BAR; PG8_SCHED;
            } else {
            PG8_LDB(B0, 0, 0); PG8_SCHED; PG8_LDA(At, 0, 0); PG8_STAGE(PG8_SA(1, 1), a1 + hstep, voffA);
            PG8_WAIT_L(8); PG8_BAR; PG8_WAIT_L(0); PG8_MMA(0, 0, At, B0); PG8_BAR; PG8_SCHED;
            PG8_LDB(B1, 0, 1); PG8_STAGE(PG8_SB(0, 0), b2, voffB);
            PG8_BAR; PG8_WAIT_L(0); PG8_MMA(0, 1, At, B1); PG8_BAR;
            PG8_LDA(At, 0, 1); PG8_STAGE(PG8_SA(0, 0), a2, voffA);
            PG8_BAR; PG8_WAIT_L(0); PG8_MMA(1, 0, At, B0); PG8_BAR; PG8_SCHED;
            PG8_STAGE(PG8_SB(0, 1), b2 + hstep, voffB);
            PG8_WAIT_V(6); PG8_BAR; PG8_MMA(1, 1, At, B1); PG8_BAR;
            PG8_LDB(B0, 1, 0); PG8_SCHED; PG8_LDA(At, 1, 0); PG8_STAGE(PG8_SA(0, 1), a2 + hstep, voffA);
            PG8_WAIT_L(8); PG8_BAR; PG8_WAIT_L(0); PG8_MMA(0, 0, At, B0); PG8_BAR; PG8_SCHED;
            PG8_LDB(B1, 1, 1); PG8_STAGE(PG8_SB(1, 0), b3, voffB);
            PG8_BAR; PG8_WAIT_L(0); PG8_MMA(0, 1, At, B1); PG8_BAR;
            PG8_LDA(At, 1, 1); PG8_STAGE(PG8_SA(1, 0), a3, voffA);
            PG8_BAR; PG8_WAIT_L(0); PG8_MMA(1, 0, At, B0); PG8_BAR; PG8_SCHED;
            PG8_STAGE(PG8_SB(1, 1), b3 + hstep, voffB);
            PG8_WAIT_V(6); PG8_BAR; PG8_MMA(1, 1, At, B1); PG8_BAR;
            }
        }
        if constexpr (ALIGN_EPI) { if (wr == 0) PG8_BAR; }
        if constexpr (!Epi::AFTER_DRAIN) { E(acc, cur, wr, wc, fr, fq); S.done(cur); }
        if (!has_next) break;
#pragma unroll
        for (int a = 0; a < 2; ++a)
#pragma unroll
            for (int b = 0; b < 2; ++b)
#pragma unroll
                for (int m = 0; m < 4; ++m)
#pragma unroll
                    for (int n = 0; n < 2; ++n) acc[a][b][m][n] = (f32x4){0.f, 0.f, 0.f, 0.f};
        cur = nxt; cA = nA; cB = nB; ++ui;
        if constexpr (ALIGN_EPI) { if (wr == 1) PG8_BAR; }
    }
    PG8_WAIT_V(0);
    if constexpr (!ALIGN_EPI) { if (wr == 0) PG8_BAR; }
    PG8_BAR;
    if constexpr (Epi::AFTER_DRAIN) { E.fused(acc, cur, wr, wc, fr, fq, lds, wid, lane); S.done(cur); }
#undef PG8_SA
#undef PG8_SB
#undef PG8_STAGE
#undef PG8_LDA
#undef PG8_LDB
#undef PG8_MMA
#undef PG8_WAIT_V
#undef PG8_WAIT_L
#undef PG8_BAR
#undef PG8_SCHED
}
}
#define LAS __attribute__((address_space(3)))
#define GASP __attribute__((address_space(1)))
typedef unsigned short bf16;
typedef float f32x4 __attribute__((ext_vector_type(4)));
typedef float f32x16 __attribute__((ext_vector_type(16)));
typedef short bf16x8 __attribute__((ext_vector_type(8)));
typedef short s16x4 __attribute__((ext_vector_type(4)));
typedef unsigned u32x4 __attribute__((ext_vector_type(4)));
typedef unsigned u32x2 __attribute__((ext_vector_type(2)));
constexpr int NWAVES = 8, NTHREADS = 512;
constexpr int DM = 1024, T_P = 32768, T_S = 512, T_ALL = 33280, DFF = 2816, NPROJ = 8448, NPROJ_SRC = 8208;
constexpr int MG = 16896;
constexpr size_t PBS = (size_t)MG * 1024 * 2;
constexpr size_t WS_W1T = 0;
constexpr size_t WS_W1OT = WS_W1T + (size_t)5632 * 1024 * 2;
constexpr size_t WS_WINT = WS_W1OT + (size_t)1024 * 2816 * 2;
constexpr size_t WS_WBGT = WS_WINT + (size_t)NPROJ * 1024 * 2;
constexpr size_t WS_WBAT = WS_WBGT + (size_t)1024 * 1024 * 2;
constexpr size_t WS_WOUTT = WS_WBAT + (size_t)1024 * 1024 * 2;
constexpr size_t WS_W2T = WS_WOUTT + (size_t)1024 * 1024 * 2;
constexpr size_t WS_W2OT = WS_W2T + (size_t)5632 * 1024 * 2;
constexpr size_t WS_CKB = WS_W2OT + (size_t)1024 * 2816 * 2;
constexpr size_t WS_CVB = WS_CKB + (size_t)8 * 512 * 1024 * 2;
constexpr size_t WS_XN = WS_CVB + (size_t)8 * 512 * 1024 * 2;
constexpr size_t WS_SS1 = WS_XN + (size_t)T_ALL * 1024 * 2;
constexpr size_t WS_SS2 = WS_SS1 + (size_t)T_ALL * 16 * 4;
constexpr size_t WS_R = WS_SS2 + (size_t)T_ALL * 16 * 4;
constexpr size_t WS_ACT = WS_R;
constexpr size_t WS_PB = WS_R, WS_GG = WS_PB + 6 * PBS, WS_FA = WS_GG + (size_t)MG * 2048 * 2, WS_OA = WS_FA + (size_t)MG * 16 * 4, WS_OB = WS_OA + PBS, WS_END = WS_OB + PBS;
constexpr size_t WS_TMP = WS_PB, WS_MIX = WS_PB + 2 * PBS;
static_assert(WS_END <= (size_t)536870912 && WS_ACT + (size_t)T_ALL * DFF * 2 <= WS_END, "workspace map");
constexpr size_t WS_CTL = WS_END, CTL_BYTES = 16384;
constexpr int LDS_BYTES = 147456, XST_OFF = 139264;
constexpr size_t O_Y = 0, O_KP = (size_t)T_ALL * 1024, O_VP = O_KP + (size_t)16 * 512 * 1024, O_GP = O_VP + (size_t)16 * 512 * 1024, O_KS = O_GP + (size_t)16 * 4 * 128 * 256,
                 O_VS = O_KS + (size_t)8 * 64 * 1024, O_GS = O_VS + (size_t)8 * 64 * 1024, O_END = O_GS + (size_t)8 * 4 * 128 * 256;

__device__ __forceinline__ unsigned f2bf(float f) { unsigned u = __builtin_bit_cast(unsigned, f); return (u + 0x7fffu + ((u >> 16) & 1u)) >> 16; }
__device__ __forceinline__ unsigned pk2(float lo, float hi) { return pg8::cvt_pk_bf16(lo, hi); }
__device__ __forceinline__ float bflo(unsigned w) { return __uint_as_float(w << 16); }
__device__ __forceinline__ float bfhi(unsigned w) { return __uint_as_float(w & 0xffff0000u); }
#define LDS_WAIT() asm volatile("s_waitcnt lgkmcnt(0)" ::: "memory")
__device__ __forceinline__ float wave_sum(float v) {
#pragma unroll
    for (int o = 1; o < 64; o <<= 1) v += __shfl_xor(v, o);
    return v;
}
__device__ __forceinline__ int crow(int r, int hi) { return (r & 3) + 8 * (r >> 2) + 4 * hi; }

struct Args { const float* in[21]; float* out; unsigned char* ws; };
typedef const __attribute__((address_space(4))) unsigned long long* karg_ptr_t;
__device__ __forceinline__ const float* arg_in(int i) { karg_ptr_t p = (karg_ptr_t)__builtin_amdgcn_kernarg_segment_ptr(); asm volatile("" : "+s"(p)); return (const float*)(const GASP float*)p[i]; }
#define AIN(i) arg_in(i)

__device__ __forceinline__ void transpose_item(const float* W, int N, int K, int k0, int src0, int nvalid, bf16* WT, int drow0, const float* gk, float cs, LAS float* scr, int lane) {
    const int c32 = lane & 31;
#pragma unroll
    for (int i = 0; i < 32; ++i) { const int kk = 2 * i + (lane >> 5); float v = 0.f;
        if (c32 < nvalid) v = W[(size_t)(k0 + kk) * N + src0 + c32] * (gk ? gk[k0 + kk] : 1.0f) * cs;
        scr[kk * 33 + c32] = v; }
    LDS_WAIT(); asm volatile("" ::: "memory");
    const int c = lane & 7;
#pragma unroll
    for (int j = 0; j < 4; ++j) { const int n = (lane >> 3) + 8 * j; const LAS float* s = scr + (8 * c) * 33 + n;
        u32x4 o; o.x = pk2(s[0 * 33], s[1 * 33]); o.y = pk2(s[2 * 33], s[3 * 33]); o.z = pk2(s[4 * 33], s[5 * 33]); o.w = pk2(s[6 * 33], s[7 * 33]);
        *(u32x4*)(WT + (size_t)(drow0 + n) * K + k0 + 8 * c) = o; }
    LDS_WAIT(); asm volatile("" ::: "memory");
}
__device__ __forceinline__ void transpose_matrix_item(int kind, const float* W, int N, int K, int ND, bf16* WT, const float* gk, int item, LAS float* scr, int lane) {
    const int nblk = ND / 32, kb = item / nblk, nb = item % nblk, drow0 = 32 * nb; int src0 = drow0, nvalid = 32; float cs = 1.0f;
    if (kind == 1) { const int j = drow0 >> 8, w = drow0 & 255; src0 = (w < 128) ? 128 * j + w : 2816 + 128 * j + (w - 128); }
    else if (kind == 2) {
        if (drow0 < 3072) { cs = (drow0 < 512) ? 0.08838834764831845f : 1.0f; }
        else if (drow0 < 8192) { src0 = drow0 + 16; cs = (drow0 < 4096) ? 0.125f : 1.0f; }
        else if (drow0 == 8192) { src0 = 3072; nvalid = 16; }
        else { src0 = 0; nvalid = 0; }
    }
    transpose_item(W, N, K, 64 * kb, src0, nvalid, WT, drow0, gk, cs, scr, lane);
}

__device__ __forceinline__ void transpose_tile_block(int kind, const float* W, int N, int K, int ND, bf16* WT, const float* gk, int item, LAS unsigned char* lds, int tid) {
    constexpr int LP = 260;
    const int ntile = ND / 256, kb = item / ntile, nt = item % ntile, k0 = 64 * kb, drow0 = 256 * nt;
    int srcA = drow0, srcB = drow0 + 128, nvalid = 256; float cs = 1.0f;
    if (kind == 1) { srcA = 128 * nt; srcB = 2816 + 128 * nt; }
    else if (kind == 2) {
        if (drow0 < 3072) { cs = (drow0 < 512) ? 0.08838834764831845f : 1.0f; }
        else if (drow0 < 8192) { srcA = drow0 + 16; srcB = drow0 + 144; cs = (drow0 < 4096) ? 0.125f : 1.0f; }
        else { srcA = 3072; srcB = 3072; nvalid = 16; }
    }
    LAS float* T = (LAS float*)lds;
    __syncthreads();
#pragma unroll
    for (int r = 0; r < 8; ++r) { const int id = tid + NTHREADS * r, row = id >> 6, cv = id & 63, col = cv * 4;
        f32x4 v = (f32x4){0.f, 0.f, 0.f, 0.f};
        if (col < nvalid) { const int src = (col < 128) ? srcA + col : srcB + (col - 128); v = *(const f32x4*)(W + (size_t)(k0 + row) * N + src); }
        const float g = (gk ? gk[k0 + row] : 1.0f) * cs;
        *(LAS f32x4*)(T + row * LP + col) = v * g; }
    __syncthreads();
#pragma unroll
    for (int r = 0; r < 4; ++r) { const int id = tid + NTHREADS * r, n = id >> 3, k8 = id & 7; const LAS float* s = T + (k8 * 8) * LP + n;
        u32x4 o; o.x = pk2(s[0 * LP], s[1 * LP]); o.y = pk2(s[2 * LP], s[3 * LP]); o.z = pk2(s[4 * LP], s[5 * LP]); o.w = pk2(s[6 * LP], s[7 * LP]);
        *(u32x4*)(WT + (size_t)(drow0 + n) * K + k0 + 8 * k8) = o; }
}
__device__ __forceinline__ void rms_rows4_to_bf16(const float* x0, bf16* o0, int lane) {
    f32x4 v[4][4]; float s[4];
#pragma unroll
    for (int q = 0; q < 4; ++q) { const f32x4* xr = (const f32x4*)(x0 + q * 1024) + lane;
#pragma unroll
        for (int j = 0; j < 4; ++j) v[q][j] = xr[64 * j]; }
#pragma unroll
    for (int q = 0; q < 4; ++q) { s[q] = 0.f;
#pragma unroll
        for (int j = 0; j < 4; ++j) s[q] += (v[q][j].x * v[q][j].x + v[q][j].y * v[q][j].y) + (v[q][j].z * v[q][j].z + v[q][j].w * v[q][j].w); }
#pragma unroll
    for (int o = 1; o < 64; o <<= 1) {
#pragma unroll
        for (int q = 0; q < 4; ++q) s[q] += __shfl_xor(s[q], o); }
#pragma unroll
    for (int q = 0; q < 4; ++q) { const float rstd = rsqrtf(s[q] * (1.f / 1024.f) + 1e-6f); u32x2* o8 = (u32x2*)(o0 + q * 1024) + lane;
#pragma unroll
        for (int j = 0; j < 4; ++j) { u32x2 w; w.x = pk2(v[q][j].x * rstd, v[q][j].y * rstd); w.y = pk2(v[q][j].z * rstd, v[q][j].w * rstd); o8[64 * j] = w; } }
}
#define XB_TMO      128
#define XB_XCNT(j)  (256  + 64 * (j))
#define XB_XSUB(j)  (1280 + 64 * (j))
#define XB_XGEN(j)  (2304 + 64 * (j))
#define XB_TOP      3328
#define XB_TOPGEN   3392
#define XCD_BAR_WORDS 3456
#define XB_SPIN_CAP (1u << 18)

__device__ __forceinline__ unsigned xb_ld(unsigned* p)              { return __hip_atomic_load(p, __ATOMIC_RELAXED, __HIP_MEMORY_SCOPE_AGENT); }
__device__ __forceinline__ unsigned xb_add(unsigned* p, unsigned v) { return __hip_atomic_fetch_add(p, v, __ATOMIC_RELAXED, __HIP_MEMORY_SCOPE_AGENT); }
__device__ __forceinline__ unsigned xb_xcc_id() { return (unsigned)__builtin_amdgcn_s_getreg((3 << 11) | 20) & 0xFu; }
#define XB_SPIN(cond, bar) do { unsigned _sp = 0; while (cond) { __builtin_amdgcn_s_sleep(1); \
    if ((++_sp & 255u) == 0u) { if (xb_ld(&(bar)[XB_TMO])) break; if (_sp > XB_SPIN_CAP) { atomicAdd(&(bar)[XB_TMO], 1u); break; } } } } while (0)

struct XcdBarrier {
    unsigned* bar; unsigned x;
    volatile LAS unsigned* st;
};

__device__ __forceinline__ XcdBarrier xcd_barrier_post(unsigned* bar, volatile LAS unsigned* st) {
    XcdBarrier b; b.bar = bar; b.x = xb_xcc_id(); b.st = st;
    if (threadIdx.x == 0) (void)xb_add(&bar[XB_XCNT(b.x)], 1u);
    return b;
}
__device__ __forceinline__ void xcd_barrier_complete(unsigned* bar, unsigned x, unsigned& nloc, unsigned& nx) {
    const unsigned G = gridDim.x * gridDim.y * gridDim.z;
    unsigned sum, cnt, mine, sp = 0u;
    for (;;) {
        sum = 0u; cnt = 0u; mine = 0u;
#pragma unroll
        for (unsigned j = 0; j < 16; ++j) { const unsigned c = xb_ld(&bar[XB_XCNT(j)]); sum += c; cnt += (c > 0u) ? 1u : 0u; mine = (j == x) ? c : mine; }
        if (sum == G) break;
        __builtin_amdgcn_s_sleep(1);
        if ((++sp & 255u) == 0u) { if (xb_ld(&bar[XB_TMO])) break; if (sp > XB_SPIN_CAP) { atomicAdd(&bar[XB_TMO], 1u); break; } }
    }
    nloc = mine > 0u ? mine : 1u; nx = cnt > 0u ? cnt : 1u;
}

__device__ __forceinline__ void xcd_barrier(const XcdBarrier& b, const bool leader) {
    asm volatile("s_waitcnt vmcnt(0)" ::: "memory");
    __syncthreads();
    if (leader) {
        unsigned* bar = b.bar;
        __builtin_amdgcn_s_waitcnt(0);
        unsigned nloc = b.st[0], nx = b.st[1];
        if (nloc == 0u) { xcd_barrier_complete(bar, b.x, nloc, nx); b.st[0] = nloc; b.st[1] = nx; }
        const unsigned old = xb_add(&bar[XB_XSUB(b.x)], 1u);
        const unsigned gen = old / nloc;
        if (old + 1u == (gen + 1u) * nloc) {
            __builtin_amdgcn_fence(__ATOMIC_RELEASE, "agent");
            asm volatile("s_waitcnt vmcnt(0)" ::: "memory");
            const unsigned og = xb_add(&bar[XB_TOP], 1u);
            const unsigned tg = og / nx;
            if (og + 1u == (tg + 1u) * nx) xb_add(&bar[XB_TOPGEN], 1u);
            else XB_SPIN(xb_ld(&bar[XB_TOPGEN]) == tg, bar);
            __builtin_amdgcn_fence(__ATOMIC_ACQUIRE, "agent");
            xb_add(&bar[XB_XGEN(b.x)], 1u);
            asm volatile("s_waitcnt vmcnt(0)" ::: "memory");
        } else {
            XB_SPIN(xb_ld(&bar[XB_XGEN(b.x)]) == gen, bar);
            __builtin_amdgcn_fence(__ATOMIC_ACQUIRE, "agent");
            asm volatile("s_waitcnt vmcnt(0)" ::: "memory");
        }
    }
    __syncthreads();
}
constexpr int ATT_VP = 144, ATT_WLDS = 10496;
__device__ __forceinline__ s16x4 tr16(LAS const unsigned char* p) { typedef short v4i16_t __attribute__((ext_vector_type(4)));
    return __builtin_bit_cast(s16x4, __builtin_amdgcn_ds_read_tr16_b64_v4i16((LAS v4i16_t*)p)); }
__device__ __forceinline__ bf16x8 cat8(s16x4 a, s16x4 b) { return (bf16x8){a[0], a[1], a[2], a[3], b[0], b[1], b[2], b[3]}; }
__device__ __forceinline__ bf16x8 pack8(const f32x16& v, int o) { u32x4 w; w.x = pk2(v[o], v[o + 1]); w.y = pk2(v[o + 2], v[o + 3]); w.z = pk2(v[o + 4], v[o + 5]); w.w = pk2(v[o + 6], v[o + 7]); return __builtin_bit_cast(bf16x8, w); }

__device__ __forceinline__ void attn_unit(LAS unsigned char* wl, const bf16* Qc, bf16* Oc, const bf16* KBc, const bf16* VBc, const bf16* CK, const bf16* CV, bool sample, int t0, const float* tabh, int lane, const int qh) {
    const int r32 = lane & 31, hi = lane >> 5, g16 = lane >> 4, i16 = lane & 15;
    LAS float* btab = (LAS float*)(wl + 9216);
    asm volatile("" ::: "memory");
    for (int i = lane; i < 257; i += 64) btab[i] = tabh[i];
    const float cb = tabh[256];
    bf16x8 qfr[4];
#pragma unroll
    for (int d0 = 0; d0 < 4; ++d0) qfr[d0] = *(const bf16x8*)(Qc + (size_t)(32 * qh + r32) * 1024 + 16 * d0 + 8 * hi);
    f32x16 oT[2];
#pragma unroll
    for (int a = 0; a < 2; ++a)
#pragma unroll
        for (int r = 0; r < 16; ++r) oT[a][r] = 0.f;
    float mrun = -1e30f, lrun = 0.f;
    const int traddr = ((g16 >> 1) * 4 + (i16 >> 2)) * ATT_VP + ((g16 & 1) * 16 + (i16 & 3) * 4) * 2;
    for (int t = t0; t < 9; ++t) {
        const bf16 *kp, *vp;
        if (sample && t < 8) { kp = CK + (size_t)t * 64 * 1024; vp = CV + (size_t)t * 64 * 1024; }
        else { const long off = -(long)(8 - t) * 64 * 1024; kp = KBc + off; vp = VBc + off; }
        u32x4 vreg[8];
#pragma unroll
        for (int i = 0; i < 8; ++i) vreg[i] = *(const u32x4*)(vp + (size_t)(8 * i + (lane >> 3)) * 1024 + (lane & 7) * 8);
        bf16x8 kf[2][4];
#pragma unroll
        for (int kvh = 0; kvh < 2; ++kvh)
#pragma unroll
            for (int d0 = 0; d0 < 4; ++d0) kf[kvh][d0] = *(const bf16x8*)(kp + (size_t)(32 * kvh + r32) * 1024 + 16 * d0 + 8 * hi);
        LDS_WAIT();
#pragma unroll
        for (int i = 0; i < 8; ++i) *(LAS u32x4*)(wl + (8 * i + (lane >> 3)) * ATT_VP + (lane & 7) * 16) = vreg[i];
        {
            f32x16 s0, s1;
#pragma unroll
            for (int r = 0; r < 16; ++r) { s0[r] = 0.f; s1[r] = 0.f; }
#pragma unroll
            for (int d0 = 0; d0 < 4; ++d0) { s0 = __builtin_amdgcn_mfma_f32_32x32x16_bf16(kf[0][d0], qfr[d0], s0, 0, 0, 0); s1 = __builtin_amdgcn_mfma_f32_32x32x16_bf16(kf[1][d0], qfr[d0], s1, 0, 0, 0); }
            if (t < 6) {
#pragma unroll
                for (int r = 0; r < 16; ++r) { s0[r] += cb; s1[r] += cb; }
            } else {
                const int relb = 64 * (8 - t) + 32 * qh + r32 + 128;
#pragma unroll
                for (int r = 0; r < 16; ++r) { const int i0 = relb - crow(r, hi); s0[r] += btab[i0 > 256 ? 256 : i0]; const int i1 = i0 - 32; s1[r] += btab[i1 > 256 ? 256 : i1]; }
            }
            float tm = fmaxf(s0[0], s1[0]);
#pragma unroll
            for (int r = 1; r < 16; ++r) tm = fmaxf(tm, fmaxf(s0[r], s1[r]));
            tm = fmaxf(tm, __shfl_xor(tm, 32));
            const float mn = fmaxf(mrun, tm), sc = __expf(mrun - mn); mrun = mn;
            float ps = 0.f;
#pragma unroll
            for (int r = 0; r < 16; ++r) { s0[r] = __expf(s0[r] - mn); s1[r] = __expf(s1[r] - mn); ps += s0[r] + s1[r]; }
            lrun = lrun * sc + ps;
#pragma unroll
            for (int r = 0; r < 16; ++r) { oT[0][r] *= sc; oT[1][r] *= sc; }
            bf16x8 pf[4]; pf[0] = pack8(s0, 0); pf[1] = pack8(s0, 8); pf[2] = pack8(s1, 0); pf[3] = pack8(s1, 8);
            LDS_WAIT();
#pragma unroll
            for (int dh = 0; dh < 2; ++dh)
#pragma unroll
                for (int kc = 0; kc < 4; ++kc) {
                    LAS const unsigned char* p = wl + traddr + (16 * kc) * ATT_VP + dh * 64;
                    const bf16x8 vf = cat8(tr16(p), tr16(p + 8 * ATT_VP));
                    oT[dh] = __builtin_amdgcn_mfma_f32_32x32x16_bf16(vf, pf[kc], oT[dh], 0, 0, 0);
                }
        }
        asm volatile("" ::: "memory");
    }
    {
        const float lt = lrun + __shfl_xor(lrun, 32), inv = 1.0f / lt;
        bf16* orow = Oc + (size_t)(32 * qh + r32) * 1024;
#pragma unroll
        for (int dh = 0; dh < 2; ++dh)
#pragma unroll
            for (int rg = 0; rg < 4; ++rg) { u32x2 w; w.x = pk2(oT[dh][4 * rg] * inv, oT[dh][4 * rg + 1] * inv); w.y = pk2(oT[dh][4 * rg + 2] * inv, oT[dh][4 * rg + 3] * inv);
                *(u32x2*)(orow + 32 * dh + 8 * rg + 4 * hi) = w; }
    }
    LDS_WAIT(); asm volatile("" ::: "memory");
}
constexpr int AB_HB = 18432, AB_BUF = 2 * AB_HB, AB_TAB = 2 * AB_BUF;
__device__ __forceinline__ void attn_block_unit(LAS unsigned char* lds, const bf16* QB, bf16* OB, const bf16* KB, const bf16* VB, int sb, int hp, int cp, const float* tab, int tid) {
    const int lane = tid & 63, w = __builtin_amdgcn_readfirstlane(tid >> 6), r32 = lane & 31, hi = lane >> 5, g16 = lane >> 4, i16 = lane & 15;
    const int hsel = w >> 2, csel = (w >> 1) & 1, qh = w & 1, h = 2 * hp + hsel, c = 2 * cp + csel;
    LAS float* btab = (LAS float*)(lds + AB_TAB + hsel * 1040);
    __syncthreads();
    for (int i = tid; i < 2 * 257; i += NTHREADS) { const int hh = i >= 257, k = i - 257 * hh; ((LAS float*)(lds + AB_TAB + hh * 1040))[k] = tab[(2 * hp + hh) * 257 + k]; }
    const float cb = tab[h * 257 + 256];
    const size_t hoff = (size_t)h * 64;
    const bf16* Qc = QB + ((size_t)sb * 2048 + (size_t)c * 64) * 1024 + hoff;
    bf16x8 qfr[4];
#pragma unroll
    for (int d0 = 0; d0 < 4; ++d0) qfr[d0] = *(const bf16x8*)(Qc + (size_t)(32 * qh + r32) * 1024 + 16 * d0 + 8 * hi);
    f32x16 oT[2];
#pragma unroll
    for (int a = 0; a < 2; ++a)
#pragma unroll
        for (int r = 0; r < 16; ++r) oT[a][r] = 0.f;
    float mrun = -1e30f, lrun = 0.f;
    const int traddr = ((g16 >> 1) * 4 + (i16 >> 2)) * ATT_VP + ((g16 & 1) * 16 + (i16 & 3) * 4) * 2;
    const int lrow = tid >> 3, lch = tid & 7;
    const int tc0 = 2 * cp - 8, j0 = tc0 < 0 ? -tc0 : 0;
    const size_t pbase = ((size_t)sb * 2048 + lrow) * 1024 + (size_t)(2 * hp) * 64 + lch * 8;
    const bf16* kbase = KB + pbase; const bf16* vbase = VB + pbase;
    u32x4 kreg0, vreg0, kreg1, vreg1;
#define AB_LOAD(jj) do { const long o_ = (long)(tc0 + (jj)) * 64 * 1024; kreg0 = *(const u32x4*)(kbase + o_); vreg0 = *(const u32x4*)(vbase + o_); kreg1 = *(const u32x4*)(kbase + o_ + 64); vreg1 = *(const u32x4*)(vbase + o_ + 64); } while (0)
#define AB_STORE(jj) do { LAS unsigned char* b_ = lds + ((jj) & 1) * AB_BUF + lrow * ATT_VP + lch * 16; *(LAS u32x4*)b_ = kreg0; *(LAS u32x4*)(b_ + 9216) = vreg0; *(LAS u32x4*)(b_ + AB_HB) = kreg1; *(LAS u32x4*)(b_ + AB_HB + 9216) = vreg1; } while (0)
    AB_LOAD(j0); AB_STORE(j0);
    for (int j = j0; j < 10; ++j) {
        __syncthreads();
        if (j + 1 < 10) AB_LOAD(j + 1);
        const int t = j - csel;
        if (t >= 0 && t < 9) {
            LAS const unsigned char* kb = lds + (j & 1) * AB_BUF + hsel * AB_HB; LAS const unsigned char* vb = kb + 9216;
            f32x16 s0, s1;
#pragma unroll
            for (int r = 0; r < 16; ++r) { s0[r] = 0.f; s1[r] = 0.f; }
#pragma unroll
            for (int d0 = 0; d0 < 4; ++d0) {
                const bf16x8 k0 = *(const LAS bf16x8*)(kb + r32 * ATT_VP + (16 * d0 + 8 * hi) * 2), k1 = *(const LAS bf16x8*)(kb + (32 + r32) * ATT_VP + (16 * d0 + 8 * hi) * 2);
                s0 = __builtin_amdgcn_mfma_f32_32x32x16_bf16(k0, qfr[d0], s0, 0, 0, 0); s1 = __builtin_amdgcn_mfma_f32_32x32x16_bf16(k1, qfr[d0], s1, 0, 0, 0); }
            if (t < 6) {
#pragma unroll
                for (int r = 0; r < 16; ++r) { s0[r] += cb; s1[r] += cb; }
            } else {
                const int relb = 64 * (8 - t) + 32 * qh + r32 + 128;
#pragma unroll
                for (int r = 0; r < 16; ++r) { const int i0 = relb - crow(r, hi); s0[r] += btab[i0 > 256 ? 256 : i0]; const int i1 = i0 - 32; s1[r] += btab[i1 > 256 ? 256 : i1]; }
            }
            float tm = fmaxf(s0[0], s1[0]);
#pragma unroll
            for (int r = 1; r < 16; ++r) tm = fmaxf(tm, fmaxf(s0[r], s1[r]));
            tm = fmaxf(tm, __shfl_xor(tm, 32));
            const float mn = fmaxf(mrun, tm), sc = __expf(mrun - mn); mrun = mn;
            float ps = 0.f;
#pragma unroll
            for (int r = 0; r < 16; ++r) { s0[r] = __expf(s0[r] - mn); s1[r] = __expf(s1[r] - mn); ps += s0[r] + s1[r]; }
            lrun = lrun * sc + ps;
#pragma unroll
            for (int r = 0; r < 16; ++r) { oT[0][r] *= sc; oT[1][r] *= sc; }
            bf16x8 pf[4]; pf[0] = pack8(s0, 0); pf[1] = pack8(s0, 8); pf[2] = pack8(s1, 0); pf[3] = pack8(s1, 8);
#pragma unroll
            for (int dh = 0; dh < 2; ++dh)
#pragma unroll
                for (int kc = 0; kc < 4; ++kc) {
                    LAS const unsigned char* p = vb + traddr + (16 * kc) * ATT_VP + dh * 64;
                    const bf16x8 vf = cat8(tr16(p), tr16(p + 8 * ATT_VP));
                    oT[dh] = __builtin_amdgcn_mfma_f32_32x32x16_bf16(vf, pf[kc], oT[dh], 0, 0, 0);
                }
        }
        if (j + 1 < 10) AB_STORE(j + 1);
    }
#undef AB_LOAD
#undef AB_STORE
    {
        const float lt = lrun + __shfl_xor(lrun, 32), inv = 1.0f / lt;
        bf16* orow = OB + ((size_t)sb * 2048 + (size_t)c * 64 + 32 * qh + r32) * 1024 + hoff;
#pragma unroll
        for (int dh = 0; dh < 2; ++dh)
#pragma unroll
            for (int rg = 0; rg < 4; ++rg) { u32x2 wv; wv.x = pk2(oT[dh][4 * rg] * inv, oT[dh][4 * rg + 1] * inv); wv.y = pk2(oT[dh][4 * rg + 2] * inv, oT[dh][4 * rg + 3] * inv);
                *(u32x2*)(orow + 32 * dh + 8 * rg + 4 * hi) = wv; }
    }
}
template <int MODE> __device__ __forceinline__ void small_gemm_res(LAS unsigned char* lds, const bf16* A, const bf16* Bt, int K, const float* base, const bf16* baseb, float* H, bf16* XN, float* SS, float alpha, const bf16* GGs, int bx, int G, int tid) {
    const int lane = tid & 63, w = __builtin_amdgcn_readfirstlane(tid >> 6), r32 = lane & 31, hi = lane >> 5;
    const int kw = K >> 3;
    LAS float* P = (LAS float*)lds;
    for (int tile = bx; tile < 256; tile += G) {
        const int t0 = (tile >> 4) * 32, n0 = (tile & 15) * 64;
        f32x16 acc0, acc1;
#pragma unroll
        for (int r = 0; r < 16; ++r) { acc0[r] = 0.f; acc1[r] = 0.f; }
        const bf16* ap = A + (size_t)(t0 + r32) * K + w * kw + 8 * hi;
        const bf16* b0p = Bt + (size_t)(n0 + r32) * K + w * kw + 8 * hi; const bf16* b1p = b0p + (size_t)32 * K;
#pragma unroll 4
        for (int k = 0; k < kw; k += 16) {
            const bf16x8 x = *(const bf16x8*)(ap + k), w0 = *(const bf16x8*)(b0p + k), w1 = *(const bf16x8*)(b1p + k);
            acc0 = __builtin_amdgcn_mfma_f32_32x32x16_bf16(w0, x, acc0, 0, 0, 0); acc1 = __builtin_amdgcn_mfma_f32_32x32x16_bf16(w1, x, acc1, 0, 0, 0);
        }
        LAS float* Pw = P + w * 2112;
#pragma unroll
        for (int r = 0; r < 16; ++r) { Pw[crow(r, hi) * 33 + r32] = acc0[r]; Pw[(32 + crow(r, hi)) * 33 + r32] = acc1[r]; }
        __syncthreads();
        const int tok = tid >> 4, nq = tid & 15;
        float v[4] = {0.f, 0.f, 0.f, 0.f};
#pragma unroll
        for (int ww = 0; ww < 8; ++ww)
#pragma unroll
            for (int e = 0; e < 4; ++e) v[e] += P[ww * 2112 + (4 * nq + e) * 33 + tok];
        const size_t off = (size_t)(t0 + tok) * 1024 + n0 + 4 * nq;
        if (MODE == 0) {
            f32x4 b; if (baseb) { const u32x2 bw = *(const u32x2*)(baseb + off); b = (f32x4){bflo(bw.x), bfhi(bw.x), bflo(bw.y), bfhi(bw.y)}; } else b = *(const f32x4*)(base + off);
            const f32x4 hv = (f32x4){b[0] + alpha * v[0], b[1] + alpha * v[1], b[2] + alpha * v[2], b[3] + alpha * v[3]};
            if (H) *(f32x4*)(H + off) = hv;
            if (XN) { u32x2 xw; xw.x = pk2(hv[0], hv[1]); xw.y = pk2(hv[2], hv[3]); *(u32x2*)(XN + off) = xw; }
            if (SS) { float ss = (hv[0] * hv[0] + hv[1] * hv[1]) + (hv[2] * hv[2] + hv[3] * hv[3]);
                ss += __shfl_xor(ss, 1); ss += __shfl_xor(ss, 2); ss += __shfl_xor(ss, 4); ss += __shfl_xor(ss, 8);
                if (nq == 0) SS[(size_t)(t0 + tok) * 16 + (n0 >> 6)] = ss; }
        } else {
            const u32x2 gw = *(const u32x2*)(GGs + (size_t)(t0 + tok) * 2048 + n0 + 4 * nq);
            f32x4 o = (f32x4){pg8::fast_sigmoid(bflo(gw.x)) * v[0], pg8::fast_sigmoid(bfhi(gw.x)) * v[1], pg8::fast_sigmoid(bflo(gw.y)) * v[2], pg8::fast_sigmoid(bfhi(gw.y)) * v[3]};
            if (MODE == 1) { u32x2 xw; xw.x = pk2(o[0], o[1]); xw.y = pk2(o[2], o[3]); *(u32x2*)(XN + off) = xw; }
            else { const u32x2 tw = *(const u32x2*)(baseb + off); o += (f32x4){bflo(tw.x), bfhi(tw.x), bflo(tw.y), bfhi(tw.y)};
                u32x2 xw; xw.x = pk2(o[0], o[1]); xw.y = pk2(o[2], o[3]); *(u32x2*)(XN + off) = xw; }
        }
        __syncthreads();
    }
}
constexpr int G_QD = 0, G_KI = 17408, G_VV = 34816, G_B = 71680, G_FA = 105472, G_SEG = 109568, G_SSQ = 111616;
constexpr int G_KT = 113664, GKTP = 320;
constexpr int GP = 272, GVP = 576, GBP = 132;
constexpr size_t WS_DECB = (size_t)1056 * 65536;
__device__ __forceinline__ bf16* ub_slot(unsigned char* ybase, int unit, int) { return (bf16*)ybase + (size_t)unit * 32768; }
__device__ __forceinline__ void gla_a_unit(LAS unsigned char* lds, bf16* QKA, bf16* VA, const float* FA, unsigned char* ws, int xnrow0, float* DECB, int lchunk, int h,
                                           const float* wgate, const float* bgate, int tid) {
    const int lane = tid & 63, w = __builtin_amdgcn_readfirstlane(tid >> 6), r32 = lane & 31, hi = lane >> 5, g16 = lane >> 4, i16 = lane & 15;
    const int gd = tid & 127, tq = tid >> 7;
    LAS float* Bimg = (LAS float*)(lds + G_B); LAS float* FAi = (LAS float*)(lds + G_FA); LAS float* SEG = (LAS float*)(lds + G_SEG);
    const int trrow = (g16 >> 1) * 4 + (i16 >> 2), trcol = (g16 & 1) * 16 + (i16 & 3) * 4;
    const size_t row0 = (size_t)lchunk * 64; const int unit = lchunk * 4 + h;
    u32x4 qv[2], kv[2];
#pragma unroll
    for (int i = 0; i < 2; ++i) { const int id = tid + 512 * i, row = id >> 4, ch = id & 15; const bf16* p = QKA + (row0 + row) * 1024 + h * 128 + ch * 8; qv[i] = *(const u32x4*)p; kv[i] = *(const u32x4*)(p + 512); }
    if (tid < 256) *(LAS f32x4*)(FAi + tid * 4) = *(const f32x4*)(FA + row0 * 16 + tid * 4);
#pragma unroll
    for (int i = 0; i < 4; ++i) { const int id = tid + 512 * i, row = id >> 5, ch = id & 31; *(LAS u32x4*)(lds + G_VV + row * GVP + ch * 16) = *(const u32x4*)(VA + (row0 + row) * 1024 + h * 256 + ch * 8); }
    __syncthreads();
    {
        float wg[16];
#pragma unroll
        for (int r = 0; r < 16; ++r) wg[r] = wgate[r * 512 + h * 128 + gd];
        const float bg = bgate[h * 128 + gd];
        float run = 0.f;
#pragma unroll
        for (int tt = 0; tt < 16; ++tt) { const int t = tq * 16 + tt; const LAS f32x4* fp = (const LAS f32x4*)(FAi + t * 16); float x = bg;
#pragma unroll
            for (int q = 0; q < 4; ++q) { const f32x4 f = fp[q]; x += f[0] * wg[4 * q] + f[1] * wg[4 * q + 1] + f[2] * wg[4 * q + 2] + f[3] * wg[4 * q + 3]; }
            const float ls = fminf(x, 0.f) - __logf(1.0f + __expf(-fabsf(x))); run += ls * 0.0625f; Bimg[t * GBP + gd] = run;
            if ((tt & 3) == 3) asm volatile("" ::: "memory"); }
        SEG[tq * 128 + gd] = run;
    }
    __syncthreads();
#pragma unroll
    for (int i = 0; i < 2; ++i) { const int id = tid + 512 * i, row = id >> 4, ch = id & 15;
        f32x4 b0 = *(const LAS f32x4*)(Bimg + row * GBP + ch * 8), b1 = *(const LAS f32x4*)(Bimg + row * GBP + ch * 8 + 4);
        f32x4 l0 = (f32x4){0.f, 0.f, 0.f, 0.f}, l1 = l0;
#pragma unroll
        for (int q = 0; q < 4; ++q) { const f32x4 s0v = *(const LAS f32x4*)(SEG + q * 128 + ch * 8), s1v = *(const LAS f32x4*)(SEG + q * 128 + ch * 8 + 4);
            l0 += s0v; l1 += s1v; if (q < (row >> 4)) { b0 += s0v; b1 += s1v; } }
        if (row == 0) { float* dp = DECB + (size_t)unit * 128 + ch * 8;
            *(f32x4*)dp = (f32x4){__expf(l0[0]), __expf(l0[1]), __expf(l0[2]), __expf(l0[3])}; *(f32x4*)(dp + 4) = (f32x4){__expf(l1[0]), __expf(l1[1]), __expf(l1[2]), __expf(l1[3])}; }
        const float bb[8] = {b0[0], b0[1], b0[2], b0[3], b1[0], b1[1], b1[2], b1[3]};
        const unsigned qw[4] = {qv[i].x, qv[i].y, qv[i].z, qv[i].w}, kw[4] = {kv[i].x, kv[i].y, kv[i].z, kv[i].w};
        unsigned oq[4], oi[4];
#pragma unroll
        for (int e = 0; e < 4; ++e) { const float q0 = bflo(qw[e]), q1 = bfhi(qw[e]), k0 = bflo(kw[e]), k1 = bfhi(kw[e]);
            const float e0 = __expf(bb[2 * e]), e1 = __expf(bb[2 * e + 1]), n0 = __expf(-bb[2 * e]), n1 = __expf(-bb[2 * e + 1]);
            oq[e] = pk2(q0 * e0, q1 * e1); oi[e] = pk2(k0 * n0, k1 * n1); }
        const u32x4 qd = (u32x4){oq[0], oq[1], oq[2], oq[3]};
        *(LAS u32x4*)(lds + G_QD + row * GP + ch * 16) = qd;
        *(LAS u32x4*)(lds + G_KI + row * GP + ch * 16) = (u32x4){oi[0], oi[1], oi[2], oi[3]};
        *(LAS u32x4*)(lds + G_KT + row * GKTP + ch * 16) = (u32x4){oi[0], oi[1], oi[2], oi[3]};
        *(u32x4*)(QKA + (row0 + row) * 1024 + h * 128 + ch * 8) = qd; }
    __syncthreads();
    bf16x8 vvf[4];
#pragma unroll
    for (int kc = 0; kc < 4; ++kc) { LAS const unsigned char* p = lds + G_VV + (16 * kc + trrow) * GVP + (32 * w + trcol) * 2; vvf[kc] = cat8(tr16(p), tr16(p + 8 * GVP)); }
    f32x16 s00, s01, s11;
#pragma unroll
    for (int r = 0; r < 16; ++r) { s00[r] = 0.f; s01[r] = 0.f; s11[r] = 0.f; }
#pragma unroll
    for (int s = 0; s < 8; ++s) {
        const bf16x8 a0 = *(const LAS bf16x8*)(lds + G_KI + r32 * GP + (16 * s + 8 * hi) * 2), a1 = *(const LAS bf16x8*)(lds + G_KI + (32 + r32) * GP + (16 * s + 8 * hi) * 2);
        const bf16x8 b0 = *(const LAS bf16x8*)(lds + G_QD + r32 * GP + (16 * s + 8 * hi) * 2), b1 = *(const LAS bf16x8*)(lds + G_QD + (32 + r32) * GP + (16 * s + 8 * hi) * 2);
        s00 = __builtin_amdgcn_mfma_f32_32x32x16_bf16(a0, b0, s00, 0, 0, 0); s01 = __builtin_amdgcn_mfma_f32_32x32x16_bf16(a0, b1, s01, 0, 0, 0); s11 = __builtin_amdgcn_mfma_f32_32x32x16_bf16(a1, b1, s11, 0, 0, 0);
    }
#pragma unroll
    for (int r = 0; r < 16; ++r) if (crow(r, hi) > r32) { s00[r] = 0.f; s11[r] = 0.f; }
    const bf16x8 p00a = pack8(s00, 0), p00b = pack8(s00, 8), p01a = pack8(s01, 0), p01b = pack8(s01, 8), p11a = pack8(s11, 0), p11b = pack8(s11, 8);
    f32x16 oT0, oT1;
#pragma unroll
    for (int r = 0; r < 16; ++r) { oT0[r] = 0.f; oT1[r] = 0.f; }
    oT0 = __builtin_amdgcn_mfma_f32_32x32x16_bf16(vvf[0], p00a, oT0, 0, 0, 0); oT0 = __builtin_amdgcn_mfma_f32_32x32x16_bf16(vvf[1], p00b, oT0, 0, 0, 0);
    oT1 = __builtin_amdgcn_mfma_f32_32x32x16_bf16(vvf[0], p01a, oT1, 0, 0, 0); oT1 = __builtin_amdgcn_mfma_f32_32x32x16_bf16(vvf[1], p01b, oT1, 0, 0, 0);
    oT1 = __builtin_amdgcn_mfma_f32_32x32x16_bf16(vvf[2], p11a, oT1, 0, 0, 0); oT1 = __builtin_amdgcn_mfma_f32_32x32x16_bf16(vvf[3], p11b, oT1, 0, 0, 0);
    { bf16* p0 = VA + (row0 + (2 * w) * 4 + g16) * 1024 + h * 256 + i16 * 16; bf16* p1 = p0 + 4 * 1024;
      *(u32x4*)p0 = __builtin_bit_cast(u32x4, pack8(oT0, 0)); *(u32x4*)(p0 + 8) = __builtin_bit_cast(u32x4, pack8(oT0, 8));
      *(u32x4*)p1 = __builtin_bit_cast(u32x4, pack8(oT1, 0)); *(u32x4*)(p1 + 8) = __builtin_bit_cast(u32x4, pack8(oT1, 8)); }
    bf16* up = ub_slot(ws, unit, xnrow0) + (size_t)w * 4096 + lane * 8;
#pragma unroll
    for (int db = 0; db < 4; ++db) { f32x16 uacc;
#pragma unroll
        for (int r = 0; r < 16; ++r) uacc[r] = 0.f;
#pragma unroll
        for (int kc = 0; kc < 4; ++kc) { LAS const unsigned char* p = lds + G_KT + (16 * kc + trrow) * GKTP + (32 * db + trcol) * 2;
            uacc = __builtin_amdgcn_mfma_f32_32x32x16_bf16(cat8(tr16(p), tr16(p + 8 * GKTP)), vvf[kc], uacc, 0, 0, 0); }
        *(u32x4*)(up + (db * 2) * 512) = __builtin_bit_cast(u32x4, pack8(uacc, 0)); *(u32x4*)(up + (db * 2 + 1) * 512) = __builtin_bit_cast(u32x4, pack8(uacc, 8)); }
    __syncthreads();
}

__device__ __forceinline__ void gla_scan_vec(unsigned char* ws, int xnrow0, const float* DECB, int lchunk0, int nchunks, int h, int e, const float* s0, float* sout) {
    const int lane = e & 63, s2 = (e >> 6) & 1, db = (e >> 7) & 3, w = e >> 9, hi = lane >> 5, r32 = lane & 31;
    const int dbase = 32 * db + 16 * s2 + 4 * hi, v = 32 * w + r32;
    float S[8];
#pragma unroll
    for (int jj = 0; jj < 8; ++jj) S[jj] = s0 ? s0[(size_t)(dbase + 8 * (jj >> 2) + (jj & 3)) * 256 + v] : 0.f;
    for (int n0 = 0; n0 < nchunks; n0 += 4) {
        u32x4 uw[4]; f32x4 d0[4], d1[4]; bf16* up[4];
#pragma unroll
        for (int q = 0; q < 4; ++q) { const int n = (n0 + q < nchunks) ? n0 + q : nchunks - 1; const int unit = (lchunk0 + n) * 4 + h;
            up[q] = ub_slot(ws, unit, xnrow0) + (size_t)e * 8; uw[q] = *(const u32x4*)up[q];
            d0[q] = *(const f32x4*)(DECB + (size_t)unit * 128 + dbase); d1[q] = *(const f32x4*)(DECB + (size_t)unit * 128 + dbase + 8); }
#pragma unroll
        for (int q = 0; q < 4; ++q) if (n0 + q < nchunks) {
            *(u32x4*)up[q] = (u32x4){pk2(S[0], S[1]), pk2(S[2], S[3]), pk2(S[4], S[5]), pk2(S[6], S[7])};
            S[0] = d0[q][0] * (S[0] + bflo(uw[q].x)); S[1] = d0[q][1] * (S[1] + bfhi(uw[q].x)); S[2] = d0[q][2] * (S[2] + bflo(uw[q].y)); S[3] = d0[q][3] * (S[3] + bfhi(uw[q].y));
            S[4] = d1[q][0] * (S[4] + bflo(uw[q].z)); S[5] = d1[q][1] * (S[5] + bfhi(uw[q].z)); S[6] = d1[q][2] * (S[6] + bflo(uw[q].w)); S[7] = d1[q][3] * (S[7] + bfhi(uw[q].w)); }
    }
#pragma unroll
    for (int jj = 0; jj < 8; ++jj) sout[(size_t)(dbase + 8 * (jj >> 2) + (jj & 3)) * 256 + v] = S[jj];
}

__device__ __forceinline__ void gla_c_unit(LAS unsigned char* lds, const bf16* QKA, const bf16* VA, const bf16* RA, unsigned char* ws, int xnrow0, bf16* OA, int lchunk, int h, const float* gnorm, int tid) {
    const int lane = tid & 63, w = __builtin_amdgcn_readfirstlane(tid >> 6), r32 = lane & 31, hi = lane >> 5, g16 = lane >> 4, i16 = lane & 15;
    LAS float* SSQ = (LAS float*)(lds + G_SSQ);
    const size_t row0 = (size_t)lchunk * 64; const int unit = lchunk * 4 + h;
#pragma unroll
    for (int i = 0; i < 2; ++i) { const int id = tid + 512 * i, row = id >> 4, ch = id & 15; *(LAS u32x4*)(lds + G_QD + row * GP + ch * 16) = *(const u32x4*)(QKA + (row0 + row) * 1024 + h * 128 + ch * 8); }
    bf16x8 sf[8];
    { const bf16* up = ub_slot(ws, unit, xnrow0) + (size_t)w * 4096 + lane * 8;
#pragma unroll
      for (int f = 0; f < 8; ++f) sf[f] = *(const bf16x8*)(up + f * 512); }
    u32x2 rwv[2][4];
#pragma unroll
    for (int ib = 0; ib < 2; ++ib)
#pragma unroll
        for (int rg = 0; rg < 4; ++rg) rwv[ib][rg] = *(const u32x2*)(RA + (row0 + 32 * ib + r32) * 1024 + h * 256 + 32 * w + 4 * hi + 8 * rg);
    f32x16 oT0, oT1;
    { const bf16* p0 = VA + (row0 + (2 * w) * 4 + g16) * 1024 + h * 256 + i16 * 16; const bf16* p1 = p0 + 4 * 1024;
      const u32x4 a0 = *(const u32x4*)p0, a1 = *(const u32x4*)(p0 + 8), c0 = *(const u32x4*)p1, c1 = *(const u32x4*)(p1 + 8);
      const unsigned aw[8] = {a0.x, a0.y, a0.z, a0.w, a1.x, a1.y, a1.z, a1.w}, cw[8] = {c0.x, c0.y, c0.z, c0.w, c1.x, c1.y, c1.z, c1.w};
#pragma unroll
      for (int q = 0; q < 8; ++q) { oT0[2 * q] = bflo(aw[q]); oT0[2 * q + 1] = bfhi(aw[q]); oT1[2 * q] = bflo(cw[q]); oT1[2 * q + 1] = bfhi(cw[q]); } }
    __syncthreads();
#pragma unroll
    for (int db = 0; db < 4; ++db)
#pragma unroll
        for (int s2 = 0; s2 < 2; ++s2) { const int dcol = (32 * db + 16 * s2 + 4 * hi) * 2;
            LAS const unsigned char* p0 = lds + G_QD + r32 * GP + dcol; LAS const unsigned char* p1 = lds + G_QD + (32 + r32) * GP + dcol;
            const bf16x8 qb0 = cat8(*(const LAS s16x4*)p0, *(const LAS s16x4*)(p0 + 16)), qb1 = cat8(*(const LAS s16x4*)p1, *(const LAS s16x4*)(p1 + 16));
            oT0 = __builtin_amdgcn_mfma_f32_32x32x16_bf16(sf[db * 2 + s2], qb0, oT0, 0, 0, 0); oT1 = __builtin_amdgcn_mfma_f32_32x32x16_bf16(sf[db * 2 + s2], qb1, oT1, 0, 0, 0); }
    float ss0 = 0.f, ss1 = 0.f;
#pragma unroll
    for (int r = 0; r < 16; ++r) { ss0 += oT0[r] * oT0[r]; ss1 += oT1[r] * oT1[r]; }
    ss0 += __shfl_xor(ss0, 32); ss1 += __shfl_xor(ss1, 32);
    if (hi == 0) { SSQ[w * 64 + r32] = ss0; SSQ[w * 64 + 32 + r32] = ss1; }
    __syncthreads();
    f32x4 gnv[4];
#pragma unroll
    for (int rg = 0; rg < 4; ++rg) gnv[rg] = *(const f32x4*)(gnorm + h * 256 + 32 * w + 8 * rg + 4 * hi);
    float t0 = 0.f, t1 = 0.f;
#pragma unroll
    for (int q = 0; q < 8; ++q) { t0 += SSQ[q * 64 + r32]; t1 += SSQ[q * 64 + 32 + r32]; }
    const float rs0 = rsqrtf(t0 * (1.f / 256.f) + 1e-6f), rs1 = rsqrtf(t1 * (1.f / 256.f) + 1e-6f);
#pragma unroll
    for (int ib = 0; ib < 2; ++ib) { int rr = 32 * ib + r32; asm volatile("" : "+v"(rr)); const size_t rowoff = (row0 + rr) * 1024 + h * 256 + 32 * w + 4 * hi; const float rs = ib ? rs1 : rs0;
#pragma unroll
        for (int rg = 0; rg < 4; ++rg) { const u32x2 rw = rwv[ib][rg];
            const float r0 = bflo(rw.x), r1 = bfhi(rw.x), r2 = bflo(rw.y), r3 = bfhi(rw.y);
            const float o0 = (ib ? oT1[4 * rg] : oT0[4 * rg]) * rs * gnv[rg][0] * r0 * pg8::fast_sigmoid(r0), o1 = (ib ? oT1[4 * rg + 1] : oT0[4 * rg + 1]) * rs * gnv[rg][1] * r1 * pg8::fast_sigmoid(r1);
            const float o2 = (ib ? oT1[4 * rg + 2] : oT0[4 * rg + 2]) * rs * gnv[rg][2] * r2 * pg8::fast_sigmoid(r2), o3 = (ib ? oT1[4 * rg + 3] : oT0[4 * rg + 3]) * rs * gnv[rg][3] * r3 * pg8::fast_sigmoid(r3);
            u32x2 ow; ow.x = pk2(o0, o1); ow.y = pk2(o2, o3); *(u32x2*)(OA + rowoff + 8 * rg) = ow; } }
}
__global__ void __launch_bounds__(NTHREADS, 2) fwd_megakernel(Args a) {
    extern __shared__ __attribute__((aligned(16))) unsigned char lds_raw[];
    LAS unsigned char* lds = (LAS unsigned char*)lds_raw;
    cg::grid_group grid = cg::this_grid();
    const int G = gridDim.x, bx = blockIdx.x;
    const int wave0 = __builtin_amdgcn_readfirstlane((int)threadIdx.x >> 6);
#define MK_TID() (wave0 * 64 + (int)__builtin_amdgcn_mbcnt_hi(~0u, __builtin_amdgcn_mbcnt_lo(~0u, 0u)))
    volatile LAS unsigned* xst = (volatile LAS unsigned*)(lds + XST_OFF);
    if (threadIdx.x < 4) xst[threadIdx.x] = 0u;
    __syncthreads();
    (void)xcd_barrier_post((unsigned*)(a.ws + WS_CTL), xst);
    unsigned char* ws = (unsigned char*)(GASP unsigned char*)a.ws; float* out = (float*)(GASP float*)a.out;
#define RELOAD_PTRS() do { size_t z_ = 0; asm volatile("" : "+s"(z_)); ws = (unsigned char*)((GASP unsigned char*)a.ws + z_); out = (float*)((GASP float*)a.out + z_); } while (0)
#define GRID_SYNC() do { XcdBarrier b_; b_.bar = (unsigned*)(ws + WS_CTL); b_.x = xb_xcc_id(); b_.st = (volatile LAS unsigned*)(lds + XST_OFF); xcd_barrier(b_, MK_TID() == 0); RELOAD_PTRS(); } while (0)
#define GRID_SYNC_CG() do { grid.sync(); GRID_SYNC(); } while (0)
#define LAUNDER_TID() int tid = MK_TID(); asm volatile("" : "+v"(tid)); const int lane = tid & 63, wave = __builtin_amdgcn_readfirstlane(tid >> 6)
#define W1T ((bf16*)(ws + WS_W1T))
#define W1OT ((bf16*)(ws + WS_W1OT))
#define WINT ((bf16*)(ws + WS_WINT))
#define WBGT ((bf16*)(ws + WS_WBGT))
#define WBAT ((bf16*)(ws + WS_WBAT))
#define WOUTT ((bf16*)(ws + WS_WOUTT))
#define W2T ((bf16*)(ws + WS_W2T))
#define W2OT ((bf16*)(ws + WS_W2OT))
#define CKB ((bf16*)(ws + WS_CKB))
#define CVB ((bf16*)(ws + WS_CVB))
#define XN ((bf16*)(ws + WS_XN))
#define SS1 ((float*)(ws + WS_SS1))
#define SS2 ((float*)(ws + WS_SS2))
#define ACT ((bf16*)(ws + WS_ACT))
#define PB ((bf16*)(ws + WS_PB))
#define GG ((bf16*)(ws + WS_GG))
#define FA ((float*)(ws + WS_FA))
#define OA ((bf16*)(ws + WS_OA))
#define OB ((bf16*)(ws + WS_OB))
#define TMP ((bf16*)(ws + WS_TMP))
#define MIX ((bf16*)((unsigned char*)(out + O_Y) + (size_t)75497472))
#define H (out + O_Y)
    constexpr size_t PBE = PBS / 2;

#ifndef REP_P0
#define REP_P0 1
#endif
    for (int rp0 = 0; rp0 < REP_P0; ++rp0) {
        LAUNDER_TID();
        const int gw = bx * NWAVES + wave, NGW = G * NWAVES;
        for (int it = bx; it < 16 * 22; it += G) transpose_tile_block(1, AIN(6), 5632, 1024, 5632, W1T, AIN(5), it, lds, tid);
        __syncthreads();
        for (int m4 = gw; m4 < T_ALL / 4; m4 += NGW) { const int m = 4 * m4;
            const float* xr = (m < T_P) ? AIN(0) + (size_t)m * 1024 : AIN(1) + (size_t)(m - T_P) * 1024;
            rms_rows4_to_bf16(xr, XN + (size_t)m * 1024, lane); }
    }
    GRID_SYNC();
#ifndef REP_P1
#define REP_P1 1
#endif
    for (int rep1 = 0; rep1 < REP_P1; ++rep1) {
      if (rep1) { GRID_SYNC(); }
 pg8::Gemm g{XN, W1T, T_ALL, 5632, 1024}; pg8::StaticOrder S; S.init(T_ALL, 5632, G, bx); pg8::EpiSwiglu E{ACT, nullptr};
      pg8::gemm_phase<pg8::EpiSwiglu, pg8::StaticOrder, true, true>(lds, g, S, E, MK_TID()); }
    {
        LAUNDER_TID();
        const int nwg = (T_ALL / 256) * 22, rounds = (nwg + G - 1) / G, first_idle = nwg - (rounds - 1) * G;
        const bool all = (first_idle >= G); const int ib = all ? bx : bx - first_idle, nib = all ? G : G - first_idle;
        if (ib >= 0) {
            constexpr int I1 = 44 * 4, I2 = 16 * 33, I3 = 16 * 4, I6 = 16 * 22, I7 = I1, NDEF = I1 + I2 + 3 * I3 + I6 + I7;
            for (int it = ib; it < NDEF; it += nib) {
                int r = it;
                if (r < I1) { transpose_tile_block(0, AIN(7), 1024, 2816, 1024, W1OT, nullptr, r, lds, tid); continue; } r -= I1;
                if (r < I2) { transpose_tile_block(2, AIN(9), NPROJ_SRC, 1024, NPROJ, WINT, AIN(8), r, lds, tid); continue; } r -= I2;
                if (r < I3) { transpose_tile_block(0, AIN(14), 1024, 1024, 1024, WBGT, nullptr, r, lds, tid); continue; } r -= I3;
                if (r < I3) { transpose_tile_block(0, AIN(15), 1024, 1024, 1024, WBAT, nullptr, r, lds, tid); continue; } r -= I3;
                if (r < I3) { transpose_tile_block(0, AIN(16), 1024, 1024, 1024, WOUTT, nullptr, r, lds, tid); continue; } r -= I3;
                if (r < I6) { transpose_tile_block(1, AIN(18), 5632, 1024, 5632, W2T, AIN(17), r, lds, tid); continue; } r -= I6;
                transpose_tile_block(0, AIN(19), 1024, 2816, 1024, W2OT, nullptr, r, lds, tid);
            }
            const size_t nvec = (size_t)8 * 512 * 1024 / 8;
            for (size_t v = (size_t)ib * NTHREADS + tid; v < nvec; v += (size_t)nib * NTHREADS) {
                const f32x4 k0 = *(const f32x4*)(AIN(2) + v * 8), k1 = *(const f32x4*)(AIN(2) + v * 8 + 4), v0 = *(const f32x4*)(AIN(3) + v * 8), v1 = *(const f32x4*)(AIN(3) + v * 8 + 4);
                *(u32x4*)(CKB + v * 8) = (u32x4){pk2(k0[0], k0[1]), pk2(k0[2], k0[3]), pk2(k1[0], k1[1]), pk2(k1[2], k1[3])};
                *(u32x4*)(CVB + v * 8) = (u32x4){pk2(v0[0], v0[1]), pk2(v0[2], v0[3]), pk2(v1[0], v1[1]), pk2(v1[2], v1[3])};
            }
        }
    }
    GRID_SYNC();
#ifndef REP_P2
#define REP_P2 1
#endif
    for (int rp2 = 0; rp2 < REP_P2; ++rp2)
    { pg8::Gemm g{ACT, W1OT, T_P, 1024, 2816}; pg8::StaticOrder S; S.init(T_P, 1024, G, bx); pg8::EpiRes E{AIN(0), AIN(1), 128, nullptr, nullptr, XN, SS1, 0.5f};
      pg8::gemm_phase<pg8::EpiRes, pg8::StaticOrder, true, true>(lds, g, S, E, MK_TID()); }
    { LAUNDER_TID(); (void)lane; (void)wave; small_gemm_res<0>(lds, ACT + (size_t)T_P * DFF, W1OT, DFF, AIN(1), nullptr, nullptr, XN + (size_t)T_P * 1024, SS1 + (size_t)T_P * 16, 0.5f, nullptr, bx, G, tid); }
    GRID_SYNC();
    for (int grp = 0; grp < 2; ++grp) {
        const int row0 = grp ? 16384 : 0, Mg = grp ? 16896 : 16384;
#ifndef REP_P3
#define REP_P3 1
#endif
        for (int rp3 = 0; rp3 < REP_P3; ++rp3)
        { pg8::Gemm g{XN + (size_t)row0 * 1024, WINT, Mg, NPROJ, 1024}; pg8::StaticOrder S; S.init(Mg, NPROJ, G, bx);
          pg8::EpiProj E{PB, PBE, GG, FA, SS1 + (size_t)row0 * 16, out + O_KP, out + O_VP, out + O_KS, out + O_VS, row0};
          pg8::gemm_phase<pg8::EpiProj, pg8::StaticOrder, true, true>(lds, g, S, E, MK_TID()); }
        GRID_SYNC();
        {
            LAUNDER_TID();
            const bf16* QB = PB + 3 * PBE; const bf16* KB = PB + 4 * PBE; const bf16* VB = PB + 5 * PBE;
            LAS unsigned char* wl = lds + wave * ATT_WLDS;
            const int nbu = 1024 + (grp ? 32 : 0);
#ifndef REP_ATT
#define REP_ATT 1
#endif
            for (int ra_ = 0; ra_ < REP_ATT; ++ra_)
            for (int bu = bx; bu < nbu; bu += G) {
                int lrow, h, t0, qh; bool sample = false; const bf16 *ck = CKB, *cv = CVB;
                if (bu < 1024) {
                    const int sb = bu & 7, j = bu >> 3, hp = (j >> 4) & 7, cp = ((j & 15) + 4 * (j >> 5)) & 15; attn_block_unit(lds, QB, OB, KB, VB, sb, hp, cp, AIN(13), tid); continue; }
                __syncthreads();
                { const int su = (bu - 1024) * 8 + wave, sbh = su >> 1, sb = sbh >> 4; h = sbh & 15; qh = su & 1; lrow = 16384 + sb * 64; t0 = 0; sample = true; ck = CKB + (size_t)sb * 512 * 1024 + h * 64; cv = CVB + (size_t)sb * 512 * 1024 + h * 64; }
                const size_t off = (size_t)lrow * 1024 + h * 64;
                if (qh) attn_unit(wl, QB + off, OB + off, KB + off, VB + off, ck, cv, sample, t0, AIN(13) + h * 257, lane, 1);
                else attn_unit(wl, QB + off, OB + off, KB + off, VB + off, ck, cv, sample, t0, AIN(13) + h * 257, lane, 0);
            }
        }
        {
            LAUNDER_TID();
            __syncthreads();
            const int nun = (grp ? 264 : 256) * 4;
            for (int u = G - 1 - bx; u < nun; u += G) gla_a_unit(lds, PB, PB + PBE, FA, (unsigned char*)H, row0, (float*)((unsigned char*)H + WS_DECB), u >> 2, u & 3, AIN(10), AIN(11), tid);
        }
        GRID_SYNC();
        {
            LAUNDER_TID();
            const int gt = bx * NTHREADS + tid, nthr = G * NTHREADS;
            for (int v = gt; v < 32 * 4096; v += nthr) { const int pair = v >> 12, e = v & 4095, sb = pair >> 2, h = pair & 3;
                gla_scan_vec((unsigned char*)H, row0, (const float*)((unsigned char*)H + WS_DECB), sb * 32, 32, h, e, nullptr, out + O_GP + (size_t)((8 * grp + sb) * 4 + h) * 32768); }
            if (grp) for (int v = gt; v < 32 * 4096; v += nthr) { const int pair = v >> 12, e = v & 4095, sb = pair >> 2, h = pair & 3;
                gla_scan_vec((unsigned char*)H, row0, (const float*)((unsigned char*)H + WS_DECB), 256 + sb, 1, h, e, AIN(4) + (size_t)(sb * 4 + h) * 32768, out + O_GS + (size_t)(sb * 4 + h) * 32768); }
        }
        GRID_SYNC();
        {
            LAUNDER_TID();
            const int nun = (grp ? 264 : 256) * 4;
#ifndef REP_C
#define REP_C 1
#endif
            for (int rc_ = 0; rc_ < REP_C; ++rc_)
            for (int u = bx; u < nun; u += G) gla_c_unit(lds, PB, PB + PBE, PB + 2 * PBE, (unsigned char*)H, row0, OA, u >> 2, u & 3, AIN(12), tid);
        }
        GRID_SYNC();
        { pg8::Gemm g{OA, WBGT, 16384, 1024, 1024}; pg8::StaticOrder S; S.init(16384, 1024, G, bx); pg8::EpiGate<0> E{GG, 0, TMP, MIX};
          pg8::gemm_phase<pg8::EpiGate<0>, pg8::StaticOrder, true, true>(lds, g, S, E, MK_TID()); }
        if (grp) { LAUNDER_TID(); (void)lane; (void)wave; small_gemm_res<1>(lds, OA + (size_t)16384 * 1024, WBGT, 1024, nullptr, nullptr, nullptr, TMP + (size_t)16384 * 1024, nullptr, 0.f, GG + (size_t)16384 * 2048, bx, G, tid); }
        { pg8::Gemm g{OB, WBAT, 16384, 1024, 1024}; pg8::StaticOrder S; S.init(16384, 1024, G, bx); pg8::EpiGate<1> E{GG, 1024, TMP, MIX};
          pg8::gemm_phase<pg8::EpiGate<1>, pg8::StaticOrder, true, true>(lds, g, S, E, MK_TID()); }
        if (grp) { LAUNDER_TID(); (void)lane; (void)wave; small_gemm_res<2>(lds, OB + (size_t)16384 * 1024, WBAT, 1024, nullptr, TMP + (size_t)16384 * 1024, nullptr, MIX + (size_t)16384 * 1024, nullptr, 0.f, GG + (size_t)16384 * 2048 + 1024, bx, G, tid); }
        GRID_SYNC();
        { pg8::Gemm g{MIX, WOUTT, 16384, 1024, 1024}; pg8::StaticOrder S; S.init(16384, 1024, G, bx);
          pg8::EpiRes E{nullptr, nullptr, 1 << 30, XN + (size_t)row0 * 1024, nullptr, XN + (size_t)row0 * 1024, SS2 + (size_t)row0 * 16, 1.0f};
          pg8::gemm_phase<pg8::EpiRes, pg8::StaticOrder, true, true>(lds, g, S, E, MK_TID()); }
        if (grp) { LAUNDER_TID(); (void)lane; (void)wave; small_gemm_res<0>(lds, MIX + (size_t)16384 * 1024, WOUTT, 1024, nullptr, XN + (size_t)T_P * 1024, nullptr, XN + (size_t)T_P * 1024, SS2 + (size_t)T_P * 16, 1.0f, nullptr, bx, G, tid); }
        if (grp == 1) GRID_SYNC();
    }
    { pg8::Gemm g{XN, W2T, T_ALL, 5632, 1024}; pg8::StaticOrder S; S.init(T_ALL, 5632, G, bx); pg8::EpiSwiglu E{ACT, SS2};
      pg8::gemm_phase<pg8::EpiSwiglu, pg8::StaticOrder, true, true>(lds, g, S, E, MK_TID()); }
    GRID_SYNC_CG();
    { pg8::Gemm g{ACT, W2OT, T_P, 1024, 2816}; pg8::StaticOrder S; S.init(T_P, 1024, G, bx); pg8::EpiRes E{nullptr, nullptr, 1 << 30, XN, nullptr, XN, nullptr, 0.5f};
      pg8::gemm_phase<pg8::EpiRes, pg8::StaticOrder, true, true>(lds, g, S, E, MK_TID()); }
    { LAUNDER_TID(); (void)lane; (void)wave; small_gemm_res<0>(lds, ACT + (size_t)T_P * DFF, W2OT, DFF, nullptr, XN + (size_t)T_P * 1024, nullptr, XN + (size_t)T_P * 1024, nullptr, 0.5f, nullptr, bx, G, tid); }
    GRID_SYNC();
    {
        LAUNDER_TID();
        const int gw = bx * NWAVES + wave, NGW = G * NWAVES; const f32x4* gf = (const f32x4*)AIN(20) + lane;
        f32x4 gv[4];
#pragma unroll
        for (int j = 0; j < 4; ++j) gv[j] = gf[64 * j];
        for (int m4 = gw; m4 < T_ALL / 4; m4 += NGW) { f32x4* xr = (f32x4*)(H + (size_t)m4 * 4096) + lane; const u32x2* hb = (const u32x2*)(XN + (size_t)m4 * 4096) + lane; f32x4 v[4][4]; float s[4];
#pragma unroll
            for (int q = 0; q < 4; ++q)
#pragma unroll
                for (int j = 0; j < 4; ++j) { const u32x2 w = hb[q * 256 + 64 * j]; v[q][j] = (f32x4){bflo(w.x), bfhi(w.x), bflo(w.y), bfhi(w.y)}; }
#pragma unroll
            for (int q = 0; q < 4; ++q) { s[q] = 0.f;
#pragma unroll
                for (int j = 0; j < 4; ++j) s[q] += (v[q][j].x * v[q][j].x + v[q][j].y * v[q][j].y) + (v[q][j].z * v[q][j].z + v[q][j].w * v[q][j].w); }
#pragma unroll
            for (int o = 1; o < 64; o <<= 1) {
#pragma unroll
                for (int q = 0; q < 4; ++q) s[q] += __shfl_xor(s[q], o); }
#pragma unroll
            for (int q = 0; q < 4; ++q) { const float rstd = rsqrtf(s[q] * (1.f / 1024.f) + 1e-6f);
#pragma unroll
                for (int j = 0; j < 4; ++j) xr[q * 256 + 64 * j] = v[q][j] * rstd * gv[j]; } }
    }
}

extern "C" void kernel_launch(void* const* d_in, const int* in_sizes, int n_in, void* d_out, int out_size, void* d_ws, size_t ws_size, hipStream_t stream) {
    static int grid = 0;
    if (grid == 0) {
        if (n_in != 21 || (size_t)out_size != O_END || ws_size < WS_CTL + CTL_BYTES) { fprintf(stderr, "kernel_launch: unexpected shapes (n_in %d, out %d, ws %zu); nothing launched\n", n_in, out_size, ws_size); grid = -1; return; }
        int dev = 0, cus = 0, per_cu = 0;
        hipGetDevice(&dev); hipDeviceGetAttribute(&cus, hipDeviceAttributeMultiprocessorCount, dev);
        hipFuncSetAttribute((const void*)fwd_megakernel, hipFuncAttributeMaxDynamicSharedMemorySize, LDS_BYTES);
        hipOccupancyMaxActiveBlocksPerMultiprocessor(&per_cu, (const void*)fwd_megakernel, NTHREADS, LDS_BYTES);
        if (per_cu < 1) { fprintf(stderr, "kernel_launch: occupancy query says %d blocks per CU; nothing launched\n", per_cu); grid = -1; return; }
        grid = cus;
        if (grid < 64) { fprintf(stderr, "kernel_launch: needs at least 64 CUs\n"); grid = -1; return; }
    }
    if (grid < 0) return;
    if (hipMemsetAsync((char*)d_ws + WS_CTL, 0, CTL_BYTES, stream) != hipSuccess) { fprintf(stderr, "kernel_launch: hipMemsetAsync failed\n"); return; }
    Args a{};
    for (int i = 0; i < 21; ++i) a.in[i] = (const float*)d_in[i];
    a.out = (float*)d_out; a.ws = (unsigned char*)d_ws;
    void* args[] = {&a};
    hipError_t e = hipLaunchCooperativeKernel((const void*)fwd_megakernel, dim3(grid), dim3(NTHREADS), args, LDS_BYTES, stream);
    if (e != hipSuccess) fprintf(stderr, "cooperative launch failed: %s (grid %d)\n", hipGetErrorString(e), grid);
}
```

```cpp
#include <hip/hip_runtime.h>
#include <hip/hip_cooperative_groups.h>
#include <cstdio>
#include <cstdint>
namespace cg = cooperative_groups;
namespace pg8 {
#define PG8_LAS __attribute__((address_space(3)))
typedef unsigned short bf16_t;
typedef short bf16x8 __attribute__((ext_vector_type(8)));
typedef float f32x4 __attribute__((ext_vector_type(4)));
typedef unsigned u32x4 __attribute__((ext_vector_type(4)));
constexpr int BM = 256, BK = 64, HALF = 128, HTB = HALF * BK * 2  , STAGE_BYTES = 8 * HTB, NXCD = 8, WGM = 4;

__host__ __device__ __forceinline__ int lds_byte(int r, int c) { const int st = (r >> 4) * 2 + (c >> 5), rr = r & 15, cc = c & 31, ob = rr * 64 + cc * 2; return st * 1024 + (ob ^ (((ob >> 9) & 1) << 5)); }
__host__ __device__ __forceinline__ void stage_rc(int b, int& R, int& C) { const int st = b / 1024, sb = b % 1024, swz = sb ^ (((sb >> 9) & 1) << 5); R = (st >> 1) * 16 + swz / 64; C = (st & 1) * 32 + (swz % 64) / 2; }
__host__ __device__ __forceinline__ int perm32(int rho) { const int n = rho >> 4, i = rho & 15; return 8 * (i >> 2) + 4 * n + (i & 3); }

struct Unit { int pm, pn; };
struct Gemm { const bf16_t* A; const bf16_t* Bt; int M, N, K; };

struct StaticOrder {
    int nM, nN, nwg, G, c;
    __host__ __device__ void init(int M, int N, int G_, int c_) { nM = M / BM; nN = N / BM; nwg = nM * nN; G = G_; c = c_; }
    __host__ __device__ bool next(int i, Unit& u) const {
        const long L = (long)i * G + c; if (L >= nwg) return false;
        int wgid = (int)L; { const int q = nwg / NXCD, r = nwg % NXCD, xcd = wgid % NXCD, off = wgid / NXCD; wgid = (xcd < r ? xcd * (q + 1) : r * (q + 1) + (xcd - r) * q) + off; }
        const int nig = WGM * nN, gid = wgid / nig, fm = gid * WGM, gsz = (nM - fm) < WGM ? (nM - fm) : WGM;
        u.pm = fm + ((wgid % nig) % gsz); u.pn = (wgid % nig) / gsz; return true;
    }
    __device__ __forceinline__ void a_ready(const Unit&) const {}
    __device__ __forceinline__ void done(const Unit&) const {}
};

typedef float f32x2_cv __attribute__((ext_vector_type(2))); typedef __bf16 bf16x2_cv __attribute__((ext_vector_type(2)));
__device__ __forceinline__ unsigned cvt_pk_bf16(float lo, float hi) { f32x2_cv v = {lo, hi}; bf16x2_cv b = __builtin_convertvector(v, bf16x2_cv); return __builtin_bit_cast(unsigned, b); }
typedef unsigned u32x2 __attribute__((ext_vector_type(2)));
__device__ __forceinline__ float fast_sigmoid(float x) { return __builtin_amdgcn_rcpf(1.0f + __expf(-x)); }
__device__ __forceinline__ float bf_lo(unsigned w) { return __uint_as_float(w << 16); }
__device__ __forceinline__ float bf_hi(unsigned w) { return __uint_as_float(w & 0xffff0000u); }
__device__ __forceinline__ float rstd_from_ss(const float* ssrow, int fq) {
    const f32x4 a = ((const f32x4*)ssrow)[fq];
    float s = (a[0] + a[1]) + (a[2] + a[3]);
    s += __shfl_xor(s, 16); s += __shfl_xor(s, 32);
    return rsqrtf(s * (1.0f / 1024.0f) + 1e-6f);
}
struct EpiSwiglu {
    static constexpr bool PERM = true, AFTER_DRAIN = false;
    bf16_t* O; const float* SS;
    __device__ __forceinline__ void operator()(const f32x4 (&acc)[2][2][4][2], const Unit& u, int wr, int wc, int fr, int fq) const {
        const int row0 = u.pm * BM + wr * 64 + fr, col0 = u.pn * 128 + wc * 32 + 8 * fq;
#pragma unroll
        for (int ai = 0; ai < 2; ++ai)
#pragma unroll
            for (int m = 0; m < 4; ++m) {
                int row = row0 + ai * HALF + m * 16; asm volatile("" : "+v"(row));
                const float rs = SS ? rstd_from_ss(SS + (size_t)row * 16, fq) : 1.0f;
                float o[8];
#pragma unroll
                for (int n = 0; n < 2; ++n)
#pragma unroll
                    for (int i = 0; i < 4; ++i) { const float g = acc[ai][0][m][n][i] * rs, up = acc[ai][1][m][n][i] * rs; o[4 * n + i] = g * fast_sigmoid(g) * up; }
                u32x4 w; w.x = cvt_pk_bf16(o[0], o[1]); w.y = cvt_pk_bf16(o[2], o[3]); w.z = cvt_pk_bf16(o[4], o[5]); w.w = cvt_pk_bf16(o[6], o[7]);
                *(u32x4*)(O + (size_t)row * 2816 + col0) = w;
            }
    }
};
struct EpiRes {
    static constexpr bool PERM = true, AFTER_DRAIN = false;
    const float* base0; const float* base1; int split_pm; const bf16_t* baseb; float* H; bf16_t* XN; float* SS; float alpha;
    __device__ __forceinline__ void operator()(const f32x4 (&acc)[2][2][4][2], const Unit& u, int wr, int wc, int fr, int fq) const {
        const float* base = (u.pm < split_pm) ? base0 + (size_t)u.pm * BM * 1024 : base1 + (size_t)(u.pm - split_pm) * BM * 1024;
        const int lrow0 = wr * 64 + fr, col0 = u.pn * BM + wc * 32 + 8 * fq;
#pragma unroll
        for (int ai = 0; ai < 2; ++ai)
#pragma unroll
            for (int m = 0; m < 4; ++m) {
                int lrow = lrow0 + ai * HALF + m * 16; asm volatile("" : "+v"(lrow)); const size_t row = (size_t)u.pm * BM + lrow;
                float ss = 0.f;
#pragma unroll
                for (int bj = 0; bj < 2; ++bj) {
                    f32x4 b0, b1;
                    if (baseb) { const u32x4 bw = *(const u32x4*)(baseb + row * 1024 + col0 + bj * HALF);
                        b0 = (f32x4){bf_lo(bw.x), bf_hi(bw.x), bf_lo(bw.y), bf_hi(bw.y)}; b1 = (f32x4){bf_lo(bw.z), bf_hi(bw.z), bf_lo(bw.w), bf_hi(bw.w)}; }
                    else { const float* bp = base + (size_t)lrow * 1024 + col0 + bj * HALF; b0 = *(const f32x4*)bp; b1 = *(const f32x4*)(bp + 4); }
                    const f32x4 v0 = b0 + acc[ai][bj][m][0] * alpha, v1 = b1 + acc[ai][bj][m][1] * alpha;
                    if (H) { float* hp = H + row * 1024 + col0 + bj * HALF; *(f32x4*)hp = v0; *(f32x4*)(hp + 4) = v1; }
                    if (XN) { u32x4 w; w.x = cvt_pk_bf16(v0[0], v0[1]); w.y = cvt_pk_bf16(v0[2], v0[3]); w.z = cvt_pk_bf16(v1[0], v1[1]); w.w = cvt_pk_bf16(v1[2], v1[3]);
                        *(u32x4*)(XN + row * 1024 + col0 + bj * HALF) = w; }
                    ss += (v0[0] * v0[0] + v0[1] * v0[1]) + (v0[2] * v0[2] + v0[3] * v0[3]) + (v1[0] * v1[0] + v1[1] * v1[1]) + (v1[2] * v1[2] + v1[3] * v1[3]);
                    asm volatile("" ::: "memory");
                }
                if (SS) { ss += __shfl_xor(ss, 16); ss += __shfl_xor(ss, 32); if (fq == 0) SS[row * 16 + u.pn * 4 + wc] = ss; }
                asm volatile("" ::: "memory");
            }
    }
};
struct EpiProj {
    static constexpr bool PERM = true, AFTER_DRAIN = false;
    bf16_t* PB; size_t pbs; bf16_t* GG; float* FA; const float* SS; float* okp; float* ovp; float* oks; float* ovs; int grow0;
    __device__ __forceinline__ void operator()(const f32x4 (&acc)[2][2][4][2], const Unit& u, int wr, int wc, int fr, int fq) const {
        const int pn = u.pn; const int lrow0 = u.pm * BM + wr * 64 + fr;
        bf16_t* dst; int ldc, colt;
        if (pn < 24) { dst = PB + (size_t)(pn >> 2) * pbs; ldc = 1024; colt = (pn & 3) * 256; } else { dst = GG; ldc = 2048; colt = (pn - 24) * 256; }
        const int col0 = colt + wc * 32 + 8 * fq;
        float* kvo = nullptr; long kvrow0 = 0;
        if (pn >= 16 && pn < 24) {
            const int gt = grow0 + u.pm * BM;
            if (gt >= 32768) { kvo = (pn < 20) ? oks : ovs; kvrow0 = (long)(gt - 32768) - (long)(u.pm * BM); }
            else if ((gt & 2047) >= 1536) { kvo = (pn < 20) ? okp : ovp; kvrow0 = (long)((gt >> 11) * 512 + ((gt & 2047) - 1536)) - (long)(u.pm * BM); }
        }
#pragma unroll
        for (int ai = 0; ai < 2; ++ai)
#pragma unroll
            for (int m = 0; m < 4; ++m) {
                int row = lrow0 + ai * HALF + m * 16; asm volatile("" : "+v"(row));
                const float rs = rstd_from_ss(SS + (size_t)row * 16, fq);
                if (pn < 32) {
#pragma unroll
                    for (int bj = 0; bj < 2; ++bj) {
                        const f32x4 v0 = acc[ai][bj][m][0] * rs, v1 = acc[ai][bj][m][1] * rs;
                        u32x4 w; w.x = cvt_pk_bf16(v0[0], v0[1]); w.y = cvt_pk_bf16(v0[2], v0[3]); w.z = cvt_pk_bf16(v1[0], v1[1]); w.w = cvt_pk_bf16(v1[2], v1[3]);
                        *(u32x4*)(dst + (size_t)row * ldc + col0 + bj * HALF) = w;
                        if (kvo) { float* p = kvo + (size_t)(kvrow0 + row) * 1024 + col0 + bj * HALF; *(f32x4*)p = v0; *(f32x4*)(p + 4) = v1; }
                    }
                } else if (wc == 0 && fq < 2) {
                    const f32x4 v0 = acc[ai][0][m][0] * rs, v1 = acc[ai][0][m][1] * rs;
                    float* p = FA + (size_t)row * 16 + 8 * fq; *(f32x4*)p = v0; *(f32x4*)(p + 4) = v1;
                }
            }
    }
};
template <int MODE> struct EpiGate {
    static constexpr bool PERM = true, AFTER_DRAIN = false;
    const bf16_t* GG; int goff; bf16_t* TMP; bf16_t* MIX;
    __device__ __forceinline__ void operator()(const f32x4 (&acc)[2][2][4][2], const Unit& u, int wr, int wc, int fr, int fq) const {
        const int lrow0 = u.pm * BM + wr * 64 + fr, col0 = u.pn * BM + wc * 32 + 8 * fq;
#pragma unroll
        for (int ai = 0; ai < 2; ++ai)
#pragma unroll
            for (int m = 0; m < 4; ++m) {
                int rowi = lrow0 + ai * HALF + m * 16; asm volatile("" : "+v"(rowi)); const size_t row = (size_t)rowi;
#pragma unroll
                for (int bj = 0; bj < 2; ++bj) {
                    const u32x4 gw = *(const u32x4*)(GG + row * 2048 + goff + col0 + bj * HALF);
                    f32x4 v0, v1;
                    v0[0] = fast_sigmoid(bf_lo(gw.x)) * acc[ai][bj][m][0][0]; v0[1] = fast_sigmoid(bf_hi(gw.x)) * acc[ai][bj][m][0][1];
                    v0[2] = fast_sigmoid(bf_lo(gw.y)) * acc[ai][bj][m][0][2]; v0[3] = fast_sigmoid(bf_hi(gw.y)) * acc[ai][bj][m][0][3];
                    v1[0] = fast_sigmoid(bf_lo(gw.z)) * acc[ai][bj][m][1][0]; v1[1] = fast_sigmoid(bf_hi(gw.z)) * acc[ai][bj][m][1][1];
                    v1[2] = fast_sigmoid(bf_lo(gw.w)) * acc[ai][bj][m][1][2]; v1[3] = fast_sigmoid(bf_hi(gw.w)) * acc[ai][bj][m][1][3];
                    bf16_t* tp = TMP + row * 1024 + col0 + bj * HALF;
                    if (MODE == 1) { const u32x4 tw = *(const u32x4*)tp;
                        v0 += (f32x4){bf_lo(tw.x), bf_hi(tw.x), bf_lo(tw.y), bf_hi(tw.y)}; v1 += (f32x4){bf_lo(tw.z), bf_hi(tw.z), bf_lo(tw.w), bf_hi(tw.w)}; }
                    u32x4 w; w.x = cvt_pk_bf16(v0[0], v0[1]); w.y = cvt_pk_bf16(v0[2], v0[3]); w.z = cvt_pk_bf16(v1[0], v1[1]); w.w = cvt_pk_bf16(v1[2], v1[3]);
                    *(u32x4*)((MODE == 0 ? tp : MIX + row * 1024 + col0 + bj * HALF)) = w;
                }
            }
    }
};
template <class Epi, class Sched, bool ALIGN_EPI = false, bool SP2 = false>
__device__ __forceinline__ void gemm_phase(PG8_LAS unsigned char* lds, const Gemm g, const Sched& S, const Epi& E, const int tid_arg) {
    int tid_l = tid_arg; asm volatile("" : "+v"(tid_l));
    const int tid = tid_l, wid = __builtin_amdgcn_readfirstlane(tid >> 6), lane = tid & 63, wr = wid >> 2, wc = wid & 3, fr = lane & 15, fq = lane >> 4;
    const int K = g.K, nt = K / BK;
    unsigned voffA[2], voffB[2];
#pragma unroll
    for (int i = 0; i < 2; ++i) { int R, C; stage_rc(tid * 16 + i * 8192, R, C); const int Rb = Epi::PERM ? ((R & ~31) + perm32(R & 31)) : R;
        voffA[i] = (unsigned)(R * K + C) * 2u; voffB[i] = (unsigned)(Rb * K + C) * 2u; }
    const size_t kstep = (size_t)(BK * 2);
    const size_t hstep = (size_t)HALF * K * 2;
    const size_t tstep = 2 * hstep;
    const unsigned ldsw = (unsigned)wid * 1024u;
    const int aoff = lds_byte(wr * 64 + fr, fq * 8), boff = lds_byte(wc * 32 + fr, fq * 8);
#define PG8_SA(b, h) (((b) * 2 + (h)) * HTB)
#define PG8_SB(b, h) ((4 + (b) * 2 + (h)) * HTB)
#define PG8_STAGE(bufoff, gbase, voff) do { _Pragma("unroll") for (int _i = 0; _i < 2; ++_i) \
        __builtin_amdgcn_global_load_lds((const unsigned*)((const char*)(gbase) + (voff)[_i]), (PG8_LAS unsigned*)(lds + (bufoff) + ldsw + _i * 8192), 16, 0, 0); } while (0)
#define PG8_LDA(dst, b, h) do { _Pragma("unroll") for (int m = 0; m < 4; ++m) _Pragma("unroll") for (int k = 0; k < 2; ++k) dst[m][k] = *(const PG8_LAS bf16x8*)(lds + PG8_SA(b, h) + aoff + m * 2048 + k * 1024); } while (0)
#define PG8_LDB(dst, b, h) do { _Pragma("unroll") for (int n = 0; n < 2; ++n) _Pragma("unroll") for (int k = 0; k < 2; ++k) dst[n][k] = *(const PG8_LAS bf16x8*)(lds + PG8_SB(b, h) + boff + n * 2048 + k * 1024); } while (0)
#define PG8_MMA(ai, bj, At, Bt) do { __builtin_amdgcn_s_setprio(1); _Pragma("unroll") for (int m = 0; m < 4; ++m) _Pragma("unroll") for (int n = 0; n < 2; ++n) _Pragma("unroll") for (int k = 0; k < 2; ++k) \
        acc[ai][bj][m][n] = __builtin_amdgcn_mfma_f32_16x16x32_bf16(Bt[n][k], At[m][k], acc[ai][bj][m][n], 0, 0, 0); __builtin_amdgcn_s_setprio(0); } while (0)
#define PG8_WAIT_V(n) asm volatile("s_waitcnt vmcnt(" #n ")" ::: "memory")
#define PG8_WAIT_L(n) asm volatile("s_waitcnt lgkmcnt(" #n ")" ::: "memory")
#define PG8_BAR __builtin_amdgcn_s_barrier()
#define PG8_SCHED __builtin_amdgcn_sched_barrier(0)
    Unit cur, nxt; int ui = 0;
    if (!S.next(0, cur)) return;
    f32x4 acc[2][2][4][2];
#pragma unroll
    for (int a = 0; a < 2; ++a)
#pragma unroll
        for (int b = 0; b < 2; ++b)
#pragma unroll
            for (int m = 0; m < 4; ++m)
#pragma unroll
                for (int n = 0; n < 2; ++n) acc[a][b][m][n] = (f32x4){0.f, 0.f, 0.f, 0.f};
    bf16x8 At[4][2], B0[2][2], B1[2][2];
    const char* cA = (const char*)g.A + (size_t)cur.pm * tstep; const char* cB = (const char*)g.Bt + (size_t)cur.pn * tstep;
    S.a_ready(cur);
    if constexpr (SP2) {
        PG8_STAGE(PG8_SB(0, 0), cB, voffB); PG8_STAGE(PG8_SB(0, 1), cB + hstep, voffB); PG8_STAGE(PG8_SA(0, 0), cA, voffA); PG8_STAGE(PG8_SA(0, 1), cA + hstep, voffA);
        if (wr == 1) PG8_BAR;
        PG8_WAIT_V(2); PG8_BAR;
        PG8_STAGE(PG8_SB(1, 0), cB + kstep, voffB); PG8_STAGE(PG8_SA(1, 0), cA + kstep, voffA); PG8_STAGE(PG8_SB(1, 1), cB + hstep + kstep, voffB);
        PG8_WAIT_V(6); PG8_BAR;
    } else {
        PG8_STAGE(PG8_SB(0, 0), cB, voffB); PG8_STAGE(PG8_SA(0, 0), cA, voffA); PG8_STAGE(PG8_SB(0, 1), cB + hstep, voffB); PG8_STAGE(PG8_SA(0, 1), cA + hstep, voffA);
        if (wr == 1) PG8_BAR;
        PG8_WAIT_V(4); PG8_BAR;
        PG8_STAGE(PG8_SB(1, 0), cB + kstep, voffB); PG8_STAGE(PG8_SA(1, 0), cA + kstep, voffA); PG8_STAGE(PG8_SB(1, 1), cB + hstep + kstep, voffB);
        PG8_WAIT_V(6); PG8_BAR;
    }
    for (;;) {
        const bool has_next = S.next(ui + 1, nxt);
        const char* nA = has_next ? (const char*)g.A + (size_t)nxt.pm * tstep : cA; const char* nB = has_next ? (const char*)g.Bt + (size_t)nxt.pn * tstep : cB;
        for (int t = 0; t < nt; t += 2) {
            const bool last = (t == nt - 2);
            const char* a1 = cA + (size_t)(t + 1) * kstep;
            const char* a2 = last ? nA : cA + (size_t)(t + 2) * kstep; const char* b2 = last ? nB : cB + (size_t)(t + 2) * kstep;
            const char* a3 = a2 + kstep; const char* b3 = b2 + kstep;
            if (last && has_next) S.a_ready(nxt);
            if constexpr (SP2) {
            PG8_LDB(B0, 0, 0); PG8_LDB(B1, 0, 1); PG8_SCHED; PG8_LDA(At, 0, 0); PG8_STAGE(PG8_SA(1, 1), a1 + hstep, voffA);
            PG8_WAIT_V(8); PG8_WAIT_L(0); PG8_BAR; PG8_MMA(0, 0, At, B0); PG8_MMA(0, 1, At, B1); PG8_BAR; PG8_SCHED;
            PG8_LDA(At, 0, 1); PG8_STAGE(PG8_SB(0, 0), b2, voffB); PG8_STAGE(PG8_SB(0, 1), b2 + hstep, voffB); PG8_STAGE(PG8_SA(0, 0), a2, voffA);
            PG8_WAIT_V(8); PG8_WAIT_L(0); PG8_BAR; PG8_MMA(1, 0, At, B0); PG8_MMA(1, 1, At, B1); PG8_BAR; PG8_SCHED;
            PG8_LDB(B0, 1, 0); PG8_LDB(B1, 1, 1); PG8_SCHED; PG8_LDA(At, 1, 0); PG8_STAGE(PG8_SA(0, 1), a2 + hstep, voffA);
            PG8_WAIT_V(8); PG8_WAIT_L(0); PG8_BAR; PG8_MMA(0, 0, At, B0); PG8_MMA(0, 1, At, B1); PG8_BAR; PG8_SCHED;
            PG8_LDA(At, 1, 1); PG8_STAGE(PG8_SB(1, 0), b3, voffB); PG8_STAGE(PG8_SB(1, 1), b3 + hstep, voffB); PG8_STAGE(PG8_SA(1, 0), a3, voffA);
            PG8_WAIT_V(8); PG8_WAIT_L(0); PG8_BAR; PG8_MMA(1, 0, At, B0); PG8_MMA(1, 1, At, B1); PG8_BAR; PG8_SCHED;
            } else {
            PG8_LDB(B0, 0, 0); PG8_SCHED; PG8_LDA(At, 0, 0); PG8_STAGE(PG8_SA(1, 1), a1 + hstep, voffA);
            PG8_WAIT_L(8); PG8_BAR; PG8_WAIT_L(0); PG8_MMA(0, 0, At, B0); PG8_BAR; PG8_SCHED;
            PG8_LDB(B1, 0, 1); PG8_STAGE(PG8_SB(0, 0), b2, voffB);
            PG8_BAR; PG8_WAIT_L(0); PG8_MMA(0, 1, At, B1); PG8_BAR;
            PG8_LDA(At, 0, 1); PG8_STAGE(PG8_SA(0, 0), a2, voffA);
            PG8_BAR; PG8_WAIT_L(0); PG8_MMA(1, 0, At, B0); PG8_BAR; PG8_SCHED;
            PG8_STAGE(PG8_SB(0, 1), b2 + hstep, voffB);
            PG8_WAIT_V(6); PG8_BAR; PG8_MMA(1, 1, At, B1); PG8_BAR;
            PG8_LDB(B0, 1, 0); PG8_SCHED; PG8_LDA(At, 1, 0); PG8_STAGE(PG8_SA(0, 1), a2 + hstep, voffA);
            PG8_WAIT_L(8); PG8_BAR; PG8_WAIT_L(0); PG8_MMA(0, 0, At, B0); PG8_BAR; PG8_SCHED;
            PG8_LDB(B1, 1, 1); PG8_STAGE(PG8_SB(1, 0), b3, voffB);
            PG8_BAR; PG8_WAIT_L(0); PG8_MMA(0, 1, At, B1); PG8_BAR;
            PG8_LDA(At, 1, 1); PG8_STAGE(PG8_SA(1, 0), a3, voffA);
            PG8_BAR; PG8_WAIT_L(0); PG8_MMA(1, 0, At, B0); PG8_BAR; PG8_SCHED;
            PG8_STAGE(PG8_SB(1, 1), b3 + hstep, voffB);
            PG8_WAIT_V(6); PG8_BAR; PG8_MMA(1, 1, At, B1); PG8_BAR;
            }
        }
        if constexpr (ALIGN_EPI) { if (wr == 0) PG8_BAR; }
        if constexpr (!Epi::AFTER_DRAIN) { E(acc, cur, wr, wc, fr, fq); S.done(cur); }
        if (!has_next) break;
#pragma unroll
        for (int a = 0; a < 2; ++a)
#pragma unroll
            for (int b = 0; b < 2; ++b)
#pragma unroll
                for (int m = 0; m < 4; ++m)
#pragma unroll
                    for (int n = 0; n < 2; ++n) acc[a][b][m][n] = (f32x4){0.f, 0.f, 0.f, 0.f};
        cur = nxt; cA = nA; cB = nB; ++ui;
        if constexpr (ALIGN_EPI) { if (wr == 1) PG8_BAR; }
    }
    PG8_WAIT_V(0);
    if constexpr (!ALIGN_EPI) { if (wr == 0) PG8_BAR; }
    PG8_BAR;
    if constexpr (Epi::AFTER_DRAIN) { E.fused(acc, cur, wr, wc, fr, fq, lds, wid, lane); S.done(cur); }
#undef PG8_SA
#undef PG8_SB
#undef PG8_STAGE
#undef PG8_LDA
#undef PG8_LDB
#undef PG8_MMA
#undef PG8_WAIT_V
#undef PG8_WAIT_L
#undef PG8_BAR
#undef PG8_SCHED
}
}
#define LAS __attribute__((address_space(3)))
#define GASP __attribute__((address_space(1)))
typedef unsigned short bf16;
typedef float f32x4 __attribute__((ext_vector_type(4)));
typedef float f32x16 __attribute__((ext_vector_type(16)));
typedef short bf16x8 __attribute__((ext_vector_type(8)));
typedef short s16x4 __attribute__((ext_vector_type(4)));
typedef unsigned u32x4 __attribute__((ext_vector_type(4)));
typedef unsigned u32x2 __attribute__((ext_vector_type(2)));
constexpr int NWAVES = 8, NTHREADS = 512;
constexpr int DM = 1024, T_P = 32768, T_S = 512, T_ALL = 33280, DFF = 2816, NPROJ = 8448, NPROJ_SRC = 8208;
constexpr int MG = 16896;
constexpr size_t PBS = (size_t)MG * 1024 * 2;
constexpr size_t WS_W1T = 0;
constexpr size_t WS_W1OT = WS_W1T + (size_t)5632 * 1024 * 2;
constexpr size_t WS_WINT = WS_W1OT + (size_t)1024 * 2816 * 2;
constexpr size_t WS_WBGT = WS_WINT + (size_t)NPROJ * 1024 * 2;
constexpr size_t WS_WBAT = WS_WBGT + (size_t)1024 * 1024 * 2;
constexpr size_t WS_WOUTT = WS_WBAT + (size_t)1024 * 1024 * 2;
constexpr size_t WS_W2T = WS_WOUTT + (size_t)1024 * 1024 * 2;
constexpr size_t WS_W2OT = WS_W2T + (size_t)5632 * 1024 * 2;
constexpr size_t WS_CKB = WS_W2OT + (size_t)1024 * 2816 * 2;
constexpr size_t WS_CVB = WS_CKB + (size_t)8 * 512 * 1024 * 2;
constexpr size_t WS_XN = WS_CVB + (size_t)8 * 512 * 1024 * 2;
constexpr size_t WS_SS1 = WS_XN + (size_t)T_ALL * 1024 * 2;
constexpr size_t WS_SS2 = WS_SS1 + (size_t)T_ALL * 16 * 4;
constexpr size_t WS_R = WS_SS2 + (size_t)T_ALL * 16 * 4;
constexpr size_t WS_ACT = WS_R;
constexpr size_t WS_PB = WS_R, WS_GG = WS_PB + 6 * PBS, WS_FA = WS_GG + (size_t)MG * 2048 * 2, WS_OA = WS_FA + (size_t)MG * 16 * 4, WS_OB = WS_OA + PBS, WS_END = WS_OB + PBS;
constexpr size_t WS_TMP = WS_PB, WS_MIX = WS_PB + 2 * PBS;
static_assert(WS_END <= (size_t)536870912 && WS_ACT + (size_t)T_ALL * DFF * 2 <= WS_END, "workspace map");
constexpr size_t WS_CTL = WS_END, CTL_BYTES = 16384;
constexpr int LDS_BYTES = 147456, XST_OFF = 139264;
constexpr size_t O_Y = 0, O_KP = (size_t)T_ALL * 1024, O_VP = O_KP + (size_t)16 * 512 * 1024, O_GP = O_VP + (size_t)16 * 512 * 1024, O_KS = O_GP + (size_t)16 * 4 * 128 * 256,
                 O_VS = O_KS + (size_t)8 * 64 * 1024, O_GS = O_VS + (size_t)8 * 64 * 1024, O_END = O_GS + (size_t)8 * 4 * 128 * 256;

__device__ __forceinline__ unsigned f2bf(float f) { unsigned u = __builtin_bit_cast(unsigned, f); return (u + 0x7fffu + ((u >> 16) & 1u)) >> 16; }
__device__ __forceinline__ unsigned pk2(float lo, float hi) { return pg8::cvt_pk_bf16(lo, hi); }
__device__ __forceinline__ float bflo(unsigned w) { return __uint_as_float(w << 16); }
__device__ __forceinline__ float bfhi(unsigned w) { return __uint_as_float(w & 0xffff0000u); }
#define LDS_WAIT() asm volatile("s_waitcnt lgkmcnt(0)" ::: "memory")
__device__ __forceinline__ float wave_sum(float v) {
#pragma unroll
    for (int o = 1; o < 64; o <<= 1) v += __shfl_xor(v, o);
    return v;
}
__device__ __forceinline__ int crow(int r, int hi) { return (r & 3) + 8 * (r >> 2) + 4 * hi; }

struct Args { const float* in[21]; float* out; unsigned char* ws; };
typedef const __attribute__((address_space(4))) unsigned long long* karg_ptr_t;
__device__ __forceinline__ const float* arg_in(int i) { karg_ptr_t p = (karg_ptr_t)__builtin_amdgcn_kernarg_segment_ptr(); asm volatile("" : "+s"(p)); return (const float*)(const GASP float*)p[i]; }
#define AIN(i) arg_in(i)

__device__ __forceinline__ void transpose_item(const float* W, int N, int K, int k0, int src0, int nvalid, bf16* WT, int drow0, const float* gk, float cs, LAS float* scr, int lane) {
    const int c32 = lane & 31;
#pragma unroll
    for (int i = 0; i < 32; ++i) { const int kk = 2 * i + (lane >> 5); float v = 0.f;
        if (c32 < nvalid) v = W[(size_t)(k0 + kk) * N + src0 + c32] * (gk ? gk[k0 + kk] : 1.0f) * cs;
        scr[kk * 33 + c32] = v; }
    LDS_WAIT(); asm volatile("" ::: "memory");
    const int c = lane & 7;
#pragma unroll
    for (int j = 0; j < 4; ++j) { const int n = (lane >> 3) + 8 * j; const LAS float* s = scr + (8 * c) * 33 + n;
        u32x4 o; o.x = pk2(s[0 * 33], s[1 * 33]); o.y = pk2(s[2 * 33], s[3 * 33]); o.z = pk2(s[4 * 33], s[5 * 33]); o.w = pk2(s[6 * 33], s[7 * 33]);
        *(u32x4*)(WT + (size_t)(drow0 + n) * K + k0 + 8 * c) = o; }
    LDS_WAIT(); asm volatile("" ::: "memory");
}
__device__ __forceinline__ void transpose_matrix_item(int kind, const float* W, int N, int K, int ND, bf16* WT, const float* gk, int item, LAS float* scr, int lane) {
    const int nblk = ND / 32, kb = item / nblk, nb = item % nblk, drow0 = 32 * nb; int src0 = drow0, nvalid = 32; float cs = 1.0f;
    if (kind == 1) { const int j = drow0 >> 8, w = drow0 & 255; src0 = (w < 128) ? 128 * j + w : 2816 + 128 * j + (w - 128); }
    else if (kind == 2) {
        if (drow0 < 3072) { cs = (drow0 < 512) ? 0.08838834764831845f : 1.0f; }
        else if (drow0 < 8192) { src0 = drow0 + 16; cs = (drow0 < 4096) ? 0.125f : 1.0f; }
        else if (drow0 == 8192) { src0 = 3072; nvalid = 16; }
        else { src0 = 0; nvalid = 0; }
    }
    transpose_item(W, N, K, 64 * kb, src0, nvalid, WT, drow0, gk, cs, scr, lane);
}

__device__ __forceinline__ void transpose_tile_block(int kind, const float* W, int N, int K, int ND, bf16* WT, const float* gk, int item, LAS unsigned char* lds, int tid) {
    constexpr int LP = 260;
    const int ntile = ND / 256, kb = item / ntile, nt = item % ntile, k0 = 64 * kb, drow0 = 256 * nt;
    int srcA = drow0, srcB = drow0 + 128, nvalid = 256; float cs = 1.0f;
    if (kind == 1) { srcA = 128 * nt; srcB = 2816 + 128 * nt; }
    else if (kind == 2) {
        if (drow0 < 3072) { cs = (drow0 < 512) ? 0.08838834764831845f : 1.0f; }
        else if (drow0 < 8192) { srcA = drow0 + 16; srcB = drow0 + 144; cs = (drow0 < 4096) ? 0.125f : 1.0f; }
        else { srcA = 3072; srcB = 3072; nvalid = 16; }
    }
    LAS float* T = (LAS float*)lds;
    __syncthreads();
#pragma unroll
    for (int r = 0; r < 8; ++r) { const int id = tid + NTHREADS * r, row = id >> 6, cv = id & 63, col = cv * 4;
        f32x4 v = (f32x4){0.f, 0.f, 0.f, 0.f};
        if (col < nvalid) { const int src = (col < 128) ? srcA + col : srcB + (col - 128); v = *(const f32x4*)(W + (size_t)(k0 + row) * N + src); }
        const float g = (gk ? gk[k0 + row] : 1.0f) * cs;
        *(LAS f32x4*)(T + row * LP + col) = v * g; }
    __syncthreads();
#pragma unroll
    for (int r = 0; r < 4; ++r) { const int id = tid + NTHREADS * r, n = id >> 3, k8 = id & 7; const LAS float* s = T + (k8 * 8) * LP + n;
        u32x4 o; o.x = pk2(s[0 * LP], s[1 * LP]); o.y = pk2(s[2 * LP], s[3 * LP]); o.z = pk2(s[4 * LP], s[5 * LP]); o.w = pk2(s[6 * LP], s[7 * LP]);
        *(u32x4*)(WT + (size_t)(drow0 + n) * K + k0 + 8 * k8) = o; }
}
__device__ __forceinline__ void rms_rows4_to_bf16(const float* x0, bf16* o0, int lane) {
    f32x4 v[4][4]; float s[4];
#pragma unroll
    for (int q = 0; q < 4; ++q) { const f32x4* xr = (const f32x4*)(x0 + q * 1024) + lane;
#pragma unroll
        for (int j = 0; j < 4; ++j) v[q][j] = xr[64 * j]; }
#pragma unroll
    for (int q = 0; q < 4; ++q) { s[q] = 0.f;
#pragma unroll
        for (int j = 0; j < 4; ++j) s[q] += (v[q][j].x * v[q][j].x + v[q][j].y * v[q][j].y) + (v[q][j].z * v[q][j].z + v[q][j].w * v[q][j].w); }
#pragma unroll
    for (int o = 1; o < 64; o <<= 1) {
#pragma unroll
        for (int q = 0; q < 4; ++q) s[q] += __shfl_xor(s[q], o); }
#pragma unroll
    for (int q = 0; q < 4; ++q) { const float rstd = rsqrtf(s[q] * (1.f / 1024.f) + 1e-6f); u32x2* o8 = (u32x2*)(o0 + q * 1024) + lane;
#pragma unroll
        for (int j = 0; j < 4; ++j) { u32x2 w; w.x = pk2(v[q][j].x * rstd, v[q][j].y * rstd); w.y = pk2(v[q][j].z * rstd, v[q][j].w * rstd); o8[64 * j] = w; } }
}
#define XB_TMO      128
#define XB_XCNT(j)  (256  + 64 * (j))
#define XB_XSUB(j)  (1280 + 64 * (j))
#define XB_XGEN(j)  (2304 + 64 * (j))
#define XB_TOP      3328
#define XB_TOPGEN   3392
#define XCD_BAR_WORDS 3456
#define XB_SPIN_CAP (1u << 18)

__device__ __forceinline__ unsigned xb_ld(unsigned* p)              { return __hip_atomic_load(p, __ATOMIC_RELAXED, __HIP_MEMORY_SCOPE_AGENT); }
__device__ __forceinline__ unsigned xb_add(unsigned* p, unsigned v) { return __hip_atomic_fetch_add(p, v, __ATOMIC_RELAXED, __HIP_MEMORY_SCOPE_AGENT); }
__device__ __forceinline__ unsigned xb_xcc_id() { return (unsigned)__builtin_amdgcn_s_getreg((3 << 11) | 20) & 0xFu; }
#define XB_SPIN(cond, bar) do { unsigned _sp = 0; while (cond) { __builtin_amdgcn_s_sleep(1); \
    if ((++_sp & 255u) == 0u) { if (xb_ld(&(bar)[XB_TMO])) break; if (_sp > XB_SPIN_CAP) { atomicAdd(&(bar)[XB_TMO], 1u); break; } } } } while (0)

struct XcdBarrier {
    unsigned* bar; unsigned x;
    volatile LAS unsigned* st;
};

__device__ __forceinline__ XcdBarrier xcd_barrier_post(unsigned* bar, volatile LAS unsigned* st) {
    XcdBarrier b; b.bar = bar; b.x = xb_xcc_id(); b.st = st;
    if (threadIdx.x == 0) (void)xb_add(&bar[XB_XCNT(b.x)], 1u);
    return b;
}
__device__ __forceinline__ void xcd_barrier_complete(unsigned* bar, unsigned x, unsigned& nloc, unsigned& nx) {
    const unsigned G = gridDim.x * gridDim.y * gridDim.z;
    unsigned sum, cnt, mine, sp = 0u;
    for (;;) {
        sum = 0u; cnt = 0u; mine = 0u;
#pragma unroll
        for (unsigned j = 0; j < 16; ++j) { const unsigned c = xb_ld(&bar[XB_XCNT(j)]); sum += c; cnt += (c > 0u) ? 1u : 0u; mine = (j == x) ? c : mine; }
        if (sum == G) break;
        __builtin_amdgcn_s_sleep(1);
        if ((++sp & 255u) == 0u) { if (xb_ld(&bar[XB_TMO])) break; if (sp > XB_SPIN_CAP) { atomicAdd(&bar[XB_TMO], 1u); break; } }
    }
    nloc = mine > 0u ? mine : 1u; nx = cnt > 0u ? cnt : 1u;
}

__device__ __forceinline__ void xcd_barrier(const XcdBarrier& b, const bool leader) {
    asm volatile("s_waitcnt vmcnt(0)" ::: "memory");
    __syncthreads();
    if (leader) {
        unsigned* bar = b.bar;
        __builtin_amdgcn_s_waitcnt(0);
        unsigned nloc = b.st[0], nx = b.st[1];
        if (nloc == 0u) { xcd_barrier_complete(bar, b.x, nloc, nx); b.st[0] = nloc; b.st[1] = nx; }
        const unsigned old = xb_add(&bar[XB_XSUB(b.x)], 1u);
        const unsigned gen = old / nloc;
        if (old + 1u == (gen + 1u) * nloc) {
            __builtin_amdgcn_fence(__ATOMIC_RELEASE, "agent");
            asm volatile("s_waitcnt vmcnt(0)" ::: "memory");
            const unsigned og = xb_add(&bar[XB_TOP], 1u);
            const unsigned tg = og / nx;
            if (og + 1u == (tg + 1u) * nx) xb_add(&bar[XB_TOPGEN], 1u);
            else XB_SPIN(xb_ld(&bar[XB_TOPGEN]) == tg, bar);
            __builtin_amdgcn_fence(__ATOMIC_ACQUIRE, "agent");
            xb_add(&bar[XB_XGEN(b.x)], 1u);
            asm volatile("s_waitcnt vmcnt(0)" ::: "memory");
        } else {
            XB_SPIN(xb_ld(&bar[XB_XGEN(b.x)]) == gen, bar);
            __builtin_amdgcn_fence(__ATOMIC_ACQUIRE, "agent");
            asm volatile("s_waitcnt vmcnt(0)" ::: "memory");
        }
    }
    __syncthreads();
}
constexpr int ATT_VP = 144, ATT_WLDS = 10496;
__device__ __forceinline__ s16x4 tr16(LAS const unsigned char* p) { typedef short v4i16_t __attribute__((ext_vector_type(4)));
    return __builtin_bit_cast(s16x4, __builtin_amdgcn_ds_read_tr16_b64_v4i16((LAS v4i16_t*)p)); }
__device__ __forceinline__ bf16x8 cat8(s16x4 a, s16x4 b) { return (bf16x8){a[0], a[1], a[2], a[3], b[0], b[1], b[2], b[3]}; }
__device__ __forceinline__ bf16x8 pack8(const f32x16& v, int o) { u32x4 w; w.x = pk2(v[o], v[o + 1]); w.y = pk2(v[o + 2], v[o + 3]); w.z = pk2(v[o + 4], v[o + 5]); w.w = pk2(v[o + 6], v[o + 7]); return __builtin_bit_cast(bf16x8, w); }

__device__ __forceinline__ void attn_unit(LAS unsigned char* wl, const bf16* Qc, bf16* Oc, const bf16* KBc, const bf16* VBc, const bf16* CK, const bf16* CV, bool sample, int t0, const float* tabh, int lane, const int qh) {
    const int r32 = lane & 31, hi = lane >> 5, g16 = lane >> 4, i16 = lane & 15;
    LAS float* btab = (LAS float*)(wl + 9216);
    asm volatile("" ::: "memory");
    for (int i = lane; i < 257; i += 64) btab[i] = tabh[i];
    const float cb = tabh[256];
    bf16x8 qfr[4];
#pragma unroll
    for (int d0 = 0; d0 < 4; ++d0) qfr[d0] = *(const bf16x8*)(Qc + (size_t)(32 * qh + r32) * 1024 + 16 * d0 + 8 * hi);
    f32x16 oT[2];
#pragma unroll
    for (int a = 0; a < 2; ++a)
#pragma unroll
        for (int r = 0; r < 16; ++r) oT[a][r] = 0.f;
    float mrun = -1e30f, lrun = 0.f;
    const int traddr = ((g16 >> 1) * 4 + (i16 >> 2)) * ATT_VP + ((g16 & 1) * 16 + (i16 & 3) * 4) * 2;
    for (int t = t0; t < 9; ++t) {
        const bf16 *kp, *vp;
        if (sample && t < 8) { kp = CK + (size_t)t * 64 * 1024; vp = CV + (size_t)t * 64 * 1024; }
        else { const long off = -(long)(8 - t) * 64 * 1024; kp = KBc + off; vp = VBc + off; }
        u32x4 vreg[8];
#pragma unroll
        for (int i = 0; i < 8; ++i) vreg[i] = *(const u32x4*)(vp + (size_t)(8 * i + (lane >> 3)) * 1024 + (lane & 7) * 8);
        bf16x8 kf[2][4];
#pragma unroll
        for (int kvh = 0; kvh < 2; ++kvh)
#pragma unroll
            for (int d0 = 0; d0 < 4; ++d0) kf[kvh][d0] = *(const bf16x8*)(kp + (size_t)(32 * kvh + r32) * 1024 + 16 * d0 + 8 * hi);
        LDS_WAIT();
#pragma unroll
        for (int i = 0; i < 8; ++i) *(LAS u32x4*)(wl + (8 * i + (lane >> 3)) * ATT_VP + (lane & 7) * 16) = vreg[i];
        {
            f32x16 s0, s1;
#pragma unroll
            for (int r = 0; r < 16; ++r) { s0[r] = 0.f; s1[r] = 0.f; }
#pragma unroll
            for (int d0 = 0; d0 < 4; ++d0) { s0 = __builtin_amdgcn_mfma_f32_32x32x16_bf16(kf[0][d0], qfr[d0], s0, 0, 0, 0); s1 = __builtin_amdgcn_mfma_f32_32x32x16_bf16(kf[1][d0], qfr[d0], s1, 0, 0, 0); }
            if (t < 6) {
#pragma unroll
                for (int r = 0; r < 16; ++r) { s0[r] += cb; s1[r] += cb; }
            } else {
                const int relb = 64 * (8 - t) + 32 * qh + r32 + 128;
#pragma unroll
                for (int r = 0; r < 16; ++r) { const int i0 = relb - crow(r, hi); s0[r] += btab[i0 > 256 ? 256 : i0]; const int i1 = i0 - 32; s1[r] += btab[i1 > 256 ? 256 : i1]; }
            }
            float tm = fmaxf(s0[0], s1[0]);
#pragma unroll
            for (int r = 1; r < 16; ++r) tm = fmaxf(tm, fmaxf(s0[r], s1[r]));
            tm = fmaxf(tm, __shfl_xor(tm, 32));
            const float mn = fmaxf(mrun, tm), sc = __expf(mrun - mn); mrun = mn;
            float ps = 0.f;
#pragma unroll
            for (int r = 0; r < 16; ++r) { s0[r] = __expf(s0[r] - mn); s1[r] = __expf(s1[r] - mn); ps += s0[r] + s1[r]; }
            lrun = lrun * sc + ps;
#pragma unroll
            for (int r = 0; r < 16; ++r) { oT[0][r] *= sc; oT[1][r] *= sc; }
            bf16x8 pf[4]; pf[0] = pack8(s0, 0); pf[1] = pack8(s0, 8); pf[2] = pack8(s1, 0); pf[3] = pack8(s1, 8);
            LDS_WAIT();
#pragma unroll
            for (int dh = 0; dh < 2; ++dh)
#pragma unroll
                for (int kc = 0; kc < 4; ++kc) {
                    LAS const unsigned char* p = wl + traddr + (16 * kc) * ATT_VP + dh * 64;
                    const bf16x8 vf = cat8(tr16(p), tr16(p + 8 * ATT_VP));
                    oT[dh] = __builtin_amdgcn_mfma_f32_32x32x16_bf16(vf, pf[kc], oT[dh], 0, 0, 0);
                }
        }
        asm volatile("" ::: "memory");
    }
    {
        const float lt = lrun + __shfl_xor(lrun, 32), inv = 1.0f / lt;
        bf16* orow = Oc + (size_t)(32 * qh + r32) * 1024;
#pragma unroll
        for (int dh = 0; dh < 2; ++dh)
#pragma unroll
            for (int rg = 0; rg < 4; ++rg) { u32x2 w; w.x = pk2(oT[dh][4 * rg] * inv, oT[dh][4 * rg + 1] * inv); w.y = pk2(oT[dh][4 * rg + 2] * inv, oT[dh][4 * rg + 3] * inv);
                *(u32x2*)(orow + 32 * dh + 8 * rg + 4 * hi) = w; }
    }
    LDS_WAIT(); asm volatile("" ::: "memory");
}
constexpr int AB_HB = 18432, AB_BUF = 2 * AB_HB, AB_TAB = 2 * AB_BUF;
__device__ __forceinline__ void attn_block_unit(LAS unsigned char* lds, const bf16* QB, bf16* OB, const bf16* KB, const bf16* VB, int sb, int hp, int cp, const float* tab, int tid) {
    const int lane = tid & 63, w = __builtin_amdgcn_readfirstlane(tid >> 6), r32 = lane & 31, hi = lane >> 5, g16 = lane >> 4, i16 = lane & 15;
    const int hsel = w >> 2, csel = (w >> 1) & 1, qh = w & 1, h = 2 * hp + hsel, c = 2 * cp + csel;
    LAS float* btab = (LAS float*)(lds + AB_TAB + hsel * 1040);
    __syncthreads();
    for (int i = tid; i < 2 * 257; i += NTHREADS) { const int hh = i >= 257, k = i - 257 * hh; ((LAS float*)(lds + AB_TAB + hh * 1040))[k] = tab[(2 * hp + hh) * 257 + k]; }
    const float cb = tab[h * 257 + 256];
    const size_t hoff = (size_t)h * 64;
    const bf16* Qc = QB + ((size_t)sb * 2048 + (size_t)c * 64) * 1024 + hoff;
    bf16x8 qfr[4];
#pragma unroll
    for (int d0 = 0; d0 < 4; ++d0) qfr[d0] = *(const bf16x8*)(Qc + (size_t)(32 * qh + r32) * 1024 + 16 * d0 + 8 * hi);
    f32x16 oT[2];
#pragma unroll
    for (int a = 0; a < 2; ++a)
#pragma unroll
        for (int r = 0; r < 16; ++r) oT[a][r] = 0.f;
    float mrun = -1e30f, lrun = 0.f;
    const int traddr = ((g16 >> 1) * 4 + (i16 >> 2)) * ATT_VP + ((g16 & 1) * 16 + (i16 & 3) * 4) * 2;
    const int lrow = tid >> 3, lch = tid & 7;
    const int tc0 = 2 * cp - 8, j0 = tc0 < 0 ? -tc0 : 0;
    const size_t pbase = ((size_t)sb * 2048 + lrow) * 1024 + (size_t)(2 * hp) * 64 + lch * 8;
    const bf16* kbase = KB + pbase; const bf16* vbase = VB + pbase;
    u32x4 kreg0, vreg0, kreg1, vreg1;
#define AB_LOAD(jj) do { const long o_ = (long)(tc0 + (jj)) * 64 * 1024; kreg0 = *(const u32x4*)(kbase + o_); vreg0 = *(const u32x4*)(vbase + o_); kreg1 = *(const u32x4*)(kbase + o_ + 64); vreg1 = *(const u32x4*)(vbase + o_ + 64); } while (0)
#define AB_STORE(jj) do { LAS unsigned char* b_ = lds + ((jj) & 1) * AB_BUF + lrow * ATT_VP + lch * 16; *(LAS u32x4*)b_ = kreg0; *(LAS u32x4*)(b_ + 9216) = vreg0; *(LAS u32x4*)(b_ + AB_HB) = kreg1; *(LAS u32x4*)(b_ + AB_HB + 9216) = vreg1; } while (0)
    AB_LOAD(j0); AB_STORE(j0);
    for (int j = j0; j < 10; ++j) {
        __syncthreads();
        if (j + 1 < 10) AB_LOAD(j + 1);
        const int t = j - csel;
        if (t >= 0 && t < 9) {
            LAS const unsigned char* kb = lds + (j & 1) * AB_BUF + hsel * AB_HB; LAS const unsigned char* vb = kb + 9216;
            f32x16 s0, s1;
#pragma unroll
            for (int r = 0; r < 16; ++r) { s0[r] = 0.f; s1[r] = 0.f; }
#pragma unroll
            for (int d0 = 0; d0 < 4; ++d0) {
                const bf16x8 k0 = *(const LAS bf16x8*)(kb + r32 * ATT_VP + (16 * d0 + 8 * hi) * 2), k1 = *(const LAS bf16x8*)(kb + (32 + r32) * ATT_VP + (16 * d0 + 8 * hi) * 2);
                s0 = __builtin_amdgcn_mfma_f32_32x32x16_bf16(k0, qfr[d0], s0, 0, 0, 0); s1 = __builtin_amdgcn_mfma_f32_32x32x16_bf16(k1, qfr[d0], s1, 0, 0, 0); }
            if (t < 6) {
#pragma unroll
                for (int r = 0; r < 16; ++r) { s0[r] += cb; s1[r] += cb; }
            } else {
                const int relb = 64 * (8 - t) + 32 * qh + r32 + 128;
#pragma unroll
                for (int r = 0; r < 16; ++r) { const int i0 = relb - crow(r, hi); s0[r] += btab[i0 > 256 ? 256 : i0]; const int i1 = i0 - 32; s1[r] += btab[i1 > 256 ? 256 : i1]; }
            }
            float tm = fmaxf(s0[0], s1[0]);
#pragma unroll
            for (int r = 1; r < 16; ++r) tm = fmaxf(tm, fmaxf(s0[r], s1[r]));
            tm = fmaxf(tm, __shfl_xor(tm, 32));
            const float mn = fmaxf(mrun, tm), sc = __expf(mrun - mn); mrun = mn;
            float ps = 0.f;
#pragma unroll
            for (int r = 0; r < 16; ++r) { s0[r] = __expf(s0[r] - mn); s1[r] = __expf(s1[r] - mn); ps += s0[r] + s1[r]; }
            lrun = lrun * sc + ps;
#pragma unroll
            for (int r = 0; r < 16; ++r) { oT[0][r] *= sc; oT[1][r] *= sc; }
            bf16x8 pf[4]; pf[0] = pack8(s0, 0); pf[1] = pack8(s0, 8); pf[2] = pack8(s1, 0); pf[3] = pack8(s1, 8);
#pragma unroll
            for (int dh = 0; dh < 2; ++dh)
#pragma unroll
                for (int kc = 0; kc < 4; ++kc) {
                    LAS const unsigned char* p = vb + traddr + (16 * kc) * ATT_VP + dh * 64;
                    const bf16x8 vf = cat8(tr16(p), tr16(p + 8 * ATT_VP));
                    oT[dh] = __builtin_amdgcn_mfma_f32_32x32x16_bf16(vf, pf[kc], oT[dh], 0, 0, 0);
                }
        }
        if (j + 1 < 10) AB_STORE(j + 1);
    }
#undef AB_LOAD
#undef AB_STORE
    {
        const float lt = lrun + __shfl_xor(lrun, 32), inv = 1.0f / lt;
        bf16* orow = OB + ((size_t)sb * 2048 + (size_t)c * 64 + 32 * qh + r32) * 1024 + hoff;
#pragma unroll
        for (int dh = 0; dh < 2; ++dh)
#pragma unroll
            for (int rg = 0; rg < 4; ++rg) { u32x2 wv; wv.x = pk2(oT[dh][4 * rg] * inv, oT[dh][4 * rg + 1] * inv); wv.y = pk2(oT[dh][4 * rg + 2] * inv, oT[dh][4 * rg + 3] * inv);
                *(u32x2*)(orow + 32 * dh + 8 * rg + 4 * hi) = wv; }
    }
}
template <int MODE> __device__ __forceinline__ void small_gemm_res(LAS unsigned char* lds, const bf16* A, const bf16* Bt, int K, const float* base, const bf16* baseb, float* H, bf16* XN, float* SS, float alpha, const bf16* GGs, int bx, int G, int tid) {
    const int lane = tid & 63, w = __builtin_amdgcn_readfirstlane(tid >> 6), r32 = lane & 31, hi = lane >> 5;
    const int kw = K >> 3;
    LAS float* P = (LAS float*)lds;
    for (int tile = bx; tile < 256; tile += G) {
        const int t0 = (tile >> 4) * 32, n0 = (tile & 15) * 64;
        f32x16 acc0, acc1;
#pragma unroll
        for (int r = 0; r < 16; ++r) { acc0[r] = 0.f; acc1[r] = 0.f; }
        const bf16* ap = A + (size_t)(t0 + r32) * K + w * kw + 8 * hi;
        const bf16* b0p = Bt + (size_t)(n0 + r32) * K + w * kw + 8 * hi; const bf16* b1p = b0p + (size_t)32 * K;
#pragma unroll 4
        for (int k = 0; k < kw; k += 16) {
            const bf16x8 x = *(const bf16x8*)(ap + k), w0 = *(const bf16x8*)(b0p + k), w1 = *(const bf16x8*)(b1p + k);
            acc0 = __builtin_amdgcn_mfma_f32_32x32x16_bf16(w0, x, acc0, 0, 0, 0); acc1 = __builtin_amdgcn_mfma_f32_32x32x16_bf16(w1, x, acc1, 0, 0, 0);
        }
        LAS float* Pw = P + w * 2112;
#pragma unroll
        for (int r = 0; r < 16; ++r) { Pw[crow(r, hi) * 33 + r32] = acc0[r]; Pw[(32 + crow(r, hi)) * 33 + r32] = acc1[r]; }
        __syncthreads();
        const int tok = tid >> 4, nq = tid & 15;
        float v[4] = {0.f, 0.f, 0.f, 0.f};
#pragma unroll
        for (int ww = 0; ww < 8; ++ww)
#pragma unroll
            for (int e = 0; e < 4; ++e) v[e] += P[ww * 2112 + (4 * nq + e) * 33 + tok];
        const size_t off = (size_t)(t0 + tok) * 1024 + n0 + 4 * nq;
        if (MODE == 0) {
            f32x4 b; if (baseb) { const u32x2 bw = *(const u32x2*)(baseb + off); b = (f32x4){bflo(bw.x), bfhi(bw.x), bflo(bw.y), bfhi(bw.y)}; } else b = *(const f32x4*)(base + off);
            const f32x4 hv = (f32x4){b[0] + alpha * v[0], b[1] + alpha * v[1], b[2] + alpha * v[2], b[3] + alpha * v[3]};
            if (H) *(f32x4*)(H + off) = hv;
            if (XN) { u32x2 xw; xw.x = pk2(hv[0], hv[1]); xw.y = pk2(hv[2], hv[3]); *(u32x2*)(XN + off) = xw; }
            if (SS) { float ss = (hv[0] * hv[0] + hv[1] * hv[1]) + (hv[2] * hv[2] + hv[3] * hv[3]);
                ss += __shfl_xor(ss, 1); ss += __shfl_xor(ss, 2); ss += __shfl_xor(ss, 4); ss += __shfl_xor(ss, 8);
                if (nq == 0) SS[(size_t)(t0 + tok) * 16 + (n0 >> 6)] = ss; }
        } else {
            const u32x2 gw = *(const u32x2*)(GGs + (size_t)(t0 + tok) * 2048 + n0 + 4 * nq);
            f32x4 o = (f32x4){pg8::fast_sigmoid(bflo(gw.x)) * v[0], pg8::fast_sigmoid(bfhi(gw.x)) * v[1], pg8::fast_sigmoid(bflo(gw.y)) * v[2], pg8::fast_sigmoid(bfhi(gw.y)) * v[3]};
            if (MODE == 1) { u32x2 xw; xw.x = pk2(o[0], o[1]); xw.y = pk2(o[2], o[3]); *(u32x2*)(XN + off) = xw; }
            else { const u32x2 tw = *(const u32x2*)(baseb + off); o += (f32x4){bflo(tw.x), bfhi(tw.x), bflo(tw.y), bfhi(tw.y)};
                u32x2 xw; xw.x = pk2(o[0], o[1]); xw.y = pk2(o[2], o[3]); *(u32x2*)(XN + off) = xw; }
        }
        __syncthreads();
    }
}
constexpr int G_QD = 0, G_KI = 17408, G_VV = 34816, G_B = 71680, G_FA = 105472, G_SEG = 109568, G_SSQ = 111616;
constexpr int G_KT = 113664, GKTP = 320;
constexpr int GP = 272, GVP = 576, GBP = 132;
constexpr size_t WS_DECB = (size_t)1056 * 65536;
__device__ __forceinline__ bf16* ub_slot(unsigned char* ybase, int unit, int) { return (bf16*)ybase + (size_t)unit * 32768; }
__device__ __forceinline__ void gla_a_unit(LAS unsigned char* lds, bf16* QKA, bf16* VA, const float* FA, unsigned char* ws, int xnrow0, float* DECB, int lchunk, int h,
                                           const float* wgate, const float* bgate, int tid) {
    const int lane = tid & 63, w = __builtin_amdgcn_readfirstlane(tid >> 6), r32 = lane & 31, hi = lane >> 5, g16 = lane >> 4, i16 = lane & 15;
    const int gd = tid & 127, tq = tid >> 7;
    LAS float* Bimg = (LAS float*)(lds + G_B); LAS float* FAi = (LAS float*)(lds + G_FA); LAS float* SEG = (LAS float*)(lds + G_SEG);
    const int trrow = (g16 >> 1) * 4 + (i16 >> 2), trcol = (g16 & 1) * 16 + (i16 & 3) * 4;
    const size_t row0 = (size_t)lchunk * 64; const int unit = lchunk * 4 + h;
    u32x4 qv[2], kv[2];
#pragma unroll
    for (int i = 0; i < 2; ++i) { const int id = tid + 512 * i, row = id >> 4, ch = id & 15; const bf16* p = QKA + (row0 + row) * 1024 + h * 128 + ch * 8; qv[i] = *(const u32x4*)p; kv[i] = *(const u32x4*)(p + 512); }
    if (tid < 256) *(LAS f32x4*)(FAi + tid * 4) = *(const f32x4*)(FA + row0 * 16 + tid * 4);
#pragma unroll
    for (int i = 0; i < 4; ++i) { const int id = tid + 512 * i, row = id >> 5, ch = id & 31; *(LAS u32x4*)(lds + G_VV + row * GVP + ch * 16) = *(const u32x4*)(VA + (row0 + row) * 1024 + h * 256 + ch * 8); }
    __syncthreads();
    {
        float wg[16];
#pragma unroll
        for (int r = 0; r < 16; ++r) wg[r] = wgate[r * 512 + h * 128 + gd];
        const float bg = bgate[h * 128 + gd];
        float run = 0.f;
#pragma unroll
        for (int tt = 0; tt < 16; ++tt) { const int t = tq * 16 + tt; const LAS f32x4* fp = (const LAS f32x4*)(FAi + t * 16); float x = bg;
#pragma unroll
            for (int q = 0; q < 4; ++q) { const f32x4 f = fp[q]; x += f[0] * wg[4 * q] + f[1] * wg[4 * q + 1] + f[2] * wg[4 * q + 2] + f[3] * wg[4 * q + 3]; }
            const float ls = fminf(x, 0.f) - __logf(1.0f + __expf(-fabsf(x))); run += ls * 0.0625f; Bimg[t * GBP + gd] = run;
            if ((tt & 3) == 3) asm volatile("" ::: "memory"); }
        SEG[tq * 128 + gd] = run;
    }
    __syncthreads();
#pragma unroll
    for (int i = 0; i < 2; ++i) { const int id = tid + 512 * i, row = id >> 4, ch = id & 15;
        f32x4 b0 = *(const LAS f32x4*)(Bimg + row * GBP + ch * 8), b1 = *(const LAS f32x4*)(Bimg + row * GBP + ch * 8 + 4);
        f32x4 l0 = (f32x4){0.f, 0.f, 0.f, 0.f}, l1 = l0;
#pragma unroll
        for (int q = 0; q < 4; ++q) { const f32x4 s0v = *(const LAS f32x4*)(SEG + q * 128 + ch * 8), s1v = *(const LAS f32x4*)(SEG + q * 128 + ch * 8 + 4);
            l0 += s0v; l1 += s1v; if (q < (row >> 4)) { b0 += s0v; b1 += s1v; } }
        if (row == 0) { float* dp = DECB + (size_t)unit * 128 + ch * 8;
            *(f32x4*)dp = (f32x4){__expf(l0[0]), __expf(l0[1]), __expf(l0[2]), __expf(l0[3])}; *(f32x4*)(dp + 4) = (f32x4){__expf(l1[0]), __expf(l1[1]), __expf(l1[2]), __expf(l1[3])}; }
        const float bb[8] = {b0[0], b0[1], b0[2], b0[3], b1[0], b1[1], b1[2], b1[3]};
        const unsigned qw[4] = {qv[i].x, qv[i].y, qv[i].z, qv[i].w}, kw[4] = {kv[i].x, kv[i].y, kv[i].z, kv[i].w};
        unsigned oq[4], oi[4];
#pragma unroll
        for (int e = 0; e < 4; ++e) { const float q0 = bflo(qw[e]), q1 = bfhi(qw[e]), k0 = bflo(kw[e]), k1 = bfhi(kw[e]);
            const float e0 = __expf(bb[2 * e]), e1 = __expf(bb[2 * e + 1]), n0 = __expf(-bb[2 * e]), n1 = __expf(-bb[2 * e + 1]);
            oq[e] = pk2(q0 * e0, q1 * e1); oi[e] = pk2(k0 * n0, k1 * n1); }
        const u32x4 qd = (u32x4){oq[0], oq[1], oq[2], oq[3]};
        *(LAS u32x4*)(lds + G_QD + row * GP + ch * 16) = qd;
        *(LAS u32x4*)(lds + G_KI + row * GP + ch * 16) = (u32x4){oi[0], oi[1], oi[2], oi[3]};
        *(LAS u32x4*)(lds + G_KT + row * GKTP + ch * 16) = (u32x4){oi[0], oi[1], oi[2], oi[3]};
        *(u32x4*)(QKA + (row0 + row) * 1024 + h * 128 + ch * 8) = qd; }
    __syncthreads();
    bf16x8 vvf[4];
#pragma unroll
    for (int kc = 0; kc < 4; ++kc) { LAS const unsigned char* p = lds + G_VV + (16 * kc + trrow) * GVP + (32 * w + trcol) * 2; vvf[kc] = cat8(tr16(p), tr16(p + 8 * GVP)); }
    f32x16 s00, s01, s11;
#pragma unroll
    for (int r = 0; r < 16; ++r) { s00[r] = 0.f; s01[r] = 0.f; s11[r] = 0.f; }
#pragma unroll
    for (int s = 0; s < 8; ++s) {
        const bf16x8 a0 = *(const LAS bf16x8*)(lds + G_KI + r32 * GP + (16 * s + 8 * hi) * 2), a1 = *(const LAS bf16x8*)(lds + G_KI + (32 + r32) * GP + (16 * s + 8 * hi) * 2);
        const bf16x8 b0 = *(const LAS bf16x8*)(lds + G_QD + r32 * GP + (16 * s + 8 * hi) * 2), b1 = *(const LAS bf16x8*)(lds + G_QD + (32 + r32) * GP + (16 * s + 8 * hi) * 2);
        s00 = __builtin_amdgcn_mfma_f32_32x32x16_bf16(a0, b0, s00, 0, 0, 0); s01 = __builtin_amdgcn_mfma_f32_32x32x16_bf16(a0, b1, s01, 0, 0, 0); s11 = __builtin_amdgcn_mfma_f32_32x32x16_bf16(a1, b1, s11, 0, 0, 0);
    }
#pragma unroll
    for (int r = 0; r < 16; ++r) if (crow(r, hi) > r32) { s00[r] = 0.f; s11[r] = 0.f; }
    const bf16x8 p00a = pack8(s00, 0), p00b = pack8(s00, 8), p01a = pack8(s01, 0), p01b = pack8(s01, 8), p11a = pack8(s11, 0), p11b = pack8(s11, 8);
    f32x16 oT0, oT1;
#pragma unroll
    for (int r = 0; r < 16; ++r) { oT0[r] = 0.f; oT1[r] = 0.f; }
    oT0 = __builtin_amdgcn_mfma_f32_32x32x16_bf16(vvf[0], p00a, oT0, 0, 0, 0); oT0 = __builtin_amdgcn_mfma_f32_32x32x16_bf16(vvf[1], p00b, oT0, 0, 0, 0);
    oT1 = __builtin_amdgcn_mfma_f32_32x32x16_bf16(vvf[0], p01a, oT1, 0, 0, 0); oT1 = __builtin_amdgcn_mfma_f32_32x32x16_bf16(vvf[1], p01b, oT1, 0, 0, 0);
    oT1 = __builtin_amdgcn_mfma_f32_32x32x16_bf16(vvf[2], p11a, oT1, 0, 0, 0); oT1 = __builtin_amdgcn_mfma_f32_32x32x16_bf16(vvf[3], p11b, oT1, 0, 0, 0);
    { bf16* p0 = VA + (row0 + (2 * w) * 4 + g16) * 1024 + h * 256 + i16 * 16; bf16* p1 = p0 + 4 * 1024;
      *(u32x4*)p0 = __builtin_bit_cast(u32x4, pack8(oT0, 0)); *(u32x4*)(p0 + 8) = __builtin_bit_cast(u32x4, pack8(oT0, 8));
      *(u32x4*)p1 = __builtin_bit_cast(u32x4, pack8(oT1, 0)); *(u32x4*)(p1 + 8) = __builtin_bit_cast(u32x4, pack8(oT1, 8)); }
    bf16* up = ub_slot(ws, unit, xnrow0) + (size_t)w * 4096 + lane * 8;
#pragma unroll
    for (int db = 0; db < 4; ++db) { f32x16 uacc;
#pragma unroll
        for (int r = 0; r < 16; ++r) uacc[r] = 0.f;
#pragma unroll
        for (int kc = 0; kc < 4; ++kc) { LAS const unsigned char* p = lds + G_KT + (16 * kc + trrow) * GKTP + (32 * db + trcol) * 2;
            uacc = __builtin_amdgcn_mfma_f32_32x32x16_bf16(cat8(tr16(p), tr16(p + 8 * GKTP)), vvf[kc], uacc, 0, 0, 0); }
        *(u32x4*)(up + (db * 2) * 512) = __builtin_bit_cast(u32x4, pack8(uacc, 0)); *(u32x4*)(up + (db * 2 + 1) * 512) = __builtin_bit_cast(u32x4, pack8(uacc, 8)); }
    __syncthreads();
}

__device__ __forceinline__ void gla_scan_vec(unsigned char* ws, int xnrow0, const float* DECB, int lchunk0, int nchunks, int h, int e, const float* s0, float* sout) {
    const int lane = e & 63, s2 = (e >> 6) & 1, db = (e >> 7) & 3, w = e >> 9, hi = lane >> 5, r32 = lane & 31;
    const int dbase = 32 * db + 16 * s2 + 4 * hi, v = 32 * w + r32;
    float S[8];
#pragma unroll
    for (int jj = 0; jj < 8; ++jj) S[jj] = s0 ? s0[(size_t)(dbase + 8 * (jj >> 2) + (jj & 3)) * 256 + v] : 0.f;
    for (int n0 = 0; n0 < nchunks; n0 += 4) {
        u32x4 uw[4]; f32x4 d0[4], d1[4]; bf16* up[4];
#pragma unroll
        for (int q = 0; q < 4; ++q) { const int n = (n0 + q < nchunks) ? n0 + q : nchunks - 1; const int unit = (lchunk0 + n) * 4 + h;
            up[q] = ub_slot(ws, unit, xnrow0) + (size_t)e * 8; uw[q] = *(const u32x4*)up[q];
            d0[q] = *(const f32x4*)(DECB + (size_t)unit * 128 + dbase); d1[q] = *(const f32x4*)(DECB + (size_t)unit * 128 + dbase + 8); }
#pragma unroll
        for (int q = 0; q < 4; ++q) if (n0 + q < nchunks) {
            *(u32x4*)up[q] = (u32x4){pk2(S[0], S[1]), pk2(S[2], S[3]), pk2(S[4], S[5]), pk2(S[6], S[7])};
            S[0] = d0[q][0] * (S[0] + bflo(uw[q].x)); S[1] = d0[q][1] * (S[1] + bfhi(uw[q].x)); S[2] = d0[q][2] * (S[2] + bflo(uw[q].y)); S[3] = d0[q][3] * (S[3] + bfhi(uw[q].y));
            S[4] = d1[q][0] * (S[4] + bflo(uw[q].z)); S[5] = d1[q][1] * (S[5] + bfhi(uw[q].z)); S[6] = d1[q][2] * (S[6] + bflo(uw[q].w)); S[7] = d1[q][3] * (S[7] + bfhi(uw[q].w)); }
    }
#pragma unroll
    for (int jj = 0; jj < 8; ++jj) sout[(size_t)(dbase + 8 * (jj >> 2) + (jj & 3)) * 256 + v] = S[jj];
}

__device__ __forceinline__ void gla_c_unit(LAS unsigned char* lds, const bf16* QKA, const bf16* VA, const bf16* RA, unsigned char* ws, int xnrow0, bf16* OA, int lchunk, int h, const float* gnorm, int tid) {
    const int lane = tid & 63, w = __builtin_amdgcn_readfirstlane(tid >> 6), r32 = lane & 31, hi = lane >> 5, g16 = lane >> 4, i16 = lane & 15;
    LAS float* SSQ = (LAS float*)(lds + G_SSQ);
    const size_t row0 = (size_t)lchunk * 64; const int unit = lchunk * 4 + h;
#pragma unroll
    for (int i = 0; i < 2; ++i) { const int id = tid + 512 * i, row = id >> 4, ch = id & 15; *(LAS u32x4*)(lds + G_QD + row * GP + ch * 16) = *(const u32x4*)(QKA + (row0 + row) * 1024 + h * 128 + ch * 8); }
    bf16x8 sf[8];
    { const bf16* up = ub_slot(ws, unit, xnrow0) + (size_t)w * 4096 + lane * 8;
#pragma unroll
      for (int f = 0; f < 8; ++f) sf[f] = *(const bf16x8*)(up + f * 512); }
    u32x2 rwv[2][4];
#pragma unroll
    for (int ib = 0; ib < 2; ++ib)
#pragma unroll
        for (int rg = 0; rg < 4; ++rg) rwv[ib][rg] = *(const u32x2*)(RA + (row0 + 32 * ib + r32) * 1024 + h * 256 + 32 * w + 4 * hi + 8 * rg);
    f32x16 oT0, oT1;
    { const bf16* p0 = VA + (row0 + (2 * w) * 4 + g16) * 1024 + h * 256 + i16 * 16; const bf16* p1 = p0 + 4 * 1024;
      const u32x4 a0 = *(const u32x4*)p0, a1 = *(const u32x4*)(p0 + 8), c0 = *(const u32x4*)p1, c1 = *(const u32x4*)(p1 + 8);
      const unsigned aw[8] = {a0.x, a0.y, a0.z, a0.w, a1.x, a1.y, a1.z, a1.w}, cw[8] = {c0.x, c0.y, c0.z, c0.w, c1.x, c1.y, c1.z, c1.w};
#pragma unroll
      for (int q = 0; q < 8; ++q) { oT0[2 * q] = bflo(aw[q]); oT0[2 * q + 1] = bfhi(aw[q]); oT1[2 * q] = bflo(cw[q]); oT1[2 * q + 1] = bfhi(cw[q]); } }
    __syncthreads();
#pragma unroll
    for (int db = 0; db < 4; ++db)
#pragma unroll
        for (int s2 = 0; s2 < 2; ++s2) { const int dcol = (32 * db + 16 * s2 + 4 * hi) * 2;
            LAS const unsigned char* p0 = lds + G_QD + r32 * GP + dcol; LAS const unsigned char* p1 = lds + G_QD + (32 + r32) * GP + dcol;
            const bf16x8 qb0 = cat8(*(const LAS s16x4*)p0, *(const LAS s16x4*)(p0 + 16)), qb1 = cat8(*(const LAS s16x4*)p1, *(const LAS s16x4*)(p1 + 16));
            oT0 = __builtin_amdgcn_mfma_f32_32x32x16_bf16(sf[db * 2 + s2], qb0, oT0, 0, 0, 0); oT1 = __builtin_amdgcn_mfma_f32_32x32x16_bf16(sf[db * 2 + s2], qb1, oT1, 0, 0, 0); }
    float ss0 = 0.f, ss1 = 0.f;
#pragma unroll
    for (int r = 0; r < 16; ++r) { ss0 += oT0[r] * oT0[r]; ss1 += oT1[r] * oT1[r]; }
    ss0 += __shfl_xor(ss0, 32); ss1 += __shfl_xor(ss1, 32);
    if (hi == 0) { SSQ[w * 64 + r32] = ss0; SSQ[w * 64 + 32 + r32] = ss1; }
    __syncthreads();
    f32x4 gnv[4];
#pragma unroll
    for (int rg = 0; rg < 4; ++rg) gnv[rg] = *(const f32x4*)(gnorm + h * 256 + 32 * w + 8 * rg + 4 * hi);
    float t0 = 0.f, t1 = 0.f;
#pragma unroll
    for (int q = 0; q < 8; ++q) { t0 += SSQ[q * 64 + r32]; t1 += SSQ[q * 64 + 32 + r32]; }
    const float rs0 = rsqrtf(t0 * (1.f / 256.f) + 1e-6f), rs1 = rsqrtf(t1 * (1.f / 256.f) + 1e-6f);
#pragma unroll
    for (int ib = 0; ib < 2; ++ib) { int rr = 32 * ib + r32; asm volatile("" : "+v"(rr)); const size_t rowoff = (row0 + rr) * 1024 + h * 256 + 32 * w + 4 * hi; const float rs = ib ? rs1 : rs0;
#pragma unroll
        for (int rg = 0; rg < 4; ++rg) { const u32x2 rw = rwv[ib][rg];
            const float r0 = bflo(rw.x), r1 = bfhi(rw.x), r2 = bflo(rw.y), r3 = bfhi(rw.y);
            const float o0 = (ib ? oT1[4 * rg] : oT0[4 * rg]) * rs * gnv[rg][0] * r0 * pg8::fast_sigmoid(r0), o1 = (ib ? oT1[4 * rg + 1] : oT0[4 * rg + 1]) * rs * gnv[rg][1] * r1 * pg8::fast_sigmoid(r1);
            const float o2 = (ib ? oT1[4 * rg + 2] : oT0[4 * rg + 2]) * rs * gnv[rg][2] * r2 * pg8::fast_sigmoid(r2), o3 = (ib ? oT1[4 * rg + 3] : oT0[4 * rg + 3]) * rs * gnv[rg][3] * r3 * pg8::fast_sigmoid(r3);
            u32x2 ow; ow.x = pk2(o0, o1); ow.y = pk2(o2, o3); *(u32x2*)(OA + rowoff + 8 * rg) = ow; } }
}
__global__ void __launch_bounds__(NTHREADS, 2) fwd_megakernel(Args a) {
    extern __shared__ __attribute__((aligned(16))) unsigned char lds_raw[];
    LAS unsigned char* lds = (LAS unsigned char*)lds_raw;
    cg::grid_group grid = cg::this_grid();
    const int G = gridDim.x, bx = blockIdx.x;
    const int wave0 = __builtin_amdgcn_readfirstlane((int)threadIdx.x >> 6);
#define MK_TID() (wave0 * 64 + (int)__builtin_amdgcn_mbcnt_hi(~0u, __builtin_amdgcn_mbcnt_lo(~0u, 0u)))
    volatile LAS unsigned* xst = (volatile LAS unsigned*)(lds + XST_OFF);
    if (threadIdx.x < 4) xst[threadIdx.x] = 0u;
    __syncthreads();
    (void)xcd_barrier_post((unsigned*)(a.ws + WS_CTL), xst);
    unsigned char* ws = (unsigned char*)(GASP unsigned char*)a.ws; float* out = (float*)(GASP float*)a.out;
#define RELOAD_PTRS() do { size_t z_ = 0; asm volatile("" : "+s"(z_)); ws = (unsigned char*)((GASP unsigned char*)a.ws + z_); out = (float*)((GASP float*)a.out + z_); } while (0)
#define GRID_SYNC() do { XcdBarrier b_; b_.bar = (unsigned*)(ws + WS_CTL); b_.x = xb_xcc_id(); b_.st = (volatile LAS unsigned*)(lds + XST_OFF); xcd_barrier(b_, MK_TID() == 0); RELOAD_PTRS(); } while (0)
#define GRID_SYNC_CG() do { grid.sync(); GRID_SYNC(); } while (0)
#define LAUNDER_TID() int tid = MK_TID(); asm volatile("" : "+v"(tid)); const int lane = tid & 63, wave = __builtin_amdgcn_readfirstlane(tid >> 6)
#define W1T ((bf16*)(ws + WS_W1T))
#define W1OT ((bf16*)(ws + WS_W1OT))
#define WINT ((bf16*)(ws + WS_WINT))
#define WBGT ((bf16*)(ws + WS_WBGT))
#define WBAT ((bf16*)(ws + WS_WBAT))
#define WOUTT ((bf16*)(ws + WS_WOUTT))
#define W2T ((bf16*)(ws + WS_W2T))
#define W2OT ((bf16*)(ws + WS_W2OT))
#define CKB ((bf16*)(ws + WS_CKB))
#define CVB ((bf16*)(ws + WS_CVB))
#define XN ((bf16*)(ws + WS_XN))
#define SS1 ((float*)(ws + WS_SS1))
#define SS2 ((float*)(ws + WS_SS2))
#define ACT ((bf16*)(ws + WS_ACT))
#define PB ((bf16*)(ws + WS_PB))
#define GG ((bf16*)(ws + WS_GG))
#define FA ((float*)(ws + WS_FA))
#define OA ((bf16*)(ws + WS_OA))
#define OB ((bf16*)(ws + WS_OB))
#define TMP ((bf16*)(ws + WS_TMP))
#define MIX ((bf16*)((unsigned char*)(out + O_Y) + (size_t)75497472))
#define H (out + O_Y)
    constexpr size_t PBE = PBS / 2;

#ifndef REP_P0
#define REP_P0 1
#endif
    for (int rp0 = 0; rp0 < REP_P0; ++rp0) {
        LAUNDER_TID();
        const int gw = bx * NWAVES + wave, NGW = G * NWAVES;
        for (int it = bx; it < 16 * 22; it += G) transpose_tile_block(1, AIN(6), 5632, 1024, 5632, W1T, AIN(5), it, lds, tid);
        __syncthreads();
        for (int m4 = gw; m4 < T_ALL / 4; m4 += NGW) { const int m = 4 * m4;
            const float* xr = (m < T_P) ? AIN(0) + (size_t)m * 1024 : AIN(1) + (size_t)(m - T_P) * 1024;
            rms_rows4_to_bf16(xr, XN + (size_t)m * 1024, lane); }
    }
    GRID_SYNC();
#ifndef REP_P1
#define REP_P1 1
#endif
    for (int rep1 = 0; rep1 < REP_P1; ++rep1) {
      if (rep1) { GRID_SYNC(); }
 pg8::Gemm g{XN, W1T, T_ALL, 5632, 1024}; pg8::StaticOrder S; S.init(T_ALL, 5632, G, bx); pg8::EpiSwiglu E{ACT, nullptr};
      pg8::gemm_phase<pg8::EpiSwiglu, pg8::StaticOrder, true, true>(lds, g, S, E, MK_TID()); }
    {
        LAUNDER_TID();
        const int nwg = (T_ALL / 256) * 22, rounds = (nwg + G - 1) / G, first_idle = nwg - (rounds - 1) * G;
        const bool all = (first_idle >= G); const int ib = all ? bx : bx - first_idle, nib = all ? G : G - first_idle;
        if (ib >= 0) {
            constexpr int I1 = 44 * 4, I2 = 16 * 33, I3 = 16 * 4, I6 = 16 * 22, I7 = I1, NDEF = I1 + I2 + 3 * I3 + I6 + I7;
            for (int it = ib; it < NDEF; it += nib) {
                int r = it;
                if (r < I1) { transpose_tile_block(0, AIN(7), 1024, 2816, 1024, W1OT, nullptr, r, lds, tid); continue; } r -= I1;
                if (r < I2) { transpose_tile_block(2, AIN(9), NPROJ_SRC, 1024, NPROJ, WINT, AIN(8), r, lds, tid); continue; } r -= I2;
                if (r < I3) { transpose_tile_block(0, AIN(14), 1024, 1024, 1024, WBGT, nullptr, r, lds, tid); continue; } r -= I3;
                if (r < I3) { transpose_tile_block(0, AIN(15), 1024, 1024, 1024, WBAT, nullptr, r, lds, tid); continue; } r -= I3;
                if (r < I3) { transpose_tile_block(0, AIN(16), 1024, 1024, 1024, WOUTT, nullptr, r, lds, tid); continue; } r -= I3;
                if (r < I6) { transpose_tile_block(1, AIN(18), 5632, 1024, 5632, W2T, AIN(17), r, lds, tid); continue; } r -= I6;
                transpose_tile_block(0, AIN(19), 1024, 2816, 1024, W2OT, nullptr, r, lds, tid);
            }
            const size_t nvec = (size_t)8 * 512 * 1024 / 8;
            for (size_t v = (size_t)ib * NTHREADS + tid; v < nvec; v += (size_t)nib * NTHREADS) {
                const f32x4 k0 = *(const f32x4*)(AIN(2) + v * 8), k1 = *(const f32x4*)(AIN(2) + v * 8 + 4), v0 = *(const f32x4*)(AIN(3) + v * 8), v1 = *(const f32x4*)(AIN(3) + v * 8 + 4);
                *(u32x4*)(CKB + v * 8) = (u32x4){pk2(k0[0], k0[1]), pk2(k0[2], k0[3]), pk2(k1[0], k1[1]), pk2(k1[2], k1[3])};
                *(u32x4*)(CVB + v * 8) = (u32x4){pk2(v0[0], v0[1]), pk2(v0[2], v0[3]), pk2(v1[0], v1[1]), pk2(v1[2], v1[3])};
            }
        }
    }
    GRID_SYNC();
#ifndef REP_P2
#define REP_P2 1
#endif
    for (int rp2 = 0; rp2 < REP_P2; ++rp2)
    { pg8::Gemm g{ACT, W1OT, T_P, 1024, 2816}; pg8::StaticOrder S; S.init(T_P, 1024, G, bx); pg8::EpiRes E{AIN(0), AIN(1), 128, nullptr, nullptr, XN, SS1, 0.5f};
      pg8::gemm_phase<pg8::EpiRes, pg8::StaticOrder, true, true>(lds, g, S, E, MK_TID()); }
    { LAUNDER_TID(); (void)lane; (void)wave; small_gemm_res<0>(lds, ACT + (size_t)T_P * DFF, W1OT, DFF, AIN(1), nullptr, nullptr, XN + (size_t)T_P * 1024, SS1 + (size_t)T_P * 16, 0.5f, nullptr, bx, G, tid); }
    GRID_SYNC();
    for (int grp = 0; grp < 2; ++grp) {
        const int row0 = grp ? 16384 : 0, Mg = grp ? 16896 : 16384;
#ifndef REP_P3
#define REP_P3 1
#endif
        for (int rp3 = 0; rp3 < REP_P3; ++rp3)
        { pg8::Gemm g{XN + (size_t)row0 * 1024, WINT, Mg, NPROJ, 1024}; pg8::StaticOrder S; S.init(Mg, NPROJ, G, bx);
          pg8::EpiProj E{PB, PBE, GG, FA, SS1 + (size_t)row0 * 16, out + O_KP, out + O_VP, out + O_KS, out + O_VS, row0};
          pg8::gemm_phase<pg8::EpiProj, pg8::StaticOrder, true, true>(lds, g, S, E, MK_TID()); }
        GRID_SYNC();
        {
            LAUNDER_TID();
            const bf16* QB = PB + 3 * PBE; const bf16* KB = PB + 4 * PBE; const bf16* VB = PB + 5 * PBE;
            LAS unsigned char* wl = lds + wave * ATT_WLDS;
            const int nbu = 1024 + (grp ? 32 : 0);
#ifndef REP_ATT
#define REP_ATT 1
#endif
            for (int ra_ = 0; ra_ < REP_ATT; ++ra_)
            for (int bu = bx; bu < nbu; bu += G) {
                int lrow, h, t0, qh; bool sample = false; const bf16 *ck = CKB, *cv = CVB;
                if (bu < 1024) {
                    const int sb = bu & 7, j = bu >> 3, hp = (j >> 4) & 7, cp = ((j & 15) + 4 * (j >> 5)) & 15; attn_block_unit(lds, QB, OB, KB, VB, sb, hp, cp, AIN(13), tid); continue; }
                __syncthreads();
                { const int su = (bu - 1024) * 8 + wave, sbh = su >> 1, sb = sbh >> 4; h = sbh & 15; qh = su & 1; lrow = 16384 + sb * 64; t0 = 0; sample = true; ck = CKB + (size_t)sb * 512 * 1024 + h * 64; cv = CVB + (size_t)sb * 512 * 1024 + h * 64; }
                const size_t off = (size_t)lrow * 1024 + h * 64;
                if (qh) attn_unit(wl, QB + off, OB + off, KB + off, VB + off, ck, cv, sample, t0, AIN(13) + h * 257, lane, 1);
                else attn_unit(wl, QB + off, OB + off, KB + off, VB + off, ck, cv, sample, t0, AIN(13) + h * 257, lane, 0);
            }
        }
        {
            LAUNDER_TID();
            __syncthreads();
            const int nun = (grp ? 264 : 256) * 4;
            for (int u = G - 1 - bx; u < nun; u += G) gla_a_unit(lds, PB, PB + PBE, FA, (unsigned char*)H, row0, (float*)((unsigned char*)H + WS_DECB), u >> 2, u & 3, AIN(10), AIN(11), tid);
        }
        GRID_SYNC();
        {
            LAUNDER_TID();
            const int gt = bx * NTHREADS + tid, nthr = G * NTHREADS;
            for (int v = gt; v < 32 * 4096; v += nthr) { const int pair = v >> 12, e = v & 4095, sb = pair >> 2, h = pair & 3;
                gla_scan_vec((unsigned char*)H, row0, (const float*)((unsigned char*)H + WS_DECB), sb * 32, 32, h, e, nullptr, out + O_GP + (size_t)((8 * grp + sb) * 4 + h) * 32768); }
            if (grp) for (int v = gt; v < 32 * 4096; v += nthr) { const int pair = v >> 12, e = v & 4095, sb = pair >> 2, h = pair & 3;
                gla_scan_vec((unsigned char*)H, row0, (const float*)((unsigned char*)H + WS_DECB), 256 + sb, 1, h, e, AIN(4) + (size_t)(sb * 4 + h) * 32768, out + O_GS + (size_t)(sb * 4 + h) * 32768); }
        }
        GRID_SYNC();
        {
            LAUNDER_TID();
            const int nun = (grp ? 264 : 256) * 4;
#ifndef REP_C
#define REP_C 1
#endif
            for (int rc_ = 0; rc_ < REP_C; ++rc_)
            for (int u = bx; u < nun; u += G) gla_c_unit(lds, PB, PB + PBE, PB + 2 * PBE, (unsigned char*)H, row0, OA, u >> 2, u & 3, AIN(12), tid);
        }
        GRID_SYNC();
        { pg8::Gemm g{OA, WBGT, 16384, 1024, 1024}; pg8::StaticOrder S; S.init(16384, 1024, G, bx); pg8::EpiGate<0> E{GG, 0, TMP, MIX};
          pg8::gemm_phase<pg8::EpiGate<0>, pg8::StaticOrder, true, true>(lds, g, S, E, MK_TID()); }
        if (grp) { LAUNDER_TID(); (void)lane; (void)wave; small_gemm_res<1>(lds, OA + (size_t)16384 * 1024, WBGT, 1024, nullptr, nullptr, nullptr, TMP + (size_t)16384 * 1024, nullptr, 0.f, GG + (size_t)16384 * 2048, bx, G, tid); }
        { pg8::Gemm g{OB, WBAT, 16384, 1024, 1024}; pg8::StaticOrder S; S.init(16384, 1024, G, bx); pg8::EpiGate<1> E{GG, 1024, TMP, MIX};
          pg8::gemm_phase<pg8::EpiGate<1>, pg8::StaticOrder, true, true>(lds, g, S, E, MK_TID()); }
        if (grp) { LAUNDER_TID(); (void)lane; (void)wave; small_gemm_res<2>(lds, OB + (size_t)16384 * 1024, WBAT, 1024, nullptr, TMP + (size_t)16384 * 1024, nullptr, MIX + (size_t)16384 * 1024, nullptr, 0.f, GG + (size_t)16384 * 2048 + 1024, bx, G, tid); }
        GRID_SYNC();
        { pg8::Gemm g{MIX, WOUTT, 16384, 1024, 1024}; pg8::StaticOrder S; S.init(16384, 1024, G, bx);
          pg8::EpiRes E{nullptr, nullptr, 1 << 30, XN + (size_t)row0 * 1024, nullptr, XN + (size_t)row0 * 1024, SS2 + (size_t)row0 * 16, 1.0f};
          pg8::gemm_phase<pg8::EpiRes, pg8::StaticOrder, true, true>(lds, g, S, E, MK_TID()); }
        if (grp) { LAUNDER_TID(); (void)lane; (void)wave; small_gemm_res<0>(lds, MIX + (size_t)16384 * 1024, WOUTT, 1024, nullptr, XN + (size_t)T_P * 1024, nullptr, XN + (size_t)T_P * 1024, SS2 + (size_t)T_P * 16, 1.0f, nullptr, bx, G, tid); }
        if (grp == 1) GRID_SYNC();
    }
    { pg8::Gemm g{XN, W2T, T_ALL, 5632, 1024}; pg8::StaticOrder S; S.init(T_ALL, 5632, G, bx); pg8::EpiSwiglu E{ACT, SS2};
      pg8::gemm_phase<pg8::EpiSwiglu, pg8::StaticOrder, true, true>(lds, g, S, E, MK_TID()); }
    GRID_SYNC_CG();
    { pg8::Gemm g{ACT, W2OT, T_P, 1024, 2816}; pg8::StaticOrder S; S.init(T_P, 1024, G, bx); pg8::EpiRes E{nullptr, nullptr, 1 << 30, XN, nullptr, XN, nullptr, 0.5f};
      pg8::gemm_phase<pg8::EpiRes, pg8::StaticOrder, true, true>(lds, g, S, E, MK_TID()); }
    { LAUNDER_TID(); (void)lane; (void)wave; small_gemm_res<0>(lds, ACT + (size_t)T_P * DFF, W2OT, DFF, nullptr, XN + (size_t)T_P * 1024, nullptr, XN + (size_t)T_P * 1024, nullptr, 0.5f, nullptr, bx, G, tid); }
    GRID_SYNC();
    {
        LAUNDER_TID();
        const int gw = bx * NWAVES + wave, NGW = G * NWAVES; const f32x4* gf = (const f32x4*)AIN(20) + lane;
        f32x4 gv[4];
#pragma unroll
        for (int j = 0; j < 4; ++j) gv[j] = gf[64 * j];
        for (int m4 = gw; m4 < T_ALL / 4; m4 += NGW) { f32x4* xr = (f32x4*)(H + (size_t)m4 * 4096) + lane; const u32x2* hb = (const u32x2*)(XN + (size_t)m4 * 4096) + lane; f32x4 v[4][4]; float s[4];
#pragma unroll
            for (int q = 0; q < 4; ++q)
#pragma unroll
                for (int j = 0; j < 4; ++j) { const u32x2 w = hb[q * 256 + 64 * j]; v[q][j] = (f32x4){bflo(w.x), bfhi(w.x), bflo(w.y), bfhi(w.y)}; }
#pragma unroll
            for (int q = 0; q < 4; ++q) { s[q] = 0.f;
#pragma unroll
                for (int j = 0; j < 4; ++j) s[q] += (v[q][j].x * v[q][j].x + v[q][j].y * v[q][j].y) + (v[q][j].z * v[q][j].z + v[q][j].w * v[q][j].w); }
#pragma unroll
            for (int o = 1; o < 64; o <<= 1) {
#pragma unroll
                for (int q = 0; q < 4; ++q) s[q] += __shfl_xor(s[q], o); }
#pragma unroll
            for (int q = 0; q < 4; ++q) { const float rstd = rsqrtf(s[q] * (1.f / 1024.f) + 1e-6f);
#pragma unroll
                for (int j = 0; j < 4; ++j) __builtin_nontemporal_store(v[q][j] * rstd * gv[j], xr + q * 256 + 64 * j); } }
    }
}

extern "C" void kernel_launch(void* const* d_in, const int* in_sizes, int n_in, void* d_out, int out_size, void* d_ws, size_t ws_size, hipStream_t stream) {
    static int grid = 0;
    if (grid == 0) {
        if (n_in != 21 || (size_t)out_size != O_END || ws_size < WS_CTL + CTL_BYTES) { fprintf(stderr, "kernel_launch: unexpected shapes (n_in %d, out %d, ws %zu); nothing launched\n", n_in, out_size, ws_size); grid = -1; return; }
        int dev = 0, cus = 0, per_cu = 0;
        hipGetDevice(&dev); hipDeviceGetAttribute(&cus, hipDeviceAttributeMultiprocessorCount, dev);
        hipFuncSetAttribute((const void*)fwd_megakernel, hipFuncAttributeMaxDynamicSharedMemorySize, LDS_BYTES);
        hipOccupancyMaxActiveBlocksPerMultiprocessor(&per_cu, (const void*)fwd_megakernel, NTHREADS, LDS_BYTES);
        if (per_cu < 1) { fprintf(stderr, "kernel_launch: occupancy query says %d blocks per CU; nothing launched\n", per_cu); grid = -1; return; }
        grid = cus;
        if (grid < 64) { fprintf(stderr, "kernel_launch: needs at least 64 CUs\n"); grid = -1; return; }
    }
    if (grid < 0) return;
    if (hipMemsetAsync((char*)d_ws + WS_CTL, 0, CTL_BYTES, stream) != hipSuccess) { fprintf(stderr, "kernel_launch: hipMemsetAsync failed\n"); return; }
    Args a{};
    for (int i = 0; i < 21; ++i) a.in[i] = (const float*)d_in[i];
    a.out = (float*)d_out; a.ws = (unsigned char*)d_ws;
    void* args[] = {&a};
    hipError_t e = hipLaunchCooperativeKernel((const void*)fwd_megakernel, dim3(grid), dim3(NTHREADS), args, LDS_BYTES, stream);
    if (e != hipSuccess) fprintf(stderr, "cooperative launch failed: %s (grid %d)\n", hipGetErrorString(e), grid);
}
```

```cpp
#include <hip/hip_runtime.h>
#include <hip/hip_cooperative_groups.h>
#include <cstdio>
#include <cstdint>
namespace cg = cooperative_groups;
namespace pg8 {
#define PG8_LAS __attribute__((address_space(3)))
typedef unsigned short bf16_t;
typedef short bf16x8 __attribute__((ext_vector_type(8)));
typedef float f32x4 __attribute__((ext_vector_type(4)));
typedef unsigned u32x4 __attribute__((ext_vector_type(4)));
constexpr int BM = 256, BK = 64, HALF = 128, HTB = HALF * BK * 2  , STAGE_BYTES = 8 * HTB, NXCD = 8, WGM = 4;

__host__ __device__ __forceinline__ int lds_byte(int r, int c) { const int st = (r >> 4) * 2 + (c >> 5), rr = r & 15, cc = c & 31, ob = rr * 64 + cc * 2; return st * 1024 + (ob ^ (((ob >> 9) & 1) << 5)); }
__host__ __device__ __forceinline__ void stage_rc(int b, int& R, int& C) { const int st = b / 1024, sb = b % 1024, swz = sb ^ (((sb >> 9) & 1) << 5); R = (st >> 1) * 16 + swz / 64; C = (st & 1) * 32 + (swz % 64) / 2; }
__host__ __device__ __forceinline__ int perm32(int rho) { const int n = rho >> 4, i = rho & 15; return 8 * (i >> 2) + 4 * n + (i & 3); }

struct Unit { int pm, pn; };
struct Gemm { const bf16_t* A; const bf16_t* Bt; int M, N, K; };

struct StaticOrder {
    int nM, nN, nwg, G, c;
    __host__ __device__ void init(int M, int N, int G_, int c_) { nM = M / BM; nN = N / BM; nwg = nM * nN; G = G_; c = c_; }
    __host__ __device__ bool next(int i, Unit& u) const {
        const long L = (long)i * G + c; if (L >= nwg) return false;
        int wgid = (int)L; { const int q = nwg / NXCD, r = nwg % NXCD, xcd = wgid % NXCD, off = wgid / NXCD; wgid = (xcd < r ? xcd * (q + 1) : r * (q + 1) + (xcd - r) * q) + off; }
        const int nig = WGM * nN, gid = wgid / nig, fm = gid * WGM, gsz = (nM - fm) < WGM ? (nM - fm) : WGM;
        u.pm = fm + ((wgid % nig) % gsz); u.pn = (wgid % nig) / gsz; return true;
    }
    __device__ __forceinline__ void a_ready(const Unit&) const {}
    __device__ __forceinline__ void done(const Unit&) const {}
};

typedef float f32x2_cv __attribute__((ext_vector_type(2))); typedef __bf16 bf16x2_cv __attribute__((ext_vector_type(2)));
__device__ __forceinline__ unsigned cvt_pk_bf16(float lo, float hi) { f32x2_cv v = {lo, hi}; bf16x2_cv b = __builtin_convertvector(v, bf16x2_cv); return __builtin_bit_cast(unsigned, b); }
typedef unsigned u32x2 __attribute__((ext_vector_type(2)));
__device__ __forceinline__ float fast_sigmoid(float x) { return __builtin_amdgcn_rcpf(1.0f + __expf(-x)); }
__device__ __forceinline__ float bf_lo(unsigned w) { return __uint_as_float(w << 16); }
__device__ __forceinline__ float bf_hi(unsigned w) { return __uint_as_float(w & 0xffff0000u); }
__device__ __forceinline__ float rstd_from_ss(const float* ssrow, int fq) {
    const f32x4 a = ((const f32x4*)ssrow)[fq];
    float s = (a[0] + a[1]) + (a[2] + a[3]);
    s += __shfl_xor(s, 16); s += __shfl_xor(s, 32);
    return rsqrtf(s * (1.0f / 1024.0f) + 1e-6f);
}
struct EpiSwiglu {
    static constexpr bool PERM = true, AFTER_DRAIN = false;
    bf16_t* O; const float* SS;
    __device__ __forceinline__ void operator()(const f32x4 (&acc)[2][2][4][2], const Unit& u, int wr, int wc, int fr, int fq) const {
        const int row0 = u.pm * BM + wr * 64 + fr, col0 = u.pn * 128 + wc * 32 + 8 * fq;
#pragma unroll
        for (int ai = 0; ai < 2; ++ai)
#pragma unroll
            for (int m = 0; m < 4; ++m) {
                int row = row0 + ai * HALF + m * 16; asm volatile("" : "+v"(row));
                const float rs = SS ? rstd_from_ss(SS + (size_t)row * 16, fq) : 1.0f;
                float o[8];
#pragma unroll
                for (int n = 0; n < 2; ++n)
#pragma unroll
                    for (int i = 0; i < 4; ++i) { const float g = acc[ai][0][m][n][i] * rs, up = acc[ai][1][m][n][i] * rs; o[4 * n + i] = g * fast_sigmoid(g) * up; }
                u32x4 w; w.x = cvt_pk_bf16(o[0], o[1]); w.y = cvt_pk_bf16(o[2], o[3]); w.z = cvt_pk_bf16(o[4], o[5]); w.w = cvt_pk_bf16(o[6], o[7]);
                *(u32x4*)(O + (size_t)row * 2816 + col0) = w;
            }
    }
};
struct EpiRes {
    static constexpr bool PERM = true, AFTER_DRAIN = false;
    const float* base0; const float* base1; int split_pm; const bf16_t* baseb; float* H; bf16_t* XN; float* SS; float alpha;
    __device__ __forceinline__ void operator()(const f32x4 (&acc)[2][2][4][2], const Unit& u, int wr, int wc, int fr, int fq) const {
        const float* base = (u.pm < split_pm) ? base0 + (size_t)u.pm * BM * 1024 : base1 + (size_t)(u.pm - split_pm) * BM * 1024;
        const int lrow0 = wr * 64 + fr, col0 = u.pn * BM + wc * 32 + 8 * fq;
#pragma unroll
        for (int ai = 0; ai < 2; ++ai)
#pragma unroll
            for (int m = 0; m < 4; ++m) {
                int lrow = lrow0 + ai * HALF + m * 16; asm volatile("" : "+v"(lrow)); const size_t row = (size_t)u.pm * BM + lrow;
                float ss = 0.f;
#pragma unroll
                for (int bj = 0; bj < 2; ++bj) {
                    f32x4 b0, b1;
                    if (baseb) { const u32x4 bw = *(const u32x4*)(baseb + row * 1024 + col0 + bj * HALF);
                        b0 = (f32x4){bf_lo(bw.x), bf_hi(bw.x), bf_lo(bw.y), bf_hi(bw.y)}; b1 = (f32x4){bf_lo(bw.z), bf_hi(bw.z), bf_lo(bw.w), bf_hi(bw.w)}; }
                    else { const float* bp = base + (size_t)lrow * 1024 + col0 + bj * HALF; b0 = *(const f32x4*)bp; b1 = *(const f32x4*)(bp + 4); }
                    const f32x4 v0 = b0 + acc[ai][bj][m][0] * alpha, v1 = b1 + acc[ai][bj][m][1] * alpha;
                    if (H) { float* hp = H + row * 1024 + col0 + bj * HALF; *(f32x4*)hp = v0; *(f32x4*)(hp + 4) = v1; }
                    if (XN) { u32x4 w; w.x = cvt_pk_bf16(v0[0], v0[1]); w.y = cvt_pk_bf16(v0[2], v0[3]); w.z = cvt_pk_bf16(v1[0], v1[1]); w.w = cvt_pk_bf16(v1[2], v1[3]);
                        *(u32x4*)(XN + row * 1024 + col0 + bj * HALF) = w; }
                    ss += (v0[0] * v0[0] + v0[1] * v0[1]) + (v0[2] * v0[2] + v0[3] * v0[3]) + (v1[0] * v1[0] + v1[1] * v1[1]) + (v1[2] * v1[2] + v1[3] * v1[3]);
                    asm volatile("" ::: "memory");
                }
                if (SS) { ss += __shfl_xor(ss, 16); ss += __shfl_xor(ss, 32); if (fq == 0) SS[row * 16 + u.pn * 4 + wc] = ss; }
                asm volatile("" ::: "memory");
            }
    }
};
struct EpiProj {
    static constexpr bool PERM = true, AFTER_DRAIN = false;
    bf16_t* PB; size_t pbs; bf16_t* GG; float* FA; const float* SS; float* okp; float* ovp; float* oks; float* ovs; int grow0;
    __device__ __forceinline__ void operator()(const f32x4 (&acc)[2][2][4][2], const Unit& u, int wr, int wc, int fr, int fq) const {
        const int pn = u.pn; const int lrow0 = u.pm * BM + wr * 64 + fr;
        bf16_t* dst; int ldc, colt;
        if (pn < 24) { dst = PB + (size_t)(pn >> 2) * pbs; ldc = 1024; colt = (pn & 3) * 256; } else { dst = GG; ldc = 2048; colt = (pn - 24) * 256; }
        const int col0 = colt + wc * 32 + 8 * fq;
        float* kvo = nullptr; long kvrow0 = 0;
        if (pn >= 16 && pn < 24) {
            const int gt = grow0 + u.pm * BM;
            if (gt >= 32768) { kvo = (pn < 20) ? oks : ovs; kvrow0 = (long)(gt - 32768) - (long)(u.pm * BM); }
            else if ((gt & 2047) >= 1536) { kvo = (pn < 20) ? okp : ovp; kvrow0 = (long)((gt >> 11) * 512 + ((gt & 2047) - 1536)) - (long)(u.pm * BM); }
        }
#pragma unroll
        for (int ai = 0; ai < 2; ++ai)
#pragma unroll
            for (int m = 0; m < 4; ++m) {
                int row = lrow0 + ai * HALF + m * 16; asm volatile("" : "+v"(row));
                const float rs = rstd_from_ss(SS + (size_t)row * 16, fq);
                if (pn < 32) {
#pragma unroll
                    for (int bj = 0; bj < 2; ++bj) {
                        const f32x4 v0 = acc[ai][bj][m][0] * rs, v1 = acc[ai][bj][m][1] * rs;
                        u32x4 w; w.x = cvt_pk_bf16(v0[0], v0[1]); w.y = cvt_pk_bf16(v0[2], v0[3]); w.z = cvt_pk_bf16(v1[0], v1[1]); w.w = cvt_pk_bf16(v1[2], v1[3]);
                        *(u32x4*)(dst + (size_t)row * ldc + col0 + bj * HALF) = w;
                        if (kvo) { float* p = kvo + (size_t)(kvrow0 + row) * 1024 + col0 + bj * HALF; __builtin_nontemporal_store(v0, (f32x4*)p); __builtin_nontemporal_store(v1, (f32x4*)(p + 4)); }
                    }
                } else if (wc == 0 && fq < 2) {
                    const f32x4 v0 = acc[ai][0][m][0] * rs, v1 = acc[ai][0][m][1] * rs;
                    float* p = FA + (size_t)row * 16 + 8 * fq; *(f32x4*)p = v0; *(f32x4*)(p + 4) = v1;
                }
            }
    }
};
template <int MODE> struct EpiGate {
    static constexpr bool PERM = true, AFTER_DRAIN = false;
    const bf16_t* GG; int goff; bf16_t* TMP; bf16_t* MIX;
    __device__ __forceinline__ void operator()(const f32x4 (&acc)[2][2][4][2], const Unit& u, int wr, int wc, int fr, int fq) const {
        const int lrow0 = u.pm * BM + wr * 64 + fr, col0 = u.pn * BM + wc * 32 + 8 * fq;
#pragma unroll
        for (int ai = 0; ai < 2; ++ai)
#pragma unroll
            for (int m = 0; m < 4; ++m) {
                int rowi = lrow0 + ai * HALF + m * 16; asm volatile("" : "+v"(rowi)); const size_t row = (size_t)rowi;
#pragma unroll
                for (int bj = 0; bj < 2; ++bj) {
                    const u32x4 gw = *(const u32x4*)(GG + row * 2048 + goff + col0 + bj * HALF);
                    f32x4 v0, v1;
                    v0[0] = fast_sigmoid(bf_lo(gw.x)) * acc[ai][bj][m][0][0]; v0[1] = fast_sigmoid(bf_hi(gw.x)) * acc[ai][bj][m][0][1];
                    v0[2] = fast_sigmoid(bf_lo(gw.y)) * acc[ai][bj][m][0][2]; v0[3] = fast_sigmoid(bf_hi(gw.y)) * acc[ai][bj][m][0][3];
                    v1[0] = fast_sigmoid(bf_lo(gw.z)) * acc[ai][bj][m][1][0]; v1[1] = fast_sigmoid(bf_hi(gw.z)) * acc[ai][bj][m][1][1];
                    v1[2] = fast_sigmoid(bf_lo(gw.w)) * acc[ai][bj][m][1][2]; v1[3] = fast_sigmoid(bf_hi(gw.w)) * acc[ai][bj][m][1][3];
                    bf16_t* tp = TMP + row * 1024 + col0 + bj * HALF;
                    if (MODE == 1) { const u32x4 tw = *(const u32x4*)tp;
                        v0 += (f32x4){bf_lo(tw.x), bf_hi(tw.x), bf_lo(tw.y), bf_hi(tw.y)}; v1 += (f32x4){bf_lo(tw.z), bf_hi(tw.z), bf_lo(tw.w), bf_hi(tw.w)}; }
                    u32x4 w; w.x = cvt_pk_bf16(v0[0], v0[1]); w.y = cvt_pk_bf16(v0[2], v0[3]); w.z = cvt_pk_bf16(v1[0], v1[1]); w.w = cvt_pk_bf16(v1[2], v1[3]);
                    *(u32x4*)((MODE == 0 ? tp : MIX + row * 1024 + col0 + bj * HALF)) = w;
                }
            }
    }
};
template <class Epi, class Sched, bool ALIGN_EPI = false, bool SP2 = false>
__device__ __forceinline__ void gemm_phase(PG8_LAS unsigned char* lds, const Gemm g, const Sched& S, const Epi& E, const int tid_arg) {
    int tid_l = tid_arg; asm volatile("" : "+v"(tid_l));
    const int tid = tid_l, wid = __builtin_amdgcn_readfirstlane(tid >> 6), lane = tid & 63, wr = wid >> 2, wc = wid & 3, fr = lane & 15, fq = lane >> 4;
    const int K = g.K, nt = K / BK;
    unsigned voffA[2], voffB[2];
#pragma unroll
    for (int i = 0; i < 2; ++i) { int R, C; stage_rc(tid * 16 + i * 8192, R, C); const int Rb = Epi::PERM ? ((R & ~31) + perm32(R & 31)) : R;
        voffA[i] = (unsigned)(R * K + C) * 2u; voffB[i] = (unsigned)(Rb * K + C) * 2u; }
    const size_t kstep = (size_t)(BK * 2);
    const size_t hstep = (size_t)HALF * K * 2;
    const size_t tstep = 2 * hstep;
    const unsigned ldsw = (unsigned)wid * 1024u;
    const int aoff = lds_byte(wr * 64 + fr, fq * 8), boff = lds_byte(wc * 32 + fr, fq * 8);
#define PG8_SA(b, h) (((b) * 2 + (h)) * HTB)
#define PG8_SB(b, h) ((4 + (b) * 2 + (h)) * HTB)
#define PG8_STAGE(bufoff, gbase, voff) do { _Pragma("unroll") for (int _i = 0; _i < 2; ++_i) \
        __builtin_amdgcn_global_load_lds((const unsigned*)((const char*)(gbase) + (voff)[_i]), (PG8_LAS unsigned*)(lds + (bufoff) + ldsw + _i * 8192), 16, 0, 0); } while (0)
#define PG8_LDA(dst, b, h) do { _Pragma("unroll") for (int m = 0; m < 4; ++m) _Pragma("unroll") for (int k = 0; k < 2; ++k) dst[m][k] = *(const PG8_LAS bf16x8*)(lds + PG8_SA(b, h) + aoff + m * 2048 + k * 1024); } while (0)
#define PG8_LDB(dst, b, h) do { _Pragma("unroll") for (int n = 0; n < 2; ++n) _Pragma("unroll") for (int k = 0; k < 2; ++k) dst[n][k] = *(const PG8_LAS bf16x8*)(lds + PG8_SB(b, h) + boff + n * 2048 + k * 1024); } while (0)
#define PG8_MMA(ai, bj, At, Bt) do { __builtin_amdgcn_s_setprio(1); _Pragma("unroll") for (int m = 0; m < 4; ++m) _Pragma("unroll") for (int n = 0; n < 2; ++n) _Pragma("unroll") for (int k = 0; k < 2; ++k) \
        acc[ai][bj][m][n] = __builtin_amdgcn_mfma_f32_16x16x32_bf16(Bt[n][k], At[m][k], acc[ai][bj][m][n], 0, 0, 0); __builtin_amdgcn_s_setprio(0); } while (0)
#define PG8_WAIT_V(n) asm volatile("s_waitcnt vmcnt(" #n ")" ::: "memory")
#define PG8_WAIT_L(n) asm volatile("s_waitcnt lgkmcnt(" #n ")" ::: "memory")
#define PG8_BAR __builtin_amdgcn_s_barrier()
#define PG8_SCHED __builtin_amdgcn_sched_barrier(0)
    Unit cur, nxt; int ui = 0;
    if (!S.next(0, cur)) return;
    f32x4 acc[2][2][4][2];
#pragma unroll
    for (int a = 0; a < 2; ++a)
#pragma unroll
        for (int b = 0; b < 2; ++b)
#pragma unroll
            for (int m = 0; m < 4; ++m)
#pragma unroll
                for (int n = 0; n < 2; ++n) acc[a][b][m][n] = (f32x4){0.f, 0.f, 0.f, 0.f};
    bf16x8 At[4][2], B0[2][2], B1[2][2];
    const char* cA = (const char*)g.A + (size_t)cur.pm * tstep; const char* cB = (const char*)g.Bt + (size_t)cur.pn * tstep;
    S.a_ready(cur);
    if constexpr (SP2) {
        PG8_STAGE(PG8_SB(0, 0), cB, voffB); PG8_STAGE(PG8_SB(0, 1), cB + hstep, voffB); PG8_STAGE(PG8_SA(0, 0), cA, voffA); PG8_STAGE(PG8_SA(0, 1), cA + hstep, voffA);
        if (wr == 1) PG8_BAR;
        PG8_WAIT_V(2); PG8_BAR;
        PG8_STAGE(PG8_SB(1, 0), cB + kstep, voffB); PG8_STAGE(PG8_SA(1, 0), cA + kstep, voffA); PG8_STAGE(PG8_SB(1, 1), cB + hstep + kstep, voffB);
        PG8_WAIT_V(6); PG8_BAR;
    } else {
        PG8_STAGE(PG8_SB(0, 0), cB, voffB); PG8_STAGE(PG8_SA(0, 0), cA, voffA); PG8_STAGE(PG8_SB(0, 1), cB + hstep, voffB); PG8_STAGE(PG8_SA(0, 1), cA + hstep, voffA);
        if (wr == 1) PG8_BAR;
        PG8_WAIT_V(4); PG8_BAR;
        PG8_STAGE(PG8_SB(1, 0), cB + kstep, voffB); PG8_STAGE(PG8_SA(1, 0), cA + kstep, voffA); PG8_STAGE(PG8_SB(1, 1), cB + hstep + kstep, voffB);
        PG8_WAIT_V(6); PG8_BAR;
    }
    for (;;) {
        const bool has_next = S.next(ui + 1, nxt);
        const char* nA = has_next ? (const char*)g.A + (size_t)nxt.pm * tstep : cA; const char* nB = has_next ? (const char*)g.Bt + (size_t)nxt.pn * tstep : cB;
        for (int t = 0; t < nt; t += 2) {
            const bool last = (t == nt - 2);
            const char* a1 = cA + (size_t)(t + 1) * kstep;
            const char* a2 = last ? nA : cA + (size_t)(t + 2) * kstep; const char* b2 = last ? nB : cB + (size_t)(t + 2) * kstep;
            const char* a3 = a2 + kstep; const char* b3 = b2 + kstep;
            if (last && has_next) S.a_ready(nxt);
            if constexpr (SP2) {
            PG8_LDB(B0, 0, 0); PG8_LDB(B1, 0, 1); PG8_SCHED; PG8_LDA(At, 0, 0); PG8_STAGE(PG8_SA(1, 1), a1 + hstep, voffA);
            PG8_WAIT_V(8); PG8_WAIT_L(0); PG8_BAR; PG8_MMA(0, 0, At, B0); PG8_MMA(0, 1, At, B1); PG8_BAR; PG8_SCHED;
            PG8_LDA(At, 0, 1); PG8_STAGE(PG8_SB(0, 0), b2, voffB); PG8_STAGE(PG8_SB(0, 1), b2 + hstep, voffB); PG8_STAGE(PG8_SA(0, 0), a2, voffA);
            PG8_WAIT_V(8); PG8_WAIT_L(0); PG8_BAR; PG8_MMA(1, 0, At, B0); PG8_MMA(1, 1, At, B1); PG8_BAR; PG8_SCHED;
            PG8_LDB(B0, 1, 0); PG8_LDB(B1, 1, 1); PG8_SCHED; PG8_LDA(At, 1, 0); PG8_STAGE(PG8_SA(0, 1), a2 + hstep, voffA);
            PG8_WAIT_V(8); PG8_WAIT_L(0); PG8_BAR; PG8_MMA(0, 0, At, B0); PG8_MMA(0, 1, At, B1); PG8_BAR; PG8_SCHED;
            PG8_LDA(At, 1, 1); PG8_STAGE(PG8_SB(1, 0), b3, voffB); PG8_STAGE(PG8_SB(1, 1), b3 + hstep, voffB); PG8_STAGE(PG8_SA(1, 0), a3, voffA);
            PG8_WAIT_V(8); PG8_WAIT_L(0); PG8_BAR; PG8_MMA(1, 0, At, B0); PG8_MMA(1, 1, At, B1); PG8_BAR; PG8_SCHED;
            } else {
            PG8_LDB(B0, 0, 0); PG8_SCHED; PG8_LDA(At, 0, 0); PG8_STAGE(PG8_SA(1, 1), a1 + hstep, voffA);
            PG8_WAIT_L(8); PG8_BAR; PG8_WAIT_L(0); PG8_MMA(0, 0, At, B0); PG8_BAR; PG8_SCHED;
            PG8_LDB(B1, 0, 1); PG8_STAGE(PG8_SB(0, 0), b2, voffB);
            PG8_BAR; PG8_WAIT_L(0); PG8_MMA(0, 1, At, B1); PG8_BAR;
            PG8_LDA(At, 0, 1); PG8_STAGE(PG8_SA(0, 0), a2, voffA);
            PG8_BAR; PG8_WAIT_L(0); PG8_MMA(1, 0, At, B0); PG8_BAR; PG8_SCHED;
            PG8_STAGE(PG8_SB(0, 1), b2 + hstep, voffB);
            PG8_WAIT_V(6); PG8_BAR; PG8_MMA(1, 1, At, B1); PG8_BAR;
            PG8_LDB(B0, 1, 0); PG8_SCHED; PG8_LDA(At, 1, 0); PG8_STAGE(PG8_SA(0, 1), a2 + hstep, voffA);
            PG8_WAIT_L(8); PG8_BAR; PG8_WAIT_L(0); PG8_MMA(0, 0, At, B0); PG8_BAR; PG8_SCHED;
            PG8_LDB(B1, 1, 1); PG8_STAGE(PG8_SB(1, 0), b3, voffB);
            PG8_BAR; PG8_WAIT_L(0); PG8_MMA(0, 1, At, B1); PG8_BAR;
            PG8_LDA(At, 1, 1); PG8_STAGE(PG8_SA(1, 0), a3, voffA);
            PG8_BAR; PG8_WAIT_L(0); PG8_MMA(1, 0, At, B0); PG8_BAR; PG8_SCHED;
            PG8_STAGE(PG8_SB(1, 1), b3 + hstep, voffB);
            PG8_WAIT_V(6); PG8_BAR; PG8_MMA(1, 1, At, B1); PG8_BAR;
            }
        }
        if constexpr (ALIGN_EPI) { if (wr == 0) PG8_BAR; }
        if constexpr (!Epi::AFTER_DRAIN) { E(acc, cur, wr, wc, fr, fq); S.done(cur); }
        if (!has_next) break;
#pragma unroll
        for (int a = 0; a < 2; ++a)
#pragma unroll
            for (int b = 0; b < 2; ++b)
#pragma unroll
                for (int m = 0; m < 4; ++m)
#pragma unroll
                    for (int n = 0; n < 2; ++n) acc[a][b][m][n] = (f32x4){0.f, 0.f, 0.f, 0.f};
        cur = nxt; cA = nA; cB = nB; ++ui;
        if constexpr (ALIGN_EPI) { if (wr == 1) PG8_BAR; }
    }
    PG8_WAIT_V(0);
    if constexpr (!ALIGN_EPI) { if (wr == 0) PG8_BAR; }
    PG8_BAR;
    if constexpr (Epi::AFTER_DRAIN) { E.fused(acc, cur, wr, wc, fr, fq, lds, wid, lane); S.done(cur); }
#undef PG8_SA
#undef PG8_SB
#undef PG8_STAGE
#undef PG8_LDA
#undef PG8_LDB
#undef PG8_MMA
#undef PG8_WAIT_V
#undef PG8_WAIT_L
#undef PG8_BAR
#undef PG8_SCHED
}
}
#define LAS __attribute__((address_space(3)))
#define GASP __attribute__((address_space(1)))
typedef unsigned short bf16;
typedef float f32x4 __attribute__((ext_vector_type(4)));
typedef float f32x16 __attribute__((ext_vector_type(16)));
typedef short bf16x8 __attribute__((ext_vector_type(8)));
typedef short s16x4 __attribute__((ext_vector_type(4)));
typedef unsigned u32x4 __attribute__((ext_vector_type(4)));
typedef unsigned u32x2 __attribute__((ext_vector_type(2)));
constexpr int NWAVES = 8, NTHREADS = 512;
constexpr int DM = 1024, T_P = 32768, T_S = 512, T_ALL = 33280, DFF = 2816, NPROJ = 8448, NPROJ_SRC = 8208;
constexpr int MG = 16896;
constexpr size_t PBS = (size_t)MG * 1024 * 2;
constexpr size_t WS_W1T = 0;
constexpr size_t WS_W1OT = WS_W1T + (size_t)5632 * 1024 * 2;
constexpr size_t WS_WINT = WS_W1OT + (size_t)1024 * 2816 * 2;
constexpr size_t WS_WBGT = WS_WINT + (size_t)NPROJ * 1024 * 2;
constexpr size_t WS_WBAT = WS_WBGT + (size_t)1024 * 1024 * 2;
constexpr size_t WS_WOUTT = WS_WBAT + (size_t)1024 * 1024 * 2;
constexpr size_t WS_W2T = WS_WOUTT + (size_t)1024 * 1024 * 2;
constexpr size_t WS_W2OT = WS_W2T + (size_t)5632 * 1024 * 2;
constexpr size_t WS_CKB = WS_W2OT + (size_t)1024 * 2816 * 2;
constexpr size_t WS_CVB = WS_CKB + (size_t)8 * 512 * 1024 * 2;
constexpr size_t WS_XN = WS_CVB + (size_t)8 * 512 * 1024 * 2;
constexpr size_t WS_SS1 = WS_XN + (size_t)T_ALL * 1024 * 2;
constexpr size_t WS_SS2 = WS_SS1 + (size_t)T_ALL * 16 * 4;
constexpr size_t WS_R = WS_SS2 + (size_t)T_ALL * 16 * 4;
constexpr size_t WS_ACT = WS_R;
constexpr size_t WS_PB = WS_R, WS_GG = WS_PB + 6 * PBS, WS_FA = WS_GG + (size_t)MG * 2048 * 2, WS_OA = WS_FA + (size_t)MG * 16 * 4, WS_OB = WS_OA + PBS, WS_END = WS_OB + PBS;
constexpr size_t WS_TMP = WS_PB, WS_MIX = WS_PB + 2 * PBS;
static_assert(WS_END <= (size_t)536870912 && WS_ACT + (size_t)T_ALL * DFF * 2 <= WS_END, "workspace map");
constexpr size_t WS_CTL = WS_END, CTL_BYTES = 16384;
constexpr int LDS_BYTES = 147456, XST_OFF = 139264;
constexpr size_t O_Y = 0, O_KP = (size_t)T_ALL * 1024, O_VP = O_KP + (size_t)16 * 512 * 1024, O_GP = O_VP + (size_t)16 * 512 * 1024, O_KS = O_GP + (size_t)16 * 4 * 128 * 256,
                 O_VS = O_KS + (size_t)8 * 64 * 1024, O_GS = O_VS + (size_t)8 * 64 * 1024, O_END = O_GS + (size_t)8 * 4 * 128 * 256;

__device__ __forceinline__ unsigned f2bf(float f) { unsigned u = __builtin_bit_cast(unsigned, f); return (u + 0x7fffu + ((u >> 16) & 1u)) >> 16; }
__device__ __forceinline__ unsigned pk2(float lo, float hi) { return pg8::cvt_pk_bf16(lo, hi); }
__device__ __forceinline__ float bflo(unsigned w) { return __uint_as_float(w << 16); }
__device__ __forceinline__ float bfhi(unsigned w) { return __uint_as_float(w & 0xffff0000u); }
#define LDS_WAIT() asm volatile("s_waitcnt lgkmcnt(0)" ::: "memory")
__device__ __forceinline__ float wave_sum(float v) {
#pragma unroll
    for (int o = 1; o < 64; o <<= 1) v += __shfl_xor(v, o);
    return v;
}
__device__ __forceinline__ int crow(int r, int hi) { return (r & 3) + 8 * (r >> 2) + 4 * hi; }

struct Args { const float* in[21]; float* out; unsigned char* ws; };
typedef const __attribute__((address_space(4))) unsigned long long* karg_ptr_t;
__device__ __forceinline__ const float* arg_in(int i) { karg_ptr_t p = (karg_ptr_t)__builtin_amdgcn_kernarg_segment_ptr(); asm volatile("" : "+s"(p)); return (const float*)(const GASP float*)p[i]; }
#define AIN(i) arg_in(i)

__device__ __forceinline__ void transpose_item(const float* W, int N, int K, int k0, int src0, int nvalid, bf16* WT, int drow0, const float* gk, float cs, LAS float* scr, int lane) {
    const int c32 = lane & 31;
#pragma unroll
    for (int i = 0; i < 32; ++i) { const int kk = 2 * i + (lane >> 5); float v = 0.f;
        if (c32 < nvalid) v = W[(size_t)(k0 + kk) * N + src0 + c32] * (gk ? gk[k0 + kk] : 1.0f) * cs;
        scr[kk * 33 + c32] = v; }
    LDS_WAIT(); asm volatile("" ::: "memory");
    const int c = lane & 7;
#pragma unroll
    for (int j = 0; j < 4; ++j) { const int n = (lane >> 3) + 8 * j; const LAS float* s = scr + (8 * c) * 33 + n;
        u32x4 o; o.x = pk2(s[0 * 33], s[1 * 33]); o.y = pk2(s[2 * 33], s[3 * 33]); o.z = pk2(s[4 * 33], s[5 * 33]); o.w = pk2(s[6 * 33], s[7 * 33]);
        *(u32x4*)(WT + (size_t)(drow0 + n) * K + k0 + 8 * c) = o; }
    LDS_WAIT(); asm volatile("" ::: "memory");
}
__device__ __forceinline__ void transpose_matrix_item(int kind, const float* W, int N, int K, int ND, bf16* WT, const float* gk, int item, LAS float* scr, int lane) {
    const int nblk = ND / 32, kb = item / nblk, nb = item % nblk, drow0 = 32 * nb; int src0 = drow0, nvalid = 32; float cs = 1.0f;
    if (kind == 1) { const int j = drow0 >> 8, w = drow0 & 255; src0 = (w < 128) ? 128 * j + w : 2816 + 128 * j + (w - 128); }
    else if (kind == 2) {
        if (drow0 < 3072) { cs = (drow0 < 512) ? 0.08838834764831845f : 1.0f; }
        else if (drow0 < 8192) { src0 = drow0 + 16; cs = (drow0 < 4096) ? 0.125f : 1.0f; }
        else if (drow0 == 8192) { src0 = 3072; nvalid = 16; }
        else { src0 = 0; nvalid = 0; }
    }
    transpose_item(W, N, K, 64 * kb, src0, nvalid, WT, drow0, gk, cs, scr, lane);
}

__device__ __forceinline__ void transpose_tile_block(int kind, const float* W, int N, int K, int ND, bf16* WT, const float* gk, int item, LAS unsigned char* lds, int tid) {
    constexpr int LP = 260;
    const int ntile = ND / 256, kb = item / ntile, nt = item % ntile, k0 = 64 * kb, drow0 = 256 * nt;
    int srcA = drow0, srcB = drow0 + 128, nvalid = 256; float cs = 1.0f;
    if (kind == 1) { srcA = 128 * nt; srcB = 2816 + 128 * nt; }
    else if (kind == 2) {
        if (drow0 < 3072) { cs = (drow0 < 512) ? 0.08838834764831845f : 1.0f; }
        else if (drow0 < 8192) { srcA = drow0 + 16; srcB = drow0 + 144; cs = (drow0 < 4096) ? 0.125f : 1.0f; }
        else { srcA = 3072; srcB = 3072; nvalid = 16; }
    }
    LAS float* T = (LAS float*)lds;
    __syncthreads();
#pragma unroll
    for (int r = 0; r < 8; ++r) { const int id = tid + NTHREADS * r, row = id >> 6, cv = id & 63, col = cv * 4;
        f32x4 v = (f32x4){0.f, 0.f, 0.f, 0.f};
        if (col < nvalid) { const int src = (col < 128) ? srcA + col : srcB + (col - 128); v = *(const f32x4*)(W + (size_t)(k0 + row) * N + src); }
        const float g = (gk ? gk[k0 + row] : 1.0f) * cs;
        *(LAS f32x4*)(T + row * LP + col) = v * g; }
    __syncthreads();
#pragma unroll
    for (int r = 0; r < 4; ++r) { const int id = tid + NTHREADS * r, n = id >> 3, k8 = id & 7; const LAS float* s = T + (k8 * 8) * LP + n;
        u32x4 o; o.x = pk2(s[0 * LP], s[1 * LP]); o.y = pk2(s[2 * LP], s[3 * LP]); o.z = pk2(s[4 * LP], s[5 * LP]); o.w = pk2(s[6 * LP], s[7 * LP]);
        *(u32x4*)(WT + (size_t)(drow0 + n) * K + k0 + 8 * k8) = o; }
}
__device__ __forceinline__ void rms_rows4_to_bf16(const float* x0, bf16* o0, int lane) {
    f32x4 v[4][4]; float s[4];
#pragma unroll
    for (int q = 0; q < 4; ++q) { const f32x4* xr = (const f32x4*)(x0 + q * 1024) + lane;
#pragma unroll
        for (int j = 0; j < 4; ++j) v[q][j] = xr[64 * j]; }
#pragma unroll
    for (int q = 0; q < 4; ++q) { s[q] = 0.f;
#pragma unroll
        for (int j = 0; j < 4; ++j) s[q] += (v[q][j].x * v[q][j].x + v[q][j].y * v[q][j].y) + (v[q][j].z * v[q][j].z + v[q][j].w * v[q][j].w); }
#pragma unroll
    for (int o = 1; o < 64; o <<= 1) {
#pragma unroll
        for (int q = 0; q < 4; ++q) s[q] += __shfl_xor(s[q], o); }
#pragma unroll
    for (int q = 0; q < 4; ++q) { const float rstd = rsqrtf(s[q] * (1.f / 1024.f) + 1e-6f); u32x2* o8 = (u32x2*)(o0 + q * 1024) + lane;
#pragma unroll
        for (int j = 0; j < 4; ++j) { u32x2 w; w.x = pk2(v[q][j].x * rstd, v[q][j].y * rstd); w.y = pk2(v[q][j].z * rstd, v[q][j].w * rstd); o8[64 * j] = w; } }
}
#define XB_TMO      128
#define XB_XCNT(j)  (256  + 64 * (j))
#define XB_XSUB(j)  (1280 + 64 * (j))
#define XB_XGEN(j)  (2304 + 64 * (j))
#define XB_TOP      3328
#define XB_TOPGEN   3392
#define XCD_BAR_WORDS 3456
#define XB_SPIN_CAP (1u << 18)

__device__ __forceinline__ unsigned xb_ld(unsigned* p)              { return __hip_atomic_load(p, __ATOMIC_RELAXED, __HIP_MEMORY_SCOPE_AGENT); }
__device__ __forceinline__ unsigned xb_add(unsigned* p, unsigned v) { return __hip_atomic_fetch_add(p, v, __ATOMIC_RELAXED, __HIP_MEMORY_SCOPE_AGENT); }
__device__ __forceinline__ unsigned xb_xcc_id() { return (unsigned)__builtin_amdgcn_s_getreg((3 << 11) | 20) & 0xFu; }
#define XB_SPIN(cond, bar) do { unsigned _sp = 0; while (cond) { __builtin_amdgcn_s_sleep(1); \
    if ((++_sp & 255u) == 0u) { if (xb_ld(&(bar)[XB_TMO])) break; if (_sp > XB_SPIN_CAP) { atomicAdd(&(bar)[XB_TMO], 1u); break; } } } } while (0)

struct XcdBarrier {
    unsigned* bar; unsigned x;
    volatile LAS unsigned* st;
};

__device__ __forceinline__ XcdBarrier xcd_barrier_post(unsigned* bar, volatile LAS unsigned* st) {
    XcdBarrier b; b.bar = bar; b.x = xb_xcc_id(); b.st = st;
    if (threadIdx.x == 0) (void)xb_add(&bar[XB_XCNT(b.x)], 1u);
    return b;
}
__device__ __forceinline__ void xcd_barrier_complete(unsigned* bar, unsigned x, unsigned& nloc, unsigned& nx) {
    const unsigned G = gridDim.x * gridDim.y * gridDim.z;
    unsigned sum, cnt, mine, sp = 0u;
    for (;;) {
        sum = 0u; cnt = 0u; mine = 0u;
#pragma unroll
        for (unsigned j = 0; j < 16; ++j) { const unsigned c = xb_ld(&bar[XB_XCNT(j)]); sum += c; cnt += (c > 0u) ? 1u : 0u; mine = (j == x) ? c : mine; }
        if (sum == G) break;
        __builtin_amdgcn_s_sleep(1);
        if ((++sp & 255u) == 0u) { if (xb_ld(&bar[XB_TMO])) break; if (sp > XB_SPIN_CAP) { atomicAdd(&bar[XB_TMO], 1u); break; } }
    }
    nloc = mine > 0u ? mine : 1u; nx = cnt > 0u ? cnt : 1u;
}

__device__ __forceinline__ void xcd_barrier(const XcdBarrier& b, const bool leader) {
    asm volatile("s_waitcnt vmcnt(0)" ::: "memory");
    __syncthreads();
    if (leader) {
        unsigned* bar = b.bar;
        __builtin_amdgcn_s_waitcnt(0);
        unsigned nloc = b.st[0], nx = b.st[1];
        if (nloc == 0u) { xcd_barrier_complete(bar, b.x, nloc, nx); b.st[0] = nloc; b.st[1] = nx; }
        const unsigned old = xb_add(&bar[XB_XSUB(b.x)], 1u);
        const unsigned gen = old / nloc;
        if (old + 1u == (gen + 1u) * nloc) {
            __builtin_amdgcn_fence(__ATOMIC_RELEASE, "agent");
            asm volatile("s_waitcnt vmcnt(0)" ::: "memory");
            const unsigned og = xb_add(&bar[XB_TOP], 1u);
            const unsigned tg = og / nx;
            if (og + 1u == (tg + 1u) * nx) xb_add(&bar[XB_TOPGEN], 1u);
            else XB_SPIN(xb_ld(&bar[XB_TOPGEN]) == tg, bar);
            __builtin_amdgcn_fence(__ATOMIC_ACQUIRE, "agent");
            xb_add(&bar[XB_XGEN(b.x)], 1u);
            asm volatile("s_waitcnt vmcnt(0)" ::: "memory");
        } else {
            XB_SPIN(xb_ld(&bar[XB_XGEN(b.x)]) == gen, bar);
            __builtin_amdgcn_fence(__ATOMIC_ACQUIRE, "agent");
            asm volatile("s_waitcnt vmcnt(0)" ::: "memory");
        }
    }
    __syncthreads();
}
constexpr int ATT_VP = 144, ATT_WLDS = 10496;
__device__ __forceinline__ s16x4 tr16(LAS const unsigned char* p) { typedef short v4i16_t __attribute__((ext_vector_type(4)));
    return __builtin_bit_cast(s16x4, __builtin_amdgcn_ds_read_tr16_b64_v4i16((LAS v4i16_t*)p)); }
__device__ __forceinline__ bf16x8 cat8(s16x4 a, s16x4 b) { return (bf16x8){a[0], a[1], a[2], a[3], b[0], b[1], b[2], b[3]}; }
__device__ __forceinline__ bf16x8 pack8(const f32x16& v, int o) { u32x4 w; w.x = pk2(v[o], v[o + 1]); w.y = pk2(v[o + 2], v[o + 3]); w.z = pk2(v[o + 4], v[o + 5]); w.w = pk2(v[o + 6], v[o + 7]); return __builtin_bit_cast(bf16x8, w); }

__device__ __forceinline__ void attn_unit(LAS unsigned char* wl, const bf16* Qc, bf16* Oc, const bf16* KBc, const bf16* VBc, const bf16* CK, const bf16* CV, bool sample, int t0, const float* tabh, int lane, const int qh) {
    const int r32 = lane & 31, hi = lane >> 5, g16 = lane >> 4, i16 = lane & 15;
    LAS float* btab = (LAS float*)(wl + 9216);
    asm volatile("" ::: "memory");
    for (int i = lane; i < 257; i += 64) btab[i] = tabh[i];
    const float cb = tabh[256];
    bf16x8 qfr[4];
#pragma unroll
    for (int d0 = 0; d0 < 4; ++d0) qfr[d0] = *(const bf16x8*)(Qc + (size_t)(32 * qh + r32) * 1024 + 16 * d0 + 8 * hi);
    f32x16 oT[2];
#pragma unroll
    for (int a = 0; a < 2; ++a)
#pragma unroll
        for (int r = 0; r < 16; ++r) oT[a][r] = 0.f;
    float mrun = -1e30f, lrun = 0.f;
    const int traddr = ((g16 >> 1) * 4 + (i16 >> 2)) * ATT_VP + ((g16 & 1) * 16 + (i16 & 3) * 4) * 2;
    for (int t = t0; t < 9; ++t) {
        const bf16 *kp, *vp;
        if (sample && t < 8) { kp = CK + (size_t)t * 64 * 1024; vp = CV + (size_t)t * 64 * 1024; }
        else { const long off = -(long)(8 - t) * 64 * 1024; kp = KBc + off; vp = VBc + off; }
        u32x4 vreg[8];
#pragma unroll
        for (int i = 0; i < 8; ++i) vreg[i] = *(const u32x4*)(vp + (size_t)(8 * i + (lane >> 3)) * 1024 + (lane & 7) * 8);
        bf16x8 kf[2][4];
#pragma unroll
        for (int kvh = 0; kvh < 2; ++kvh)
#pragma unroll
            for (int d0 = 0; d0 < 4; ++d0) kf[kvh][d0] = *(const bf16x8*)(kp + (size_t)(32 * kvh + r32) * 1024 + 16 * d0 + 8 * hi);
        LDS_WAIT();
#pragma unroll
        for (int i = 0; i < 8; ++i) *(LAS u32x4*)(wl + (8 * i + (lane >> 3)) * ATT_VP + (lane & 7) * 16) = vreg[i];
        {
            f32x16 s0, s1;
#pragma unroll
            for (int r = 0; r < 16; ++r) { s0[r] = 0.f; s1[r] = 0.f; }
#pragma unroll
            for (int d0 = 0; d0 < 4; ++d0) { s0 = __builtin_amdgcn_mfma_f32_32x32x16_bf16(kf[0][d0], qfr[d0], s0, 0, 0, 0); s1 = __builtin_amdgcn_mfma_f32_32x32x16_bf16(kf[1][d0], qfr[d0], s1, 0, 0, 0); }
            if (t < 6) {
#pragma unroll
                for (int r = 0; r < 16; ++r) { s0[r] += cb; s1[r] += cb; }
            } else {
                const int relb = 64 * (8 - t) + 32 * qh + r32 + 128;
#pragma unroll
                for (int r = 0; r < 16; ++r) { const int i0 = relb - crow(r, hi); s0[r] += btab[i0 > 256 ? 256 : i0]; const int i1 = i0 - 32; s1[r] += btab[i1 > 256 ? 256 : i1]; }
            }
            float tm = fmaxf(s0[0], s1[0]);
#pragma unroll
            for (int r = 1; r < 16; ++r) tm = fmaxf(tm, fmaxf(s0[r], s1[r]));
            tm = fmaxf(tm, __shfl_xor(tm, 32));
            const float mn = fmaxf(mrun, tm), sc = __expf(mrun - mn); mrun = mn;
            float ps = 0.f;
#pragma unroll
            for (int r = 0; r < 16; ++r) { s0[r] = __expf(s0[r] - mn); s1[r] = __expf(s1[r] - mn); ps += s0[r] + s1[r]; }
            lrun = lrun * sc + ps;
#pragma unroll
            for (int r = 0; r < 16; ++r) { oT[0][r] *= sc; oT[1][r] *= sc; }
            bf16x8 pf[4]; pf[0] = pack8(s0, 0); pf[1] = pack8(s0, 8); pf[2] = pack8(s1, 0); pf[3] = pack8(s1, 8);
            LDS_WAIT();
#pragma unroll
            for (int dh = 0; dh < 2; ++dh)
#pragma unroll
                for (int kc = 0; kc < 4; ++kc) {
                    LAS const unsigned char* p = wl + traddr + (16 * kc) * ATT_VP + dh * 64;
                    const bf16x8 vf = cat8(tr16(p), tr16(p + 8 * ATT_VP));
                    oT[dh] = __builtin_amdgcn_mfma_f32_32x32x16_bf16(vf, pf[kc], oT[dh], 0, 0, 0);
                }
        }
        asm volatile("" ::: "memory");
    }
    {
        const float lt = lrun + __shfl_xor(lrun, 32), inv = 1.0f / lt;
        bf16* orow = Oc + (size_t)(32 * qh + r32) * 1024;
#pragma unroll
        for (int dh = 0; dh < 2; ++dh)
#pragma unroll
            for (int rg = 0; rg < 4; ++rg) { u32x2 w; w.x = pk2(oT[dh][4 * rg] * inv, oT[dh][4 * rg + 1] * inv); w.y = pk2(oT[dh][4 * rg + 2] * inv, oT[dh][4 * rg + 3] * inv);
                *(u32x2*)(orow + 32 * dh + 8 * rg + 4 * hi) = w; }
    }
    LDS_WAIT(); asm volatile("" ::: "memory");
}
constexpr int AB_HB = 18432, AB_BUF = 2 * AB_HB, AB_TAB = 2 * AB_BUF;
__device__ __forceinline__ void attn_block_unit(LAS unsigned char* lds, const bf16* QB, bf16* OB, const bf16* KB, const bf16* VB, int sb, int hp, int cp, const float* tab, int tid) {
    const int lane = tid & 63, w = __builtin_amdgcn_readfirstlane(tid >> 6), r32 = lane & 31, hi = lane >> 5, g16 = lane >> 4, i16 = lane & 15;
    const int hsel = w >> 2, csel = (w >> 1) & 1, qh = w & 1, h = 2 * hp + hsel, c = 2 * cp + csel;
    LAS float* btab = (LAS float*)(lds + AB_TAB + hsel * 1040);
    __syncthreads();
    for (int i = tid; i < 2 * 257; i += NTHREADS) { const int hh = i >= 257, k = i - 257 * hh; ((LAS float*)(lds + AB_TAB + hh * 1040))[k] = tab[(2 * hp + hh) * 257 + k]; }
    const float cb = tab[h * 257 + 256];
    const size_t hoff = (size_t)h * 64;
    const bf16* Qc = QB + ((size_t)sb * 2048 + (size_t)c * 64) * 1024 + hoff;
    bf16x8 qfr[4];
#pragma unroll
    for (int d0 = 0; d0 < 4; ++d0) qfr[d0] = *(const bf16x8*)(Qc + (size_t)(32 * qh + r32) * 1024 + 16 * d0 + 8 * hi);
    f32x16 oT[2];
#pragma unroll
    for (int a = 0; a < 2; ++a)
#pragma unroll
        for (int r = 0; r < 16; ++r) oT[a][r] = 0.f;
    float mrun = -1e30f, lrun = 0.f;
    const int traddr = ((g16 >> 1) * 4 + (i16 >> 2)) * ATT_VP + ((g16 & 1) * 16 + (i16 & 3) * 4) * 2;
    const int lrow = tid >> 3, lch = tid & 7;
    const int tc0 = 2 * cp - 8, j0 = tc0 < 0 ? -tc0 : 0;
    const size_t pbase = ((size_t)sb * 2048 + lrow) * 1024 + (size_t)(2 * hp) * 64 + lch * 8;
    const bf16* kbase = KB + pbase; const bf16* vbase = VB + pbase;
    u32x4 kreg0, vreg0, kreg1, vreg1;
#define AB_LOAD(jj) do { const long o_ = (long)(tc0 + (jj)) * 64 * 1024; kreg0 = *(const u32x4*)(kbase + o_); vreg0 = *(const u32x4*)(vbase + o_); kreg1 = *(const u32x4*)(kbase + o_ + 64); vreg1 = *(const u32x4*)(vbase + o_ + 64); } while (0)
#define AB_STORE(jj) do { LAS unsigned char* b_ = lds + ((jj) & 1) * AB_BUF + lrow * ATT_VP + lch * 16; *(LAS u32x4*)b_ = kreg0; *(LAS u32x4*)(b_ + 9216) = vreg0; *(LAS u32x4*)(b_ + AB_HB) = kreg1; *(LAS u32x4*)(b_ + AB_HB + 9216) = vreg1; } while (0)
    AB_LOAD(j0); AB_STORE(j0);
    for (int j = j0; j < 10; ++j) {
        __syncthreads();
        if (j + 1 < 10) AB_LOAD(j + 1);
        const int t = j - csel;
        if (t >= 0 && t < 9) {
            LAS const unsigned char* kb = lds + (j & 1) * AB_BUF + hsel * AB_HB; LAS const unsigned char* vb = kb + 9216;
            f32x16 s0, s1;
#pragma unroll
            for (int r = 0; r < 16; ++r) { s0[r] = 0.f; s1[r] = 0.f; }
#pragma unroll
            for (int d0 = 0; d0 < 4; ++d0) {
                const bf16x8 k0 = *(const LAS bf16x8*)(kb + r32 * ATT_VP + (16 * d0 + 8 * hi) * 2), k1 = *(const LAS bf16x8*)(kb + (32 + r32) * ATT_VP + (16 * d0 + 8 * hi) * 2);
                s0 = __builtin_amdgcn_mfma_f32_32x32x16_bf16(k0, qfr[d0], s0, 0, 0, 0); s1 = __builtin_amdgcn_mfma_f32_32x32x16_bf16(k1, qfr[d0], s1, 0, 0, 0); }
            if (t < 6) {
#pragma unroll
                for (int r = 0; r < 16; ++r) { s0[r] += cb; s1[r] += cb; }
            } else {
                const int relb = 64 * (8 - t) + 32 * qh + r32 + 128;
#pragma unroll
                for (int r = 0; r < 16; ++r) { const int i0 = relb - crow(r, hi); s0[r] += btab[i0 > 256 ? 256 : i0]; const int i1 = i0 - 32; s1[r] += btab[i1 > 256 ? 256 : i1]; }
            }
            float tm = fmaxf(s0[0], s1[0]);
#pragma unroll
            for (int r = 1; r < 16; ++r) tm = fmaxf(tm, fmaxf(s0[r], s1[r]));
            tm = fmaxf(tm, __shfl_xor(tm, 32));
            const float mn = fmaxf(mrun, tm), sc = __expf(mrun - mn); mrun = mn;
            float ps = 0.f;
#pragma unroll
            for (int r = 0; r < 16; ++r) { s0[r] = __expf(s0[r] - mn); s1[r] = __expf(s1[r] - mn); ps += s0[r] + s1[r]; }
            lrun = lrun * sc + ps;
#pragma unroll
            for (int r = 0; r < 16; ++r) { oT[0][r] *= sc; oT[1][r] *= sc; }
            bf16x8 pf[4]; pf[0] = pack8(s0, 0); pf[1] = pack8(s0, 8); pf[2] = pack8(s1, 0); pf[3] = pack8(s1, 8);
#pragma unroll
            for (int dh = 0; dh < 2; ++dh)
#pragma unroll
                for (int kc = 0; kc < 4; ++kc) {
                    LAS const unsigned char* p = vb + traddr + (16 * kc) * ATT_VP + dh * 64;
                    const bf16x8 vf = cat8(tr16(p), tr16(p + 8 * ATT_VP));
                    oT[dh] = __builtin_amdgcn_mfma_f32_32x32x16_bf16(vf, pf[kc], oT[dh], 0, 0, 0);
                }
        }
        if (j + 1 < 10) AB_STORE(j + 1);
    }
#undef AB_LOAD
#undef AB_STORE
    {
        const float lt = lrun + __shfl_xor(lrun, 32), inv = 1.0f / lt;
        bf16* orow = OB + ((size_t)sb * 2048 + (size_t)c * 64 + 32 * qh + r32) * 1024 + hoff;
#pragma unroll
        for (int dh = 0; dh < 2; ++dh)
#pragma unroll
            for (int rg = 0; rg < 4; ++rg) { u32x2 wv; wv.x = pk2(oT[dh][4 * rg] * inv, oT[dh][4 * rg + 1] * inv); wv.y = pk2(oT[dh][4 * rg + 2] * inv, oT[dh][4 * rg + 3] * inv);
                *(u32x2*)(orow + 32 * dh + 8 * rg + 4 * hi) = wv; }
    }
}
template <int MODE> __device__ __forceinline__ void small_gemm_res(LAS unsigned char* lds, const bf16* A, const bf16* Bt, int K, const float* base, const bf16* baseb, float* H, bf16* XN, float* SS, float alpha, const bf16* GGs, int bx, int G, int tid) {
    const int lane = tid & 63, w = __builtin_amdgcn_readfirstlane(tid >> 6), r32 = lane & 31, hi = lane >> 5;
    const int kw = K >> 3;
    LAS float* P = (LAS float*)lds;
    for (int tile = bx; tile < 256; tile += G) {
        const int t0 = (tile >> 4) * 32, n0 = (tile & 15) * 64;
        f32x16 acc0, acc1;
#pragma unroll
        for (int r = 0; r < 16; ++r) { acc0[r] = 0.f; acc1[r] = 0.f; }
        const bf16* ap = A + (size_t)(t0 + r32) * K + w * kw + 8 * hi;
        const bf16* b0p = Bt + (size_t)(n0 + r32) * K + w * kw + 8 * hi; const bf16* b1p = b0p + (size_t)32 * K;
#pragma unroll 4
        for (int k = 0; k < kw; k += 16) {
            const bf16x8 x = *(const bf16x8*)(ap + k), w0 = *(const bf16x8*)(b0p + k), w1 = *(const bf16x8*)(b1p + k);
            acc0 = __builtin_amdgcn_mfma_f32_32x32x16_bf16(w0, x, acc0, 0, 0, 0); acc1 = __builtin_amdgcn_mfma_f32_32x32x16_bf16(w1, x, acc1, 0, 0, 0);
        }
        LAS float* Pw = P + w * 2112;
#pragma unroll
        for (int r = 0; r < 16; ++r) { Pw[crow(r, hi) * 33 + r32] = acc0[r]; Pw[(32 + crow(r, hi)) * 33 + r32] = acc1[r]; }
        __syncthreads();
        const int tok = tid >> 4, nq = tid & 15;
        float v[4] = {0.f, 0.f, 0.f, 0.f};
#pragma unroll
        for (int ww = 0; ww < 8; ++ww)
#pragma unroll
            for (int e = 0; e < 4; ++e) v[e] += P[ww * 2112 + (4 * nq + e) * 33 + tok];
        const size_t off = (size_t)(t0 + tok) * 1024 + n0 + 4 * nq;
        if (MODE == 0) {
            f32x4 b; if (baseb) { const u32x2 bw = *(const u32x2*)(baseb + off); b = (f32x4){bflo(bw.x), bfhi(bw.x), bflo(bw.y), bfhi(bw.y)}; } else b = *(const f32x4*)(base + off);
            const f32x4 hv = (f32x4){b[0] + alpha * v[0], b[1] + alpha * v[1], b[2] + alpha * v[2], b[3] + alpha * v[3]};
            if (H) *(f32x4*)(H + off) = hv;
            if (XN) { u32x2 xw; xw.x = pk2(hv[0], hv[1]); xw.y = pk2(hv[2], hv[3]); *(u32x2*)(XN + off) = xw; }
            if (SS) { float ss = (hv[0] * hv[0] + hv[1] * hv[1]) + (hv[2] * hv[2] + hv[3] * hv[3]);
                ss += __shfl_xor(ss, 1); ss += __shfl_xor(ss, 2); ss += __shfl_xor(ss, 4); ss += __shfl_xor(ss, 8);
                if (nq == 0) SS[(size_t)(t0 + tok) * 16 + (n0 >> 6)] = ss; }
        } else {
            const u32x2 gw = *(const u32x2*)(GGs + (size_t)(t0 + tok) * 2048 + n0 + 4 * nq);
            f32x4 o = (f32x4){pg8::fast_sigmoid(bflo(gw.x)) * v[0], pg8::fast_sigmoid(bfhi(gw.x)) * v[1], pg8::fast_sigmoid(bflo(gw.y)) * v[2], pg8::fast_sigmoid(bfhi(gw.y)) * v[3]};
            if (MODE == 1) { u32x2 xw; xw.x = pk2(o[0], o[1]); xw.y = pk2(o[2], o[3]); *(u32x2*)(XN + off) = xw; }
            else { const u32x2 tw = *(const u32x2*)(baseb + off); o += (f32x4){bflo(tw.x), bfhi(tw.x), bflo(tw.y), bfhi(tw.y)};
                u32x2 xw; xw.x = pk2(o[0], o[1]); xw.y = pk2(o[2], o[3]); *(u32x2*)(XN + off) = xw; }
        }
        __syncthreads();
    }
}
constexpr int G_QD = 0, G_KI = 17408, G_VV = 34816, G_B = 71680, G_FA = 105472, G_SEG = 109568, G_SSQ = 111616;
constexpr int G_KT = 113664, GKTP = 320;
constexpr int GP = 272, GVP = 576, GBP = 132;
constexpr size_t WS_DECB = (size_t)1056 * 65536;
__device__ __forceinline__ bf16* ub_slot(unsigned char* ybase, int unit, int) { return (bf16*)ybase + (size_t)unit * 32768; }
__device__ __forceinline__ void gla_a_unit(LAS unsigned char* lds, bf16* QKA, bf16* VA, const float* FA, unsigned char* ws, int xnrow0, float* DECB, int lchunk, int h,
                                           const float* wgate, const float* bgate, int tid) {
    const int lane = tid & 63, w = __builtin_amdgcn_readfirstlane(tid >> 6), r32 = lane & 31, hi = lane >> 5, g16 = lane >> 4, i16 = lane & 15;
    const int gd = tid & 127, tq = tid >> 7;
    LAS float* Bimg = (LAS float*)(lds + G_B); LAS float* FAi = (LAS float*)(lds + G_FA); LAS float* SEG = (LAS float*)(lds + G_SEG);
    const int trrow = (g16 >> 1) * 4 + (i16 >> 2), trcol = (g16 & 1) * 16 + (i16 & 3) * 4;
    const size_t row0 = (size_t)lchunk * 64; const int unit = lchunk * 4 + h;
    u32x4 qv[2], kv[2];
#pragma unroll
    for (int i = 0; i < 2; ++i) { const int id = tid + 512 * i, row = id >> 4, ch = id & 15; const bf16* p = QKA + (row0 + row) * 1024 + h * 128 + ch * 8; qv[i] = *(const u32x4*)p; kv[i] = *(const u32x4*)(p + 512); }
    if (tid < 256) *(LAS f32x4*)(FAi + tid * 4) = *(const f32x4*)(FA + row0 * 16 + tid * 4);
#pragma unroll
    for (int i = 0; i < 4; ++i) { const int id = tid + 512 * i, row = id >> 5, ch = id & 31; *(LAS u32x4*)(lds + G_VV + row * GVP + ch * 16) = *(const u32x4*)(VA + (row0 + row) * 1024 + h * 256 + ch * 8); }
    __syncthreads();
    {
        float wg[16];
#pragma unroll
        for (int r = 0; r < 16; ++r) wg[r] = wgate[r * 512 + h * 128 + gd];
        const float bg = bgate[h * 128 + gd];
        float run = 0.f;
#pragma unroll
        for (int tt = 0; tt < 16; ++tt) { const int t = tq * 16 + tt; const LAS f32x4* fp = (const LAS f32x4*)(FAi + t * 16); float x = bg;
#pragma unroll
            for (int q = 0; q < 4; ++q) { const f32x4 f = fp[q]; x += f[0] * wg[4 * q] + f[1] * wg[4 * q + 1] + f[2] * wg[4 * q + 2] + f[3] * wg[4 * q + 3]; }
            const float ls = fminf(x, 0.f) - __logf(1.0f + __expf(-fabsf(x))); run += ls * 0.0625f; Bimg[t * GBP + gd] = run;
            if ((tt & 3) == 3) asm volatile("" ::: "memory"); }
        SEG[tq * 128 + gd] = run;
    }
    __syncthreads();
#pragma unroll
    for (int i = 0; i < 2; ++i) { const int id = tid + 512 * i, row = id >> 4, ch = id & 15;
        f32x4 b0 = *(const LAS f32x4*)(Bimg + row * GBP + ch * 8), b1 = *(const LAS f32x4*)(Bimg + row * GBP + ch * 8 + 4);
        f32x4 l0 = (f32x4){0.f, 0.f, 0.f, 0.f}, l1 = l0;
#pragma unroll
        for (int q = 0; q < 4; ++q) { const f32x4 s0v = *(const LAS f32x4*)(SEG + q * 128 + ch * 8), s1v = *(const LAS f32x4*)(SEG + q * 128 + ch * 8 + 4);
            l0 += s0v; l1 += s1v; if (q < (row >> 4)) { b0 += s0v; b1 += s1v; } }
        if (row == 0) { float* dp = DECB + (size_t)unit * 128 + ch * 8;
            *(f32x4*)dp = (f32x4){__expf(l0[0]), __expf(l0[1]), __expf(l0[2]), __expf(l0[3])}; *(f32x4*)(dp + 4) = (f32x4){__expf(l1[0]), __expf(l1[1]), __expf(l1[2]), __expf(l1[3])}; }
        const float bb[8] = {b0[0], b0[1], b0[2], b0[3], b1[0], b1[1], b1[2], b1[3]};
        const unsigned qw[4] = {qv[i].x, qv[i].y, qv[i].z, qv[i].w}, kw[4] = {kv[i].x, kv[i].y, kv[i].z, kv[i].w};
        unsigned oq[4], oi[4];
#pragma unroll
        for (int e = 0; e < 4; ++e) { const float q0 = bflo(qw[e]), q1 = bfhi(qw[e]), k0 = bflo(kw[e]), k1 = bfhi(kw[e]);
            const float e0 = __expf(bb[2 * e]), e1 = __expf(bb[2 * e + 1]), n0 = __expf(-bb[2 * e]), n1 = __expf(-bb[2 * e + 1]);
            oq[e] = pk2(q0 * e0, q1 * e1); oi[e] = pk2(k0 * n0, k1 * n1); }
        const u32x4 qd = (u32x4){oq[0], oq[1], oq[2], oq[3]};
        *(LAS u32x4*)(lds + G_QD + row * GP + ch * 16) = qd;
        *(LAS u32x4*)(lds + G_KI + row * GP + ch * 16) = (u32x4){oi[0], oi[1], oi[2], oi[3]};
        *(LAS u32x4*)(lds + G_KT + row * GKTP + ch * 16) = (u32x4){oi[0], oi[1], oi[2], oi[3]};
        *(u32x4*)(QKA + (row0 + row) * 1024 + h * 128 + ch * 8) = qd; }
    __syncthreads();
    bf16x8 vvf[4];
#pragma unroll
    for (int kc = 0; kc < 4; ++kc) { LAS const unsigned char* p = lds + G_VV + (16 * kc + trrow) * GVP + (32 * w + trcol) * 2; vvf[kc] = cat8(tr16(p), tr16(p + 8 * GVP)); }
    f32x16 s00, s01, s11;
#pragma unroll
    for (int r = 0; r < 16; ++r) { s00[r] = 0.f; s01[r] = 0.f; s11[r] = 0.f; }
#pragma unroll
    for (int s = 0; s < 8; ++s) {
        const bf16x8 a0 = *(const LAS bf16x8*)(lds + G_KI + r32 * GP + (16 * s + 8 * hi) * 2), a1 = *(const LAS bf16x8*)(lds + G_KI + (32 + r32) * GP + (16 * s + 8 * hi) * 2);
        const bf16x8 b0 = *(const LAS bf16x8*)(lds + G_QD + r32 * GP + (16 * s + 8 * hi) * 2), b1 = *(const LAS bf16x8*)(lds + G_QD + (32 + r32) * GP + (16 * s + 8 * hi) * 2);
        s00 = __builtin_amdgcn_mfma_f32_32x32x16_bf16(a0, b0, s00, 0, 0, 0); s01 = __builtin_amdgcn_mfma_f32_32x32x16_bf16(a0, b1, s01, 0, 0, 0); s11 = __builtin_amdgcn_mfma_f32_32x32x16_bf16(a1, b1, s11, 0, 0, 0);
    }
#pragma unroll
    for (int r = 0; r < 16; ++r) if (crow(r, hi) > r32) { s00[r] = 0.f; s11[r] = 0.f; }
    const bf16x8 p00a = pack8(s00, 0), p00b = pack8(s00, 8), p01a = pack8(s01, 0), p01b = pack8(s01, 8), p11a = pack8(s11, 0), p11b = pack8(s11, 8);
    f32x16 oT0, oT1;
#pragma unroll
    for (int r = 0; r < 16; ++r) { oT0[r] = 0.f; oT1[r] = 0.f; }
    oT0 = __builtin_amdgcn_mfma_f32_32x32x16_bf16(vvf[0], p00a, oT0, 0, 0, 0); oT0 = __builtin_amdgcn_mfma_f32_32x32x16_bf16(vvf[1], p00b, oT0, 0, 0, 0);
    oT1 = __builtin_amdgcn_mfma_f32_32x32x16_bf16(vvf[0], p01a, oT1, 0, 0, 0); oT1 = __builtin_amdgcn_mfma_f32_32x32x16_bf16(vvf[1], p01b, oT1, 0, 0, 0);
    oT1 = __builtin_amdgcn_mfma_f32_32x32x16_bf16(vvf[2], p11a, oT1, 0, 0, 0); oT1 = __builtin_amdgcn_mfma_f32_32x32x16_bf16(vvf[3], p11b, oT1, 0, 0, 0);
    { bf16* p0 = VA + (row0 + (2 * w) * 4 + g16) * 1024 + h * 256 + i16 * 16; bf16* p1 = p0 + 4 * 1024;
      *(u32x4*)p0 = __builtin_bit_cast(u32x4, pack8(oT0, 0)); *(u32x4*)(p0 + 8) = __builtin_bit_cast(u32x4, pack8(oT0, 8));
      *(u32x4*)p1 = __builtin_bit_cast(u32x4, pack8(oT1, 0)); *(u32x4*)(p1 + 8) = __builtin_bit_cast(u32x4, pack8(oT1, 8)); }
    bf16* up = ub_slot(ws, unit, xnrow0) + (size_t)w * 4096 + lane * 8;
#pragma unroll
    for (int db = 0; db < 4; ++db) { f32x16 uacc;
#pragma unroll
        for (int r = 0; r < 16; ++r) uacc[r] = 0.f;
#pragma unroll
        for (int kc = 0; kc < 4; ++kc) { LAS const unsigned char* p = lds + G_KT + (16 * kc + trrow) * GKTP + (32 * db + trcol) * 2;
            uacc = __builtin_amdgcn_mfma_f32_32x32x16_bf16(cat8(tr16(p), tr16(p + 8 * GKTP)), vvf[kc], uacc, 0, 0, 0); }
        *(u32x4*)(up + (db * 2) * 512) = __builtin_bit_cast(u32x4, pack8(uacc, 0)); *(u32x4*)(up + (db * 2 + 1) * 512) = __builtin_bit_cast(u32x4, pack8(uacc, 8)); }
    __syncthreads();
}

__device__ __forceinline__ void gla_scan_vec(unsigned char* ws, int xnrow0, const float* DECB, int lchunk0, int nchunks, int h, int e, const float* s0, float* sout) {
    const int lane = e & 63, s2 = (e >> 6) & 1, db = (e >> 7) & 3, w = e >> 9, hi = lane >> 5, r32 = lane & 31;
    const int dbase = 32 * db + 16 * s2 + 4 * hi, v = 32 * w + r32;
    float S[8];
#pragma unroll
    for (int jj = 0; jj < 8; ++jj) S[jj] = s0 ? s0[(size_t)(dbase + 8 * (jj >> 2) + (jj & 3)) * 256 + v] : 0.f;
    for (int n0 = 0; n0 < nchunks; n0 += 4) {
        u32x4 uw[4]; f32x4 d0[4], d1[4]; bf16* up[4];
#pragma unroll
        for (int q = 0; q < 4; ++q) { const int n = (n0 + q < nchunks) ? n0 + q : nchunks - 1; const int unit = (lchunk0 + n) * 4 + h;
            up[q] = ub_slot(ws, unit, xnrow0) + (size_t)e * 8; uw[q] = *(const u32x4*)up[q];
            d0[q] = *(const f32x4*)(DECB + (size_t)unit * 128 + dbase); d1[q] = *(const f32x4*)(DECB + (size_t)unit * 128 + dbase + 8); }
#pragma unroll
        for (int q = 0; q < 4; ++q) if (n0 + q < nchunks) {
            *(u32x4*)up[q] = (u32x4){pk2(S[0], S[1]), pk2(S[2], S[3]), pk2(S[4], S[5]), pk2(S[6], S[7])};
            S[0] = d0[q][0] * (S[0] + bflo(uw[q].x)); S[1] = d0[q][1] * (S[1] + bfhi(uw[q].x)); S[2] = d0[q][2] * (S[2] + bflo(uw[q].y)); S[3] = d0[q][3] * (S[3] + bfhi(uw[q].y));
            S[4] = d1[q][0] * (S[4] + bflo(uw[q].z)); S[5] = d1[q][1] * (S[5] + bfhi(uw[q].z)); S[6] = d1[q][2] * (S[6] + bflo(uw[q].w)); S[7] = d1[q][3] * (S[7] + bfhi(uw[q].w)); }
    }
#pragma unroll
    for (int jj = 0; jj < 8; ++jj) __builtin_nontemporal_store(S[jj], sout + (size_t)(dbase + 8 * (jj >> 2) + (jj & 3)) * 256 + v);
}

__device__ __forceinline__ void gla_c_unit(LAS unsigned char* lds, const bf16* QKA, const bf16* VA, const bf16* RA, unsigned char* ws, int xnrow0, bf16* OA, int lchunk, int h, const float* gnorm, int tid) {
    const int lane = tid & 63, w = __builtin_amdgcn_readfirstlane(tid >> 6), r32 = lane & 31, hi = lane >> 5, g16 = lane >> 4, i16 = lane & 15;
    LAS float* SSQ = (LAS float*)(lds + G_SSQ);
    const size_t row0 = (size_t)lchunk * 64; const int unit = lchunk * 4 + h;
#pragma unroll
    for (int i = 0; i < 2; ++i) { const int id = tid + 512 * i, row = id >> 4, ch = id & 15; *(LAS u32x4*)(lds + G_QD + row * GP + ch * 16) = *(const u32x4*)(QKA + (row0 + row) * 1024 + h * 128 + ch * 8); }
    bf16x8 sf[8];
    { const bf16* up = ub_slot(ws, unit, xnrow0) + (size_t)w * 4096 + lane * 8;
#pragma unroll
      for (int f = 0; f < 8; ++f) sf[f] = *(const bf16x8*)(up + f * 512); }
    u32x2 rwv[2][4];
#pragma unroll
    for (int ib = 0; ib < 2; ++ib)
#pragma unroll
        for (int rg = 0; rg < 4; ++rg) rwv[ib][rg] = *(const u32x2*)(RA + (row0 + 32 * ib + r32) * 1024 + h * 256 + 32 * w + 4 * hi + 8 * rg);
    f32x16 oT0, oT1;
    { const bf16* p0 = VA + (row0 + (2 * w) * 4 + g16) * 1024 + h * 256 + i16 * 16; const bf16* p1 = p0 + 4 * 1024;
      const u32x4 a0 = *(const u32x4*)p0, a1 = *(const u32x4*)(p0 + 8), c0 = *(const u32x4*)p1, c1 = *(const u32x4*)(p1 + 8);
      const unsigned aw[8] = {a0.x, a0.y, a0.z, a0.w, a1.x, a1.y, a1.z, a1.w}, cw[8] = {c0.x, c0.y, c0.z, c0.w, c1.x, c1.y, c1.z, c1.w};
#pragma unroll
      for (int q = 0; q < 8; ++q) { oT0[2 * q] = bflo(aw[q]); oT0[2 * q + 1] = bfhi(aw[q]); oT1[2 * q] = bflo(cw[q]); oT1[2 * q + 1] = bfhi(cw[q]); } }
    __syncthreads();
#pragma unroll
    for (int db = 0; db < 4; ++db)
#pragma unroll
        for (int s2 = 0; s2 < 2; ++s2) { const int dcol = (32 * db + 16 * s2 + 4 * hi) * 2;
            LAS const unsigned char* p0 = lds + G_QD + r32 * GP + dcol; LAS const unsigned char* p1 = lds + G_QD + (32 + r32) * GP + dcol;
            const bf16x8 qb0 = cat8(*(const LAS s16x4*)p0, *(const LAS s16x4*)(p0 + 16)), qb1 = cat8(*(const LAS s16x4*)p1, *(const LAS s16x4*)(p1 + 16));
            oT0 = __builtin_amdgcn_mfma_f32_32x32x16_bf16(sf[db * 2 + s2], qb0, oT0, 0, 0, 0); oT1 = __builtin_amdgcn_mfma_f32_32x32x16_bf16(sf[db * 2 + s2], qb1, oT1, 0, 0, 0); }
    float ss0 = 0.f, ss1 = 0.f;
#pragma unroll
    for (int r = 0; r < 16; ++r) { ss0 += oT0[r] * oT0[r]; ss1 += oT1[r] * oT1[r]; }
    ss0 += __shfl_xor(ss0, 32); ss1 += __shfl_xor(ss1, 32);
    if (hi == 0) { SSQ[w * 64 + r32] = ss0; SSQ[w * 64 + 32 + r32] = ss1; }
    __syncthreads();
    f32x4 gnv[4];
#pragma unroll
    for (int rg = 0; rg < 4; ++rg) gnv[rg] = *(const f32x4*)(gnorm + h * 256 + 32 * w + 8 * rg + 4 * hi);
    float t0 = 0.f, t1 = 0.f;
#pragma unroll
    for (int q = 0; q < 8; ++q) { t0 += SSQ[q * 64 + r32]; t1 += SSQ[q * 64 + 32 + r32]; }
    const float rs0 = rsqrtf(t0 * (1.f / 256.f) + 1e-6f), rs1 = rsqrtf(t1 * (1.f / 256.f) + 1e-6f);
#pragma unroll
    for (int ib = 0; ib < 2; ++ib) { int rr = 32 * ib + r32; asm volatile("" : "+v"(rr)); const size_t rowoff = (row0 + rr) * 1024 + h * 256 + 32 * w + 4 * hi; const float rs = ib ? rs1 : rs0;
#pragma unroll
        for (int rg = 0; rg < 4; ++rg) { const u32x2 rw = rwv[ib][rg];
            const float r0 = bflo(rw.x), r1 = bfhi(rw.x), r2 = bflo(rw.y), r3 = bfhi(rw.y);
            const float o0 = (ib ? oT1[4 * rg] : oT0[4 * rg]) * rs * gnv[rg][0] * r0 * pg8::fast_sigmoid(r0), o1 = (ib ? oT1[4 * rg + 1] : oT0[4 * rg + 1]) * rs * gnv[rg][1] * r1 * pg8::fast_sigmoid(r1);
            const float o2 = (ib ? oT1[4 * rg + 2] : oT0[4 * rg + 2]) * rs * gnv[rg][2] * r2 * pg8::fast_sigmoid(r2), o3 = (ib ? oT1[4 * rg + 3] : oT0[4 * rg + 3]) * rs * gnv[rg][3] * r3 * pg8::fast_sigmoid(r3);
            u32x2 ow; ow.x = pk2(o0, o1); ow.y = pk2(o2, o3); *(u32x2*)(OA + rowoff + 8 * rg) = ow; } }
}
__global__ void __launch_bounds__(NTHREADS, 2) fwd_megakernel(Args a) {
    extern __shared__ __attribute__((aligned(16))) unsigned char lds_raw[];
    LAS unsigned char* lds = (LAS unsigned char*)lds_raw;
    cg::grid_group grid = cg::this_grid();
    const int G = gridDim.x, bx = blockIdx.x;
    const int wave0 = __builtin_amdgcn_readfirstlane((int)threadIdx.x >> 6);
#define MK_TID() (wave0 * 64 + (int)__builtin_amdgcn_mbcnt_hi(~0u, __builtin_amdgcn_mbcnt_lo(~0u, 0u)))
    volatile LAS unsigned* xst = (volatile LAS unsigned*)(lds + XST_OFF);
    if (threadIdx.x < 4) xst[threadIdx.x] = 0u;
    __syncthreads();
    (void)xcd_barrier_post((unsigned*)(a.ws + WS_CTL), xst);
    unsigned char* ws = (unsigned char*)(GASP unsigned char*)a.ws; float* out = (float*)(GASP float*)a.out;
#define RELOAD_PTRS() do { size_t z_ = 0; asm volatile("" : "+s"(z_)); ws = (unsigned char*)((GASP unsigned char*)a.ws + z_); out = (float*)((GASP float*)a.out + z_); } while (0)
#define GRID_SYNC() do { XcdBarrier b_; b_.bar = (unsigned*)(ws + WS_CTL); b_.x = xb_xcc_id(); b_.st = (volatile LAS unsigned*)(lds + XST_OFF); xcd_barrier(b_, MK_TID() == 0); RELOAD_PTRS(); } while (0)
#define GRID_SYNC_CG() do { grid.sync(); GRID_SYNC(); } while (0)
#define LAUNDER_TID() int tid = MK_TID(); asm volatile("" : "+v"(tid)); const int lane = tid & 63, wave = __builtin_amdgcn_readfirstlane(tid >> 6)
#define W1T ((bf16*)(ws + WS_W1T))
#define W1OT ((bf16*)(ws + WS_W1OT))
#define WINT ((bf16*)(ws + WS_WINT))
#define WBGT ((bf16*)(ws + WS_WBGT))
#define WBAT ((bf16*)(ws + WS_WBAT))
#define WOUTT ((bf16*)(ws + WS_WOUTT))
#define W2T ((bf16*)(ws + WS_W2T))
#define W2OT ((bf16*)(ws + WS_W2OT))
#define CKB ((bf16*)(ws + WS_CKB))
#define CVB ((bf16*)(ws + WS_CVB))
#define XN ((bf16*)(ws + WS_XN))
#define SS1 ((float*)(ws + WS_SS1))
#define SS2 ((float*)(ws + WS_SS2))
#define ACT ((bf16*)(ws + WS_ACT))
#define PB ((bf16*)(ws + WS_PB))
#define GG ((bf16*)(ws + WS_GG))
#define FA ((float*)(ws + WS_FA))
#define OA ((bf16*)(ws + WS_OA))
#define OB ((bf16*)(ws + WS_OB))
#define TMP ((bf16*)(ws + WS_TMP))
#define MIX ((bf16*)((unsigned char*)(out + O_Y) + (size_t)75497472))
#define H (out + O_Y)
    constexpr size_t PBE = PBS / 2;

#ifndef REP_P0
#define REP_P0 1
#endif
    for (int rp0 = 0; rp0 < REP_P0; ++rp0) {
        LAUNDER_TID();
        const int gw = bx * NWAVES + wave, NGW = G * NWAVES;
        for (int it = bx; it < 16 * 22; it += G) transpose_tile_block(1, AIN(6), 5632, 1024, 5632, W1T, AIN(5), it, lds, tid);
        __syncthreads();
        for (int m4 = gw; m4 < T_ALL / 4; m4 += NGW) { const int m = 4 * m4;
            const float* xr = (m < T_P) ? AIN(0) + (size_t)m * 1024 : AIN(1) + (size_t)(m - T_P) * 1024;
            rms_rows4_to_bf16(xr, XN + (size_t)m * 1024, lane); }
    }
    GRID_SYNC();
#ifndef REP_P1
#define REP_P1 1
#endif
    for (int rep1 = 0; rep1 < REP_P1; ++rep1) {
      if (rep1) { GRID_SYNC(); }
 pg8::Gemm g{XN, W1T, T_ALL, 5632, 1024}; pg8::StaticOrder S; S.init(T_ALL, 5632, G, bx); pg8::EpiSwiglu E{ACT, nullptr};
      pg8::gemm_phase<pg8::EpiSwiglu, pg8::StaticOrder, true, true>(lds, g, S, E, MK_TID()); }
    {
        LAUNDER_TID();
        const int nwg = (T_ALL / 256) * 22, rounds = (nwg + G - 1) / G, first_idle = nwg - (rounds - 1) * G;
        const bool all = (first_idle >= G); const int ib = all ? bx : bx - first_idle, nib = all ? G : G - first_idle;
        if (ib >= 0) {
            constexpr int I1 = 44 * 4, I2 = 16 * 33, I3 = 16 * 4, I6 = 16 * 22, I7 = I1, NDEF = I1 + I2 + 3 * I3 + I6 + I7;
            for (int it = ib; it < NDEF; it += nib) {
                int r = it;
                if (r < I1) { transpose_tile_block(0, AIN(7), 1024, 2816, 1024, W1OT, nullptr, r, lds, tid); continue; } r -= I1;
                if (r < I2) { transpose_tile_block(2, AIN(9), NPROJ_SRC, 1024, NPROJ, WINT, AIN(8), r, lds, tid); continue; } r -= I2;
                if (r < I3) { transpose_tile_block(0, AIN(14), 1024, 1024, 1024, WBGT, nullptr, r, lds, tid); continue; } r -= I3;
                if (r < I3) { transpose_tile_block(0, AIN(15), 1024, 1024, 1024, WBAT, nullptr, r, lds, tid); continue; } r -= I3;
                if (r < I3) { transpose_tile_block(0, AIN(16), 1024, 1024, 1024, WOUTT, nullptr, r, lds, tid); continue; } r -= I3;
                if (r < I6) { transpose_tile_block(1, AIN(18), 5632, 1024, 5632, W2T, AIN(17), r, lds, tid); continue; } r -= I6;
                transpose_tile_block(0, AIN(19), 1024, 2816, 1024, W2OT, nullptr, r, lds, tid);
            }
            const size_t nvec = (size_t)8 * 512 * 1024 / 8;
            for (size_t v = (size_t)ib * NTHREADS + tid; v < nvec; v += (size_t)nib * NTHREADS) {
                const f32x4 k0 = *(const f32x4*)(AIN(2) + v * 8), k1 = *(const f32x4*)(AIN(2) + v * 8 + 4), v0 = *(const f32x4*)(AIN(3) + v * 8), v1 = *(const f32x4*)(AIN(3) + v * 8 + 4);
                *(u32x4*)(CKB + v * 8) = (u32x4){pk2(k0[0], k0[1]), pk2(k0[2], k0[3]), pk2(k1[0], k1[1]), pk2(k1[2], k1[3])};
                *(u32x4*)(CVB + v * 8) = (u32x4){pk2(v0[0], v0[1]), pk2(v0[2], v0[3]), pk2(v1[0], v1[1]), pk2(v1[2], v1[3])};
            }
        }
    }
    GRID_SYNC();
#ifndef REP_P2
#define REP_P2 1
#endif
    for (int rp2 = 0; rp2 < REP_P2; ++rp2)
    { pg8::Gemm g{ACT, W1OT, T_P, 1024, 2816}; pg8::StaticOrder S; S.init(T_P, 1024, G, bx); pg8::EpiRes E{AIN(0), AIN(1), 128, nullptr, nullptr, XN, SS1, 0.5f};
      pg8::gemm_phase<pg8::EpiRes, pg8::StaticOrder, true, true>(lds, g, S, E, MK_TID()); }
    { LAUNDER_TID(); (void)lane; (void)wave; small_gemm_res<0>(lds, ACT + (size_t)T_P * DFF, W1OT, DFF, AIN(1), nullptr, nullptr, XN + (size_t)T_P * 1024, SS1 + (size_t)T_P * 16, 0.5f, nullptr, bx, G, tid); }
    GRID_SYNC();
    for (int grp = 0; grp < 2; ++grp) {
        const int row0 = grp ? 16384 : 0, Mg = grp ? 16896 : 16384;
#ifndef REP_P3
#define REP_P3 1
#endif
        for (int rp3 = 0; rp3 < REP_P3; ++rp3)
        { pg8::Gemm g{XN + (size_t)row0 * 1024, WINT, Mg, NPROJ, 1024}; pg8::StaticOrder S; S.init(Mg, NPROJ, G, bx);
          pg8::EpiProj E{PB, PBE, GG, FA, SS1 + (size_t)row0 * 16, out + O_KP, out + O_VP, out + O_KS, out + O_VS, row0};
          pg8::gemm_phase<pg8::EpiProj, pg8::StaticOrder, true, true>(lds, g, S, E, MK_TID()); }
        GRID_SYNC();
        {
            LAUNDER_TID();
            const bf16* QB = PB + 3 * PBE; const bf16* KB = PB + 4 * PBE; const bf16* VB = PB + 5 * PBE;
            LAS unsigned char* wl = lds + wave * ATT_WLDS;
            const int nbu = 1024 + (grp ? 32 : 0);
#ifndef REP_ATT
#define REP_ATT 1
#endif
            for (int ra_ = 0; ra_ < REP_ATT; ++ra_)
            for (int bu = bx; bu < nbu; bu += G) {
                int lrow, h, t0, qh; bool sample = false; const bf16 *ck = CKB, *cv = CVB;
                if (bu < 1024) {
                    const int sb = bu & 7, j = bu >> 3, hp = (j >> 4) & 7, cp = ((j & 15) + 4 * (j >> 5)) & 15; attn_block_unit(lds, QB, OB, KB, VB, sb, hp, cp, AIN(13), tid); continue; }
                __syncthreads();
                { const int su = (bu - 1024) * 8 + wave, sbh = su >> 1, sb = sbh >> 4; h = sbh & 15; qh = su & 1; lrow = 16384 + sb * 64; t0 = 0; sample = true; ck = CKB + (size_t)sb * 512 * 1024 + h * 64; cv = CVB + (size_t)sb * 512 * 1024 + h * 64; }
                const size_t off = (size_t)lrow * 1024 + h * 64;
                if (qh) attn_unit(wl, QB + off, OB + off, KB + off, VB + off, ck, cv, sample, t0, AIN(13) + h * 257, lane, 1);
                else attn_unit(wl, QB + off, OB + off, KB + off, VB + off, ck, cv, sample, t0, AIN(13) + h * 257, lane, 0);
            }
        }
        {
            LAUNDER_TID();
            __syncthreads();
            const int nun = (grp ? 264 : 256) * 4;
            for (int u = G - 1 - bx; u < nun; u += G) gla_a_unit(lds, PB, PB + PBE, FA, (unsigned char*)H, row0, (float*)((unsigned char*)H + WS_DECB), u >> 2, u & 3, AIN(10), AIN(11), tid);
        }
        GRID_SYNC();
        {
            LAUNDER_TID();
            const int gt = bx * NTHREADS + tid, nthr = G * NTHREADS;
            for (int v = gt; v < 32 * 4096; v += nthr) { const int pair = v >> 12, e = v & 4095, sb = pair >> 2, h = pair & 3;
                gla_scan_vec((unsigned char*)H, row0, (const float*)((unsigned char*)H + WS_DECB), sb * 32, 32, h, e, nullptr, out + O_GP + (size_t)((8 * grp + sb) * 4 + h) * 32768); }
            if (grp) for (int v = gt; v < 32 * 4096; v += nthr) { const int pair = v >> 12, e = v & 4095, sb = pair >> 2, h = pair & 3;
                gla_scan_vec((unsigned char*)H, row0, (const float*)((unsigned char*)H + WS_DECB), 256 + sb, 1, h, e, AIN(4) + (size_t)(sb * 4 + h) * 32768, out + O_GS + (size_t)(sb * 4 + h) * 32768); }
        }
        GRID_SYNC();
        {
            LAUNDER_TID();
            const int nun = (grp ? 264 : 256) * 4;
#ifndef REP_C
#define REP_C 1
#endif
            for (int rc_ = 0; rc_ < REP_C; ++rc_)
            for (int u = bx; u < nun; u += G) gla_c_unit(lds, PB, PB + PBE, PB + 2 * PBE, (unsigned char*)H, row0, OA, u >> 2, u & 3, AIN(12), tid);
        }
        GRID_SYNC();
        { pg8::Gemm g{OA, WBGT, 16384, 1024, 1024}; pg8::StaticOrder S; S.init(16384, 1024, G, bx); pg8::EpiGate<0> E{GG, 0, TMP, MIX};
          pg8::gemm_phase<pg8::EpiGate<0>, pg8::StaticOrder, true, true>(lds, g, S, E, MK_TID()); }
        if (grp) { LAUNDER_TID(); (void)lane; (void)wave; small_gemm_res<1>(lds, OA + (size_t)16384 * 1024, WBGT, 1024, nullptr, nullptr, nullptr, TMP + (size_t)16384 * 1024, nullptr, 0.f, GG + (size_t)16384 * 2048, bx, G, tid); }
        { pg8::Gemm g{OB, WBAT, 16384, 1024, 1024}; pg8::StaticOrder S; S.init(16384, 1024, G, bx); pg8::EpiGate<1> E{GG, 1024, TMP, MIX};
          pg8::gemm_phase<pg8::EpiGate<1>, pg8::StaticOrder, true, true>(lds, g, S, E, MK_TID()); }
        if (grp) { LAUNDER_TID(); (void)lane; (void)wave; small_gemm_res<2>(lds, OB + (size_t)16384 * 1024, WBAT, 1024, nullptr, TMP + (size_t)16384 * 1024, nullptr, MIX + (size_t)16384 * 1024, nullptr, 0.f, GG + (size_t)16384 * 2048 + 1024, bx, G, tid); }
        GRID_SYNC();
        { pg8::Gemm g{MIX, WOUTT, 16384, 1024, 1024}; pg8::StaticOrder S; S.init(16384, 1024, G, bx);
          pg8::EpiRes E{nullptr, nullptr, 1 << 30, XN + (size_t)row0 * 1024, nullptr, XN + (size_t)row0 * 1024, SS2 + (size_t)row0 * 16, 1.0f};
          pg8::gemm_phase<pg8::EpiRes, pg8::StaticOrder, true, true>(lds, g, S, E, MK_TID()); }
        if (grp) { LAUNDER_TID(); (void)lane; (void)wave; small_gemm_res<0>(lds, MIX + (size_t)16384 * 1024, WOUTT, 1024, nullptr, XN + (size_t)T_P * 1024, nullptr, XN + (size_t)T_P * 1024, SS2 + (size_t)T_P * 16, 1.0f, nullptr, bx, G, tid); }
        if (grp == 1) GRID_SYNC();
    }
    { pg8::Gemm g{XN, W2T, T_ALL, 5632, 1024}; pg8::StaticOrder S; S.init(T_ALL, 5632, G, bx); pg8::EpiSwiglu E{ACT, SS2};
      pg8::gemm_phase<pg8::EpiSwiglu, pg8::StaticOrder, true, true>(lds, g, S, E, MK_TID()); }
    GRID_SYNC_CG();
    { pg8::Gemm g{ACT, W2OT, T_P, 1024, 2816}; pg8::StaticOrder S; S.init(T_P, 1024, G, bx); pg8::EpiRes E{nullptr, nullptr, 1 << 30, XN, nullptr, XN, nullptr, 0.5f};
      pg8::gemm_phase<pg8::EpiRes, pg8::StaticOrder, true, true>(lds, g, S, E, MK_TID()); }
    { LAUNDER_TID(); (void)lane; (void)wave; small_gemm_res<0>(lds, ACT + (size_t)T_P * DFF, W2OT, DFF, nullptr, XN + (size_t)T_P * 1024, nullptr, XN + (size_t)T_P * 1024, nullptr, 0.5f, nullptr, bx, G, tid); }
    GRID_SYNC();
    {
        LAUNDER_TID();
        const int gw = bx * NWAVES + wave, NGW = G * NWAVES; const f32x4* gf = (const f32x4*)AIN(20) + lane;
        f32x4 gv[4];
#pragma unroll
        for (int j = 0; j < 4; ++j) gv[j] = gf[64 * j];
        for (int m4 = gw; m4 < T_ALL / 4; m4 += NGW) { f32x4* xr = (f32x4*)(H + (size_t)m4 * 4096) + lane; const u32x2* hb = (const u32x2*)(XN + (size_t)m4 * 4096) + lane; f32x4 v[4][4]; float s[4];
#pragma unroll
            for (int q = 0; q < 4; ++q)
#pragma unroll
                for (int j = 0; j < 4; ++j) { const u32x2 w = hb[q * 256 + 64 * j]; v[q][j] = (f32x4){bflo(w.x), bfhi(w.x), bflo(w.y), bfhi(w.y)}; }
#pragma unroll
            for (int q = 0; q < 4; ++q) { s[q] = 0.f;
#pragma unroll
                for (int j = 0; j < 4; ++j) s[q] += (v[q][j].x * v[q][j].x + v[q][j].y * v[q][j].y) + (v[q][j].z * v[q][j].z + v[q][j].w * v[q][j].w); }
#pragma unroll
            for (int o = 1; o < 64; o <<= 1) {
#pragma unroll
                for (int q = 0; q < 4; ++q) s[q] += __shfl_xor(s[q], o); }
#pragma unroll
            for (int q = 0; q < 4; ++q) { const float rstd = rsqrtf(s[q] * (1.f / 1024.f) + 1e-6f);
#pragma unroll
                for (int j = 0; j < 4; ++j) __builtin_nontemporal_store(v[q][j] * rstd * gv[j], xr + q * 256 + 64 * j); } }
    }
}

extern "C" void kernel_launch(void* const* d_in, const int* in_sizes, int n_in, void* d_out, int out_size, void* d_ws, size_t ws_size, hipStream_t stream) {
    static int grid = 0;
    if (grid == 0) {
        if (n_in != 21 || (size_t)out_size != O_END || ws_size < WS_CTL + CTL_BYTES) { fprintf(stderr, "kernel_launch: unexpected shapes (n_in %d, out %d, ws %zu); nothing launched\n", n_in, out_size, ws_size); grid = -1; return; }
        int dev = 0, cus = 0, per_cu = 0;
        hipGetDevice(&dev); hipDeviceGetAttribute(&cus, hipDeviceAttributeMultiprocessorCount, dev);
        hipFuncSetAttribute((const void*)fwd_megakernel, hipFuncAttributeMaxDynamicSharedMemorySize, LDS_BYTES);
        hipOccupancyMaxActiveBlocksPerMultiprocessor(&per_cu, (const void*)fwd_megakernel, NTHREADS, LDS_BYTES);
        if (per_cu < 1) { fprintf(stderr, "kernel_launch: occupancy query says %d blocks per CU; nothing launched\n", per_cu); grid = -1; return; }
        grid = cus;
        if (grid < 64) { fprintf(stderr, "kernel_launch: needs at least 64 CUs\n"); grid = -1; return; }
    }
    if (grid < 0) return;
    if (hipMemsetAsync((char*)d_ws + WS_CTL, 0, CTL_BYTES, stream) != hipSuccess) { fprintf(stderr, "kernel_launch: hipMemsetAsync failed\n"); return; }
    Args a{};
    for (int i = 0; i < 21; ++i) a.in[i] = (const float*)d_in[i];
    a.out = (float*)d_out; a.ws = (unsigned char*)d_ws;
    void* args[] = {&a};
    hipError_t e = hipLaunchCooperativeKernel((const void*)fwd_megakernel, dim3(grid), dim3(NTHREADS), args, LDS_BYTES, stream);
    if (e != hipSuccess) fprintf(stderr, "cooperative launch failed: %s (grid %d)\n", hipGetErrorString(e), grid);
}
```
